# Optimizing an MI355X kernel written in HIP

```python
import math
import jax, jax.numpy as jnp
from jax import lax
import numpy as np

D_MODEL = 2048
BATCH = 2
SEQ = 8192
DEPTH = 2

N_MEM = 256
A_HEADS = 8
A_KV_HEADS = 2
A_HEAD_DIM = 128
IDX_HEADS = 4
IDX_DIM = 64
TOPK_MAX = 256
Q_BLOCK = 128
LRU_WIDTH = 1024
LRU_BLOCKS = 8
CONV_WIDTH = 4
LRU_C = 8.0
X_HEADS = 4
X_HEAD_DIM = 256
N_BRANCH = 3
BRANCH_WIDTH = 1024
D_FF = 5504
N_BUCKETS = 32
MAX_DISTANCE = 128
EPS = 1e-6

A_Q = A_HEADS * A_HEAD_DIM
A_KV = A_KV_HEADS * A_HEAD_DIM
SPLIT_SIZES = (A_Q, A_KV, A_KV, IDX_HEADS * IDX_DIM, IDX_DIM, IDX_HEADS,
               LRU_WIDTH, LRU_WIDTH, X_HEADS * X_HEAD_DIM, N_BRANCH * D_MODEL)
D_IN = sum(SPLIT_SIZES)

kernel_name = "hybrid_dsa_rglru_memory_macaron"


def rmsnorm(x, g):
    xf = x.astype(jnp.float32)
    y = xf * lax.rsqrt(jnp.mean(xf * xf, axis=-1, keepdims=True) + EPS)
    return (y * g.astype(jnp.float32)).astype(x.dtype)


def layernorm(x, g, b):
    xf = x.astype(jnp.float32)
    mu = jnp.mean(xf, axis=-1, keepdims=True)
    var = jnp.mean(jnp.square(xf - mu), axis=-1, keepdims=True)
    y = (xf - mu) * lax.rsqrt(var + EPS)
    return (y * g.astype(jnp.float32) + b.astype(jnp.float32)).astype(x.dtype)


def swiglu(x, w_gu, w_down):
    g, u = jnp.split(x @ w_gu, 2, axis=-1)
    return (jax.nn.silu(g) * u) @ w_down


def split_points():
    pts, acc = [], 0
    for n in SPLIT_SIZES[:-1]:
        acc += n
        pts.append(acc)
    return pts


def t5_bucket(dist):
    max_exact = N_BUCKETS // 2
    d = jnp.maximum(dist, 0)
    df = jnp.maximum(d, 1).astype(jnp.float32)
    large = max_exact + (jnp.log(df / max_exact) / math.log(MAX_DISTANCE / max_exact)
                         * (N_BUCKETS - max_exact)).astype(jnp.int32)
    large = jnp.minimum(large, N_BUCKETS - 1)
    return jnp.where(d < max_exact, d, large)


def dsa_attention(q, k, v, q_idx, k_idx, w_idx, rel_bias):
    b, s = q.shape[0], q.shape[1]
    topk = min(TOPK_MAX, s // 4)
    n_blocks = s // Q_BLOCK
    group = A_HEADS // A_KV_HEADS
    key_pos = jnp.arange(s, dtype=jnp.int32)
    gather = jax.vmap(lambda t, i: t[i])
    idx_scale = IDX_DIM ** -0.5
    w_scale = IDX_HEADS ** -0.5
    att_scale = A_HEAD_DIM ** -0.5

    def block(i):
        start = i * Q_BLOCK
        q_pos = start + jnp.arange(Q_BLOCK, dtype=jnp.int32)
        qb = lax.dynamic_slice_in_dim(q, start, Q_BLOCK, axis=1)
        qib = lax.dynamic_slice_in_dim(q_idx, start, Q_BLOCK, axis=1)
        wb = lax.dynamic_slice_in_dim(w_idx, start, Q_BLOCK, axis=1)
        dots = jnp.einsum('bqhd,bsd->bqhs', qib, k_idx).astype(jnp.float32) * idx_scale
        score = jnp.einsum('bqh,bqhs->bqs', wb.astype(jnp.float32) * w_scale, jax.nn.relu(dots))
        causal = key_pos[None, None, :] <= q_pos[None, :, None]
        score = jnp.where(causal, score, -jnp.inf)
        _, sel = lax.top_k(score, topk)
        kg = gather(k, sel)
        vg = gather(v, sel)
        qg = qb.reshape(b, Q_BLOCK, A_KV_HEADS, group, A_HEAD_DIM)
        logits = jnp.einsum('bqngd,bqknd->bqngk', qg, kg).astype(jnp.float32) * att_scale
        dist = q_pos[None, :, None] - sel
        bias = rel_bias[t5_bucket(dist)].astype(jnp.float32)
        bias = bias.reshape(b, Q_BLOCK, topk, A_KV_HEADS, group).transpose(0, 1, 3, 4, 2)
        valid = (dist >= 0)[:, :, None, None, :]
        logits = jnp.where(valid, logits + bias, -jnp.inf)
        p = jax.nn.softmax(logits, axis=-1).astype(v.dtype)
        out = jnp.einsum('bqngk,bqknd->bqngd', p, vg)
        return out.reshape(b, Q_BLOCK, A_Q)

    outs = lax.map(block, jnp.arange(n_blocks, dtype=jnp.int32))
    return outs.transpose(1, 0, 2, 3).reshape(b, s, A_Q)


def rglru_branch(xb, gate, conv_w, conv_b, w_a, b_a, w_i, b_i, lam):
    b, s, _ = xb.shape
    xp = jnp.pad(xb, ((0, 0), (CONV_WIDTH - 1, 0), (0, 0)))
    xc = conv_b + sum(xp[:, j:j + s] * conv_w[j] for j in range(CONV_WIDTH))
    xr = xc.reshape(b, s, LRU_BLOCKS, LRU_WIDTH // LRU_BLOCKS)
    r = jax.nn.sigmoid(jnp.einsum('bsnc,ncd->bsnd', xr, w_a).reshape(b, s, LRU_WIDTH) + b_a)
    i = jax.nn.sigmoid(jnp.einsum('bsnc,ncd->bsnd', xr, w_i).reshape(b, s, LRU_WIDTH) + b_i)
    log_a = -LRU_C * r.astype(jnp.float32) * jax.nn.softplus(-lam.astype(jnp.float32))
    a = jnp.exp(log_a)
    mult = jnp.sqrt(jnp.maximum(-jnp.expm1(2.0 * log_a), 0.0))
    u = mult * (i * xc).astype(jnp.float32)

    def combine(left, right):
        a1, b1 = left
        a2, b2 = right
        return a1 * a2, a2 * b1 + b2

    _, h = lax.associative_scan(combine, (a, u), axis=1)
    return h.astype(xb.dtype) * jax.nn.gelu(gate)


def memory_attention(q, mem_k, mem_v):
    b, s = q.shape[0], q.shape[1]
    logits = jnp.einsum('bshd,bmhd->bhsm', q, mem_k).astype(jnp.float32) * (X_HEAD_DIM ** -0.5)
    p = jax.nn.softmax(logits, axis=-1).astype(q.dtype)
    return jnp.einsum('bhsm,bmhd->bshd', p, mem_v).reshape(b, s, X_HEADS * X_HEAD_DIM)


def hybrid_layer(x, mem, rel_bias, norm_ff1, w_ff1_gu, w_ff1_down, norm_mix, w_in,
                 conv_w, conv_b, w_a, b_a, w_i, b_i, lam, idx_ln_g, idx_ln_b,
                 mem_norm, w_mem_kv, w_branch, w_out, norm_ff2, w_ff2_gu, w_ff2_down):
    b, s, _ = x.shape
    x = x + 0.5 * swiglu(rmsnorm(x, norm_ff1), w_ff1_gu, w_ff1_down)
    h = rmsnorm(x, norm_mix)
    proj = h @ w_in
    (q_a, k_a, v_a, q_idx, k_idx, w_idx, x_lru, g_lru, q_mem, gates) = jnp.split(proj, split_points(), axis=-1)
    y_a = dsa_attention(q_a.reshape(b, s, A_HEADS, A_HEAD_DIM),
                        k_a.reshape(b, s, A_KV_HEADS, A_HEAD_DIM),
                        v_a.reshape(b, s, A_KV_HEADS, A_HEAD_DIM),
                        q_idx.reshape(b, s, IDX_HEADS, IDX_DIM),
                        layernorm(k_idx, idx_ln_g, idx_ln_b), w_idx, rel_bias)
    y_b = rglru_branch(x_lru, g_lru, conv_w, conv_b, w_a, b_a, w_i, b_i, lam)
    mk, mv = jnp.split(rmsnorm(mem, mem_norm) @ w_mem_kv, 2, axis=-1)
    m = mem.shape[1]
    y_c = memory_attention(q_mem.reshape(b, s, X_HEADS, X_HEAD_DIM),
                           mk.reshape(b, m, X_HEADS, X_HEAD_DIM),
                           mv.reshape(b, m, X_HEADS, X_HEAD_DIM))
    branches = jnp.stack([y_a, y_b, y_c], axis=2)
    branch_d = jnp.einsum('bsjc,jcd->bsjd', branches, w_branch)
    g = jax.nn.sigmoid(gates.reshape(b, s, N_BRANCH, D_MODEL))
    merged = jnp.einsum('bsjd,bsjd->bsd', g, branch_d)
    x = x + merged @ w_out
    x = x + 0.5 * swiglu(rmsnorm(x, norm_ff2), w_ff2_gu, w_ff2_down)
    return x


def setup_inputs(seed: int = 0) -> dict:
    key = jax.random.key(seed)
    ks = jax.random.split(key, 32)
    f32 = jnp.float32
    nrm = lambda k, shape, scale: jax.random.normal(k, shape, f32) * scale
    gain = lambda k, shape: 1.0 + 0.02 * jax.random.normal(k, shape, f32)
    L = DEPTH
    base = jnp.sqrt(jax.random.uniform(ks[12], (L, LRU_WIDTH), f32, 0.81, 0.998))
    lam = jnp.log(base) - jnp.log1p(-base)
    bw = LRU_WIDTH // LRU_BLOCKS
    return {
        "x": nrm(ks[0], (BATCH, SEQ, D_MODEL), 1.0),
        "mem": nrm(ks[1], (BATCH, N_MEM, D_MODEL), 1.0),
        "rel_bias": nrm(ks[2], (N_BUCKETS, A_HEADS), 0.5),
        "final_norm": gain(ks[3], (D_MODEL,)),
        "norm_ff1": gain(ks[4], (L, D_MODEL)),
        "w_ff1_gu": nrm(ks[5], (L, D_MODEL, 2 * D_FF), D_MODEL ** -0.5),
        "w_ff1_down": nrm(ks[6], (L, D_FF, D_MODEL), D_FF ** -0.5),
        "norm_mix": gain(ks[7], (L, D_MODEL)),
        "w_in": nrm(ks[8], (L, D_MODEL, D_IN), D_MODEL ** -0.5),
        "conv_w": nrm(ks[9], (L, CONV_WIDTH, LRU_WIDTH), CONV_WIDTH ** -0.5),
        "conv_b": nrm(ks[10], (L, LRU_WIDTH), 0.01),
        "w_a": nrm(ks[11], (L, LRU_BLOCKS, bw, bw), bw ** -0.5),
        "b_a": nrm(ks[13], (L, LRU_WIDTH), 0.01),
        "w_i": nrm(ks[14], (L, LRU_BLOCKS, bw, bw), bw ** -0.5),
        "b_i": nrm(ks[15], (L, LRU_WIDTH), 0.01),
        "lam": lam,
        "idx_ln_g": gain(ks[16], (L, IDX_DIM)),
        "idx_ln_b": nrm(ks[17], (L, IDX_DIM), 0.01),
        "mem_norm": gain(ks[18], (L, D_MODEL)),
        "w_mem_kv": nrm(ks[19], (L, D_MODEL, 2 * X_HEADS * X_HEAD_DIM), D_MODEL ** -0.5),
        "w_branch": nrm(ks[20], (L, N_BRANCH, BRANCH_WIDTH, D_MODEL), BRANCH_WIDTH ** -0.5),
        "w_out": nrm(ks[21], (L, D_MODEL, D_MODEL), D_MODEL ** -0.5),
        "norm_ff2": gain(ks[22], (L, D_MODEL)),
        "w_ff2_gu": nrm(ks[23], (L, D_MODEL, 2 * D_FF), D_MODEL ** -0.5),
        "w_ff2_down": nrm(ks[24], (L, D_FF, D_MODEL), D_FF ** -0.5),
    }


def reference(x, mem, rel_bias, final_norm, norm_ff1, w_ff1_gu, w_ff1_down, norm_mix, w_in,
              conv_w, conv_b, w_a, b_a, w_i, b_i, lam, idx_ln_g, idx_ln_b, mem_norm,
              w_mem_kv, w_branch, w_out, norm_ff2, w_ff2_gu, w_ff2_down):
    for l in range(DEPTH):
        x = hybrid_layer(x, mem, rel_bias,
                         norm_ff1[l], w_ff1_gu[l], w_ff1_down[l], norm_mix[l], w_in[l],
                         conv_w[l], conv_b[l], w_a[l], b_a[l], w_i[l], b_i[l], lam[l],
                         idx_ln_g[l], idx_ln_b[l], mem_norm[l], w_mem_kv[l],
                         w_branch[l], w_out[l], norm_ff2[l], w_ff2_gu[l], w_ff2_down[l])
    return rmsnorm(x, final_norm)
```

```cpp
#include <hip/hip_runtime.h>
#include <cstdio>
#include <cstdint>

namespace pg8 {
#define PG8_LAS __attribute__((address_space(3)))
typedef unsigned short bf16_t;
typedef short bf16x8 __attribute__((ext_vector_type(8)));
typedef float f32x4 __attribute__((ext_vector_type(4)));
typedef unsigned u32x4 __attribute__((ext_vector_type(4)));
typedef unsigned u32x2 __attribute__((ext_vector_type(2)));
constexpr int BM = 256, BK = 64, HALF = 128, HTB = HALF * BK * 2  , STAGE_BYTES = 8 * HTB, NXCD = 8, WGM = 8;

__host__ __device__ __forceinline__ int lds_byte(int r, int c) { const int st = (r >> 4) * 2 + (c >> 5), rr = r & 15, cc = c & 31, ob = rr * 64 + cc * 2; return st * 1024 + (ob ^ (((ob >> 9) & 1) << 5)); }
__host__ __device__ __forceinline__ void stage_rc(int b, int& R, int& C) { const int st = b / 1024, sb = b % 1024, swz = sb ^ (((sb >> 9) & 1) << 5); R = (st >> 1) * 16 + swz / 64; C = (st & 1) * 32 + (swz % 64) / 2; }
__host__ __device__ __forceinline__ int perm32(int rho) { const int n = rho >> 4, i = rho & 15; return 8 * (i >> 2) + 4 * n + (i & 3); }

struct Unit { int pm, pn; };
struct Gemm { const bf16_t* A; const bf16_t* Bt; int M, N, K, lda, ldb; };

struct StaticOrder {
    int nM, nN, nwg, G, c;
    __host__ __device__ void init(int M, int N, int G_, int c_) { nM = M / BM; nN = N / BM; nwg = nM * nN; G = G_; c = c_; }
    __host__ __device__ bool next(int i, Unit& u) const {
        const long L = (long)i * G + c; if (L >= nwg) return false;
        int wgid = (int)L; { const int q = nwg / NXCD, r = nwg % NXCD, xcd = wgid % NXCD, off = wgid / NXCD; wgid = (xcd < r ? xcd * (q + 1) : r * (q + 1) + (xcd - r) * q) + off; }
        const int nig = WGM * nN, gid = wgid / nig, fm = gid * WGM, gsz = (nM - fm) < WGM ? (nM - fm) : WGM;
        u.pm = fm + ((wgid % nig) % gsz); u.pn = (wgid % nig) / gsz; return true;
    }
    __device__ __forceinline__ void a_ready(const Unit&) const {}
    __device__ __forceinline__ void done(const Unit&) const {}
};
struct SimpleOrder {
    int nM, nN, nwg, G, c;
    __host__ __device__ void init(int M, int N, int G_, int c_) { nM = M / BM; nN = N / BM; nwg = nM * nN; G = G_; c = c_; }
    __host__ __device__ bool next(int i, Unit& u) const {
        const long L = (long)i * G + c; if (L < 0 || L >= nwg) return false;
        u.pm = (int)(L % nM); u.pn = (int)(L / nM); return true;
    }
    __device__ __forceinline__ void a_ready(const Unit&) const {}
    __device__ __forceinline__ void done(const Unit&) const {}
};

__device__ __forceinline__ unsigned cvt_pk_bf16(float lo, float hi) { unsigned r; asm volatile("v_cvt_pk_bf16_f32 %0, %1, %2" : "=v"(r) : "v"(lo), "v"(hi)); return r; }

__device__ __forceinline__ float fsigmoid(float x) { return __builtin_amdgcn_rcpf(1.0f + __builtin_amdgcn_exp2f(-1.4426950408889634f * x)); }
__device__ __forceinline__ float bf_lo(unsigned w) { return __uint_as_float(w << 16); }
__device__ __forceinline__ float bf_hi(unsigned w) { return __uint_as_float(w & 0xffff0000u); }

struct EpiSwiglu {
    static constexpr bool PERM = true, AFTER_DRAIN = false;
    bf16_t* H; int ldh;
    __device__ __forceinline__ void operator()(const f32x4 (&acc)[2][2][4][2], const Unit& u, int wr, int wc, int fr, int fq) const {
        const int row0 = u.pm * BM + wr * 64 + fr, col0 = u.pn * HALF + wc * 32 + 8 * fq;
#pragma unroll
        for (int ai = 0; ai < 2; ++ai)
#pragma unroll
            for (int m = 0; m < 4; ++m) {
                bf16_t* rowp = H + (size_t)(row0 + ai * HALF + m * 16) * ldh + col0;
                const f32x4 g0 = acc[ai][0][m][0], g1 = acc[ai][0][m][1], u0 = acc[ai][1][m][0], u1 = acc[ai][1][m][1];
                float o[8];
#pragma unroll
                for (int j = 0; j < 4; ++j) { o[j] = g0[j] * fsigmoid(g0[j]) * u0[j]; o[4 + j] = g1[j] * fsigmoid(g1[j]) * u1[j]; }
                u32x4 w; w.x = cvt_pk_bf16(o[0], o[1]); w.y = cvt_pk_bf16(o[2], o[3]); w.z = cvt_pk_bf16(o[4], o[5]); w.w = cvt_pk_bf16(o[6], o[7]);
                *(u32x4*)rowp = w;
            }
    }
};
struct EpiResid {
    static constexpr bool PERM = false, AFTER_DRAIN = false;
    const float* src; float* out; int ldc; float alpha;
    __device__ __forceinline__ void operator()(const f32x4 (&acc)[2][2][4][2], const Unit& u, int wr, int wc, int fr, int fq) const {
        const int row0 = u.pm * BM + wr * 64 + fr, col0 = u.pn * BM + wc * 32 + 4 * fq;
#pragma unroll
        for (int ai = 0; ai < 2; ++ai)
#pragma unroll
            for (int m = 0; m < 4; ++m) {
                const size_t off = (size_t)(row0 + ai * HALF + m * 16) * ldc + col0;
                f32x4 s[2][2];
#pragma unroll
                for (int bj = 0; bj < 2; ++bj)
#pragma unroll
                    for (int n = 0; n < 2; ++n) s[bj][n] = *(const f32x4*)(src + off + bj * HALF + n * 16);
#pragma unroll
                for (int bj = 0; bj < 2; ++bj)
#pragma unroll
                    for (int n = 0; n < 2; ++n) *(f32x4*)(out + off + bj * HALF + n * 16) = s[bj][n] + acc[ai][bj][m][n] * alpha;
                if (m & 1) asm volatile("" ::: "memory");
            }
    }
};
struct EpiProj {
    static constexpr bool PERM = true, AFTER_DRAIN = false;
    bf16_t* P; int ldp; float* side;
    __device__ __forceinline__ void operator()(const f32x4 (&acc)[2][2][4][2], const Unit& u, int wr, int wc, int fr, int fq) const {
        const int row0 = u.pm * BM + wr * 64 + fr, cw = wc * 32 + 8 * fq;
        if (u.pn == 7) {
            if (cw < 72) {
#pragma unroll
                for (int ai = 0; ai < 2; ++ai)
#pragma unroll
                    for (int m = 0; m < 4; ++m) { float* rp = side + (size_t)(row0 + ai * HALF + m * 16) * 72 + cw; *(f32x4*)rp = acc[ai][0][m][0]; *(f32x4*)(rp + 4) = acc[ai][0][m][1]; }
            }
            return;
        }
        const int colbase = 256 * (u.pn > 7 ? u.pn - 1 : u.pn) + cw; const bool sig = u.pn >= 20;
#pragma unroll
        for (int ai = 0; ai < 2; ++ai)
#pragma unroll
            for (int m = 0; m < 4; ++m) {
                bf16_t* rowp = P + (size_t)(row0 + ai * HALF + m * 16) * ldp + colbase;
#pragma unroll
                for (int bj = 0; bj < 2; ++bj) {
                    f32x4 v0 = acc[ai][bj][m][0] + 0.0f, v1 = acc[ai][bj][m][1] + 0.0f;
                    if (sig) {
#pragma unroll
                        for (int j = 0; j < 4; ++j) { v0[j] = fsigmoid(v0[j]); v1[j] = fsigmoid(v1[j]); }
                    }
                    u32x4 w; w.x = cvt_pk_bf16(v0[0], v0[1]); w.y = cvt_pk_bf16(v0[2], v0[3]); w.z = cvt_pk_bf16(v1[0], v1[1]); w.w = cvt_pk_bf16(v1[2], v1[3]);
                    *(u32x4*)(rowp + bj * HALF) = w;
                }
            }
    }
};
template <int J> struct EpiBranch {
    static constexpr bool PERM = true, AFTER_DRAIN = false;
    const bf16_t* gate; int ldg; float* tmp; bf16_t* outb; int ldc;
    __device__ __forceinline__ void operator()(const f32x4 (&acc)[2][2][4][2], const Unit& u, int wr, int wc, int fr, int fq) const {
        const int row0 = u.pm * BM + wr * 64 + fr, col0 = u.pn * BM + wc * 32 + 8 * fq;
#pragma unroll
        for (int ai = 0; ai < 2; ++ai)
#pragma unroll
            for (int m = 0; m < 4; ++m) {
                const int row = row0 + ai * HALF + m * 16;
#pragma unroll
                for (int bj = 0; bj < 2; ++bj) {
                    const int c = col0 + bj * HALF;
                    const u32x4 gv = *(const u32x4*)(gate + (size_t)row * ldg + c);
                    f32x4 t0, t1;
                    t0[0] = bf_lo(gv.x) * acc[ai][bj][m][0][0]; t0[1] = bf_hi(gv.x) * acc[ai][bj][m][0][1]; t0[2] = bf_lo(gv.y) * acc[ai][bj][m][0][2]; t0[3] = bf_hi(gv.y) * acc[ai][bj][m][0][3];
                    t1[0] = bf_lo(gv.z) * acc[ai][bj][m][1][0]; t1[1] = bf_hi(gv.z) * acc[ai][bj][m][1][1]; t1[2] = bf_lo(gv.w) * acc[ai][bj][m][1][2]; t1[3] = bf_hi(gv.w) * acc[ai][bj][m][1][3];
                    float* tp = tmp + (size_t)row * ldc + c;
                    if (J > 0) { t0 += *(const f32x4*)tp; t1 += *(const f32x4*)(tp + 4); }
                    if (J < 2) { *(f32x4*)tp = t0; *(f32x4*)(tp + 4) = t1; }
                    else { u32x4 w; w.x = cvt_pk_bf16(t0[0], t0[1]); w.y = cvt_pk_bf16(t0[2], t0[3]); w.z = cvt_pk_bf16(t1[0], t1[1]); w.w = cvt_pk_bf16(t1[2], t1[3]);
                        *(u32x4*)(outb + (size_t)row * ldc + c) = w; }
                }
                asm volatile("" ::: "memory");
            }
    }
};
struct EpiMerge {
    static constexpr bool PERM = true, AFTER_DRAIN = false;
    const bf16_t* gate; int ldg; const bf16_t* z0; const bf16_t* z1; bf16_t* outb; int ldc;
    __device__ __forceinline__ void operator()(const f32x4 (&acc)[2][2][4][2], const Unit& u, int wr, int wc, int fr, int fq) const {
        const int row0 = u.pm * BM + wr * 64 + fr, col0 = u.pn * BM + wc * 32 + 8 * fq;
#pragma unroll
        for (int ai = 0; ai < 2; ++ai)
#pragma unroll
            for (int m = 0; m < 4; ++m) {
                const int row = row0 + ai * HALF + m * 16;
                u32x4 g0[2], g1[2], g2[2], a0[2], a1[2];
#pragma unroll
                for (int bj = 0; bj < 2; ++bj) { const int c = col0 + bj * HALF; const bf16_t* gp = gate + (size_t)row * ldg + c;
                    g0[bj] = *(const u32x4*)gp; g1[bj] = *(const u32x4*)(gp + 2048); g2[bj] = *(const u32x4*)(gp + 4096);
                    a0[bj] = *(const u32x4*)(z0 + (size_t)row * ldc + c); a1[bj] = *(const u32x4*)(z1 + (size_t)row * ldc + c); }
#pragma unroll
                for (int bj = 0; bj < 2; ++bj) {
                    const unsigned G0[4] = {g0[bj].x, g0[bj].y, g0[bj].z, g0[bj].w}, G1[4] = {g1[bj].x, g1[bj].y, g1[bj].z, g1[bj].w}, G2[4] = {g2[bj].x, g2[bj].y, g2[bj].z, g2[bj].w};
                    const unsigned A0[4] = {a0[bj].x, a0[bj].y, a0[bj].z, a0[bj].w}, A1[4] = {a1[bj].x, a1[bj].y, a1[bj].z, a1[bj].w};
                    unsigned w[4];
#pragma unroll
                    for (int k = 0; k < 4; ++k) {
                        const float lo = bf_lo(G0[k]) * bf_lo(A0[k]) + bf_lo(G1[k]) * bf_lo(A1[k]) + bf_lo(G2[k]) * acc[ai][bj][m][k >> 1][2 * (k & 1)];
                        const float hi = bf_hi(G0[k]) * bf_hi(A0[k]) + bf_hi(G1[k]) * bf_hi(A1[k]) + bf_hi(G2[k]) * acc[ai][bj][m][k >> 1][2 * (k & 1) + 1];
                        w[k] = cvt_pk_bf16(lo, hi); }
                    *(u32x4*)(outb + (size_t)row * ldc + col0 + bj * HALF) = (u32x4){w[0], w[1], w[2], w[3]};
                }
                asm volatile("" ::: "memory");
            }
    }
};
struct EpiBf16 {
    static constexpr bool PERM = true, AFTER_DRAIN = false;
    bf16_t* C; int ldc;
    __device__ __forceinline__ void operator()(const f32x4 (&acc)[2][2][4][2], const Unit& u, int wr, int wc, int fr, int fq) const {
        const int row0 = u.pm * BM + wr * 64 + fr, col0 = u.pn * BM + wc * 32 + 8 * fq;
#pragma unroll
        for (int ai = 0; ai < 2; ++ai)
#pragma unroll
            for (int m = 0; m < 4; ++m) {
                bf16_t* rowp = C + (size_t)(row0 + ai * HALF + m * 16) * ldc + col0;
#pragma unroll
                for (int bj = 0; bj < 2; ++bj) {
                    const f32x4 v0 = acc[ai][bj][m][0] + 0.0f, v1 = acc[ai][bj][m][1] + 0.0f;
                    u32x4 w; w.x = cvt_pk_bf16(v0[0], v0[1]); w.y = cvt_pk_bf16(v0[2], v0[3]); w.z = cvt_pk_bf16(v1[0], v1[1]); w.w = cvt_pk_bf16(v1[2], v1[3]);
                    *(u32x4*)(rowp + bj * HALF) = w;
                }
            }
    }
};

template <class Epi, class Sched, bool ALIGN_EPI = false, bool SP2 = false>
__device__ __forceinline__ void gemm_phase(PG8_LAS unsigned char* lds, const Gemm g, const Sched& S, const Epi& E, const int tid) {
    const int wid = __builtin_amdgcn_readfirstlane(tid >> 6), lane = tid & 63, wr = wid >> 2, wc = wid & 3, fr = lane & 15, fq = lane >> 4;
    const int K = g.K, nt = K / BK;
    unsigned voffA[2], voffB[2];
#pragma unroll
    for (int i = 0; i < 2; ++i) { int R, C; stage_rc(tid * 16 + i * 8192, R, C); const int Rb = Epi::PERM ? ((R & ~31) + perm32(R & 31)) : R;
        voffA[i] = (unsigned)(R * g.lda + C) * 2u; voffB[i] = (unsigned)(Rb * g.ldb + C) * 2u; }
    const size_t kstep = (size_t)(BK * 2);
    const size_t hstepA = (size_t)HALF * g.lda * 2, hstepB = (size_t)HALF * g.ldb * 2;
    const size_t tstepA = 2 * hstepA, tstepB = 2 * hstepB;
    const unsigned ldsw = (unsigned)wid * 1024u;
    const int aoff = lds_byte(wr * 64 + fr, fq * 8), boff = lds_byte(wc * 32 + fr, fq * 8);
#define PG8_SA(b, h) (((b) * 2 + (h)) * HTB)
#define PG8_SB(b, h) ((4 + (b) * 2 + (h)) * HTB)
#define PG8_STAGE(bufoff, gbase, voff) do { _Pragma("unroll") for (int _i = 0; _i < 2; ++_i) \
        __builtin_amdgcn_global_load_lds((const unsigned*)((const char*)(gbase) + (voff)[_i]), (PG8_LAS unsigned*)(lds + (bufoff) + ldsw + _i * 8192), 16, 0, 0); } while (0)
#define PG8_LDA(dst, b, h) do { _Pragma("unroll") for (int m = 0; m < 4; ++m) _Pragma("unroll") for (int k = 0; k < 2; ++k) dst[m][k] = *(const PG8_LAS bf16x8*)(lds + PG8_SA(b, h) + aoff + m * 2048 + k * 1024); } while (0)
#define PG8_LDB(dst, b, h) do { _Pragma("unroll") for (int n = 0; n < 2; ++n) _Pragma("unroll") for (int k = 0; k < 2; ++k) dst[n][k] = *(const PG8_LAS bf16x8*)(lds + PG8_SB(b, h) + boff + n * 2048 + k * 1024); } while (0)
#define PG8_MMA(ai, bj, At, Bt) do { __builtin_amdgcn_s_setprio(1); _Pragma("unroll") for (int m = 0; m < 4; ++m) _Pragma("unroll") for (int n = 0; n < 2; ++n) _Pragma("unroll") for (int k = 0; k < 2; ++k) \
        acc[ai][bj][m][n] = __builtin_amdgcn_mfma_f32_16x16x32_bf16(Bt[n][k], At[m][k], acc[ai][bj][m][n], 0, 0, 0); __builtin_amdgcn_s_setprio(0); } while (0)
#define PG8_WAIT_V(n) asm volatile("s_waitcnt vmcnt(" #n ")" ::: "memory")
#define PG8_WAIT_L(n) asm volatile("s_waitcnt lgkmcnt(" #n ")" ::: "memory")
#define PG8_BAR __builtin_amdgcn_s_barrier()
#define PG8_SCHED __builtin_amdgcn_sched_barrier(0)
    Unit cur, nxt; int ui = 0;
    if (!S.next(0, cur)) return;
    f32x4 acc[2][2][4][2];
#pragma unroll
    for (int a = 0; a < 2; ++a)
#pragma unroll
        for (int b = 0; b < 2; ++b)
#pragma unroll
            for (int m = 0; m < 4; ++m)
#pragma unroll
                for (int n = 0; n < 2; ++n) acc[a][b][m][n] = (f32x4){0.f, 0.f, 0.f, 0.f};
    bf16x8 At[4][2], B0[2][2], B1[2][2];
    const char* cA = (const char*)g.A + (size_t)cur.pm * tstepA; const char* cB = (const char*)g.Bt + (size_t)cur.pn * tstepB;
    S.a_ready(cur);
    if constexpr (SP2) {
        PG8_STAGE(PG8_SB(0, 0), cB, voffB); PG8_STAGE(PG8_SB(0, 1), cB + hstepB, voffB); PG8_STAGE(PG8_SA(0, 0), cA, voffA); PG8_STAGE(PG8_SA(0, 1), cA + hstepA, voffA);
        if (wr == 1) PG8_BAR;
        PG8_WAIT_V(2); PG8_BAR;
        PG8_STAGE(PG8_SB(1, 0), cB + kstep, voffB); PG8_STAGE(PG8_SA(1, 0), cA + kstep, voffA); PG8_STAGE(PG8_SB(1, 1), cB + hstepB + kstep, voffB);
        PG8_WAIT_V(6); PG8_BAR;
    } else {
        PG8_STAGE(PG8_SB(0, 0), cB, voffB); PG8_STAGE(PG8_SA(0, 0), cA, voffA); PG8_STAGE(PG8_SB(0, 1), cB + hstepB, voffB); PG8_STAGE(PG8_SA(0, 1), cA + hstepA, voffA);
        if (wr == 1) PG8_BAR;
        PG8_WAIT_V(4); PG8_BAR;
        PG8_STAGE(PG8_SB(1, 0), cB + kstep, voffB); PG8_STAGE(PG8_SA(1, 0), cA + kstep, voffA); PG8_STAGE(PG8_SB(1, 1), cB + hstepB + kstep, voffB);
        PG8_WAIT_V(6); PG8_BAR;
    }
    for (;;) {
        const bool has_next = S.next(ui + 1, nxt);
        const char* nA = has_next ? (const char*)g.A + (size_t)nxt.pm * tstepA : cA; const char* nB = has_next ? (const char*)g.Bt + (size_t)nxt.pn * tstepB : cB;
        for (int t = 0; t < nt; t += 2) {
            const bool last = (t == nt - 2);
            const char* a1 = cA + (size_t)(t + 1) * kstep;
            const char* a2 = last ? nA : cA + (size_t)(t + 2) * kstep; const char* b2 = last ? nB : cB + (size_t)(t + 2) * kstep;
            const char* a3 = a2 + kstep; const char* b3 = b2 + kstep;
            if (last && has_next) S.a_ready(nxt);
            if constexpr (SP2) {
            PG8_LDB(B0, 0, 0); PG8_LDB(B1, 0, 1); PG8_SCHED; PG8_LDA(At, 0, 0); PG8_STAGE(PG8_SA(1, 1), a1 + hstepA, voffA);
            PG8_WAIT_V(8); PG8_WAIT_L(0); PG8_BAR; PG8_MMA(0, 0, At, B0); PG8_MMA(0, 1, At, B1); PG8_BAR; PG8_SCHED;
            PG8_LDA(At, 0, 1); PG8_STAGE(PG8_SB(0, 0), b2, voffB); PG8_STAGE(PG8_SB(0, 1), b2 + hstepB, voffB); PG8_STAGE(PG8_SA(0, 0), a2, voffA);
            PG8_WAIT_V(8); PG8_WAIT_L(0); PG8_BAR; PG8_MMA(1, 0, At, B0); PG8_MMA(1, 1, At, B1); PG8_BAR; PG8_SCHED;
            PG8_LDB(B0, 1, 0); PG8_LDB(B1, 1, 1); PG8_SCHED; PG8_LDA(At, 1, 0); PG8_STAGE(PG8_SA(0, 1), a2 + hstepA, voffA);
            PG8_WAIT_V(8); PG8_WAIT_L(0); PG8_BAR; PG8_MMA(0, 0, At, B0); PG8_MMA(0, 1, At, B1); PG8_BAR; PG8_SCHED;
            PG8_LDA(At, 1, 1); PG8_STAGE(PG8_SB(1, 0), b3, voffB); PG8_STAGE(PG8_SB(1, 1), b3 + hstepB, voffB); PG8_STAGE(PG8_SA(1, 0), a3, voffA);
            PG8_WAIT_V(8); PG8_WAIT_L(0); PG8_BAR; PG8_MMA(1, 0, At, B0); PG8_MMA(1, 1, At, B1); PG8_BAR; PG8_SCHED;
            } else {
            PG8_LDB(B0, 0, 0); PG8_SCHED; PG8_LDA(At, 0, 0); PG8_STAGE(PG8_SA(1, 1), a1 + hstepA, voffA);
            PG8_WAIT_L(8); PG8_BAR; PG8_WAIT_L(0); PG8_MMA(0, 0, At, B0); PG8_BAR; PG8_SCHED;
            PG8_LDB(B1, 0, 1); PG8_STAGE(PG8_SB(0, 0), b2, voffB);
            PG8_BAR; PG8_WAIT_L(0); PG8_MMA(0, 1, At, B1); PG8_BAR;
            PG8_LDA(At, 0, 1); PG8_STAGE(PG8_SA(0, 0), a2, voffA);
            PG8_BAR; PG8_WAIT_L(0); PG8_MMA(1, 0, At, B0); PG8_BAR; PG8_SCHED;
            PG8_STAGE(PG8_SB(0, 1), b2 + hstepB, voffB);
            PG8_WAIT_V(6); PG8_BAR; PG8_MMA(1, 1, At, B1); PG8_BAR;
            PG8_LDB(B0, 1, 0); PG8_SCHED; PG8_LDA(At, 1, 0); PG8_STAGE(PG8_SA(0, 1), a2 + hstepA, voffA);
            PG8_WAIT_L(8); PG8_BAR; PG8_WAIT_L(0); PG8_MMA(0, 0, At, B0); PG8_BAR; PG8_SCHED;
            PG8_LDB(B1, 1, 1); PG8_STAGE(PG8_SB(1, 0), b3, voffB);
            PG8_BAR; PG8_WAIT_L(0); PG8_MMA(0, 1, At, B1); PG8_BAR;
            PG8_LDA(At, 1, 1); PG8_STAGE(PG8_SA(1, 0), a3, voffA);
            PG8_BAR; PG8_WAIT_L(0); PG8_MMA(1, 0, At, B0); PG8_BAR; PG8_SCHED;
            PG8_STAGE(PG8_SB(1, 1), b3 + hstepB, voffB);
            PG8_WAIT_V(6); PG8_BAR; PG8_MMA(1, 1, At, B1); PG8_BAR;
            }
        }
        if constexpr (ALIGN_EPI) { if (wr == 0) PG8_BAR; }
        if constexpr (!Epi::AFTER_DRAIN) { E(acc, cur, wr, wc, fr, fq); S.done(cur); }
        if (!has_next) break;
#pragma unroll
        for (int a = 0; a < 2; ++a)
#pragma unroll
            for (int b = 0; b < 2; ++b)
#pragma unroll
                for (int m = 0; m < 4; ++m)
#pragma unroll
                    for (int n = 0; n < 2; ++n) acc[a][b][m][n] = (f32x4){0.f, 0.f, 0.f, 0.f};
        cur = nxt; cA = nA; cB = nB; ++ui;
        if constexpr (ALIGN_EPI) { if (wr == 1) PG8_BAR; }
    }
    PG8_WAIT_V(0);
    if constexpr (!ALIGN_EPI) { if (wr == 0) PG8_BAR; }
    PG8_BAR;
    if constexpr (Epi::AFTER_DRAIN) { E.fused(acc, cur, wr, wc, fr, fq, lds, wid, lane); S.done(cur); }
#undef PG8_SA
#undef PG8_SB
#undef PG8_STAGE
#undef PG8_LDA
#undef PG8_LDB
#undef PG8_MMA
#undef PG8_WAIT_V
#undef PG8_WAIT_L
#undef PG8_BAR
#undef PG8_SCHED
}
}

constexpr int BATCH = 2, SEQ = 8192, M = BATCH * SEQ, DM = 2048, DFF = 5504, NMEM = 256, DEPTH = 2;
constexpr int DIN = 11076, DIN_PAD = 11264, PLD = 11008;
constexpr int C_QA = 0, C_KA = 1024, C_VA = 1280, C_QI = 1536, C_XL = 1792, C_GL = 2816, C_QM = 3840, C_GT = 4864;
constexpr float EPS = 1e-6f, LOG2E = 1.4426950408889634f;

constexpr size_t MiB = 1u << 20;
constexpr size_t WS_CTL = 0, CTL_ZERO_BYTES = 1 * MiB;
constexpr size_t WS_WGU = 2 * MiB, WS_WDN = 45 * MiB, WS_WIN = 67 * MiB, WS_WMKV = 111 * MiB, WS_WBR = 119 * MiB, WS_WOUT = 131 * MiB;
constexpr size_t WS_WGU2 = 139 * MiB, WS_WDN2 = 182 * MiB, WS_WAT = 204 * MiB, WS_WIT = 204 * MiB + 512 * 1024;
constexpr size_t WS_XN = 206 * MiB, WS_R1 = 270 * MiB, WS_SCR = 614 * MiB, WS_SIDE = 742 * MiB, WS_KIDX = 747 * MiB, WS_WIDX = 749 * MiB;
constexpr size_t WS_MASK = 750 * MiB, WS_VT = 766 * MiB, WS_MK = 774 * MiB, WS_VTM = 775 * MiB, WS_MEMN = 776 * MiB, WS_AGG = 778 * MiB, WS_END = 780 * MiB;
constexpr int CW_BAR = 4096;

constexpr int LDS_BYTES = 163840, MISC_OFF = LDS_BYTES - 256;

#define LAS __attribute__((address_space(3)))
typedef unsigned short bf16;
typedef short bf16x8 __attribute__((ext_vector_type(8)));
typedef float f32x4 __attribute__((ext_vector_type(4)));
typedef float f32x16 __attribute__((ext_vector_type(16)));
typedef unsigned u32x4 __attribute__((ext_vector_type(4)));
typedef unsigned u32x2 __attribute__((ext_vector_type(2)));
#define LDS_WAIT() asm volatile("s_waitcnt lgkmcnt(0)" ::: "memory")
#define VM_WAIT() asm volatile("s_waitcnt vmcnt(0)" ::: "memory")
__device__ __forceinline__ unsigned f2bf(float f) { unsigned u = __builtin_bit_cast(unsigned, f); return (u + 0x7fffu + ((u >> 16) & 1u)) >> 16; }
__device__ __forceinline__ unsigned pk2(float lo, float hi) { return f2bf(lo) | (f2bf(hi) << 16); }
__device__ __forceinline__ unsigned pkbf(float lo, float hi) { unsigned r; asm("v_cvt_pk_bf16_f32 %0, %1, %2" : "=v"(r) : "v"(lo), "v"(hi)); return r; }
__device__ __forceinline__ float bflo(unsigned w) { return __uint_as_float(w << 16); }
__device__ __forceinline__ float bfhi(unsigned w) { return __uint_as_float(w & 0xffff0000u); }

#define XB_TMO      128
#define XB_XCNT(j)  (256  + 64 * (j))
#define XB_XSUB(j)  (1280 + 64 * (j))
#define XB_XGEN(j)  (2304 + 64 * (j))
#define XB_TOP      3328
#define XB_TOPGEN   3392
#define XCD_BAR_WORDS 3456
#define XB_SPIN_CAP (1u << 18)

__device__ __forceinline__ unsigned xb_ld(unsigned* p)              { return __hip_atomic_load(p, __ATOMIC_RELAXED, __HIP_MEMORY_SCOPE_AGENT); }
__device__ __forceinline__ unsigned xb_add(unsigned* p, unsigned v) { return __hip_atomic_fetch_add(p, v, __ATOMIC_RELAXED, __HIP_MEMORY_SCOPE_AGENT); }
__device__ __forceinline__ unsigned xb_xcc_id() { return (unsigned)__builtin_amdgcn_s_getreg((3 << 11) | 20) & 0xFu; }
#define XB_SPIN(cond, bar) do { unsigned _sp = 0; while (cond) { __builtin_amdgcn_s_sleep(1); \
    if ((++_sp & 255u) == 0u) { if (xb_ld(&(bar)[XB_TMO])) break; if (_sp > XB_SPIN_CAP) { atomicAdd(&(bar)[XB_TMO], 1u); break; } } } } while (0)

struct XcdBarrier {
    unsigned* bar; unsigned x;
    volatile LAS unsigned* st;
};
__device__ __forceinline__ XcdBarrier xcd_barrier_post(unsigned* bar, volatile LAS unsigned* st) {
    XcdBarrier b; b.bar = bar; b.x = xb_xcc_id(); b.st = st;
    if (threadIdx.x == 0) (void)xb_add(&bar[XB_XCNT(b.x)], 1u);
    return b;
}
__device__ __forceinline__ void xcd_barrier_complete(unsigned* bar, unsigned x, unsigned& nloc, unsigned& nx) {
    const unsigned G = gridDim.x * gridDim.y * gridDim.z;
    unsigned sum, cnt, mine, sp = 0u;
    for (;;) {
        sum = 0u; cnt = 0u; mine = 0u;
#pragma unroll
        for (unsigned j = 0; j < 16; ++j) { const unsigned c = xb_ld(&bar[XB_XCNT(j)]); sum += c; cnt += (c > 0u) ? 1u : 0u; mine = (j == x) ? c : mine; }
        if (sum == G) break;
        __builtin_amdgcn_s_sleep(1);
        if ((++sp & 255u) == 0u) { if (xb_ld(&bar[XB_TMO])) break; if (sp > XB_SPIN_CAP) { atomicAdd(&bar[XB_TMO], 1u); break; } }
    }
    nloc = mine > 0u ? mine : 1u; nx = cnt > 0u ? cnt : 1u;
}
__device__ __forceinline__ void xcd_barrier(const XcdBarrier& b) {
    asm volatile("s_waitcnt vmcnt(0)" ::: "memory");
    __syncthreads();
    if (threadIdx.x == 0) {
        unsigned* bar = b.bar;
        __builtin_amdgcn_s_waitcnt(0);
        unsigned nloc = b.st[0], nx = b.st[1];
        if (nloc == 0u) { xcd_barrier_complete(bar, b.x, nloc, nx); b.st[0] = nloc; b.st[1] = nx; }
        const unsigned old = xb_add(&bar[XB_XSUB(b.x)], 1u);
        const unsigned gen = old / nloc;
        if (old + 1u == (gen + 1u) * nloc) {
            __builtin_amdgcn_fence(__ATOMIC_RELEASE, "agent");
            asm volatile("s_waitcnt vmcnt(0)" ::: "memory");
            const unsigned og = xb_add(&bar[XB_TOP], 1u);
            const unsigned tg = og / nx;
            if (og + 1u == (tg + 1u) * nx) xb_add(&bar[XB_TOPGEN], 1u);
            else XB_SPIN(xb_ld(&bar[XB_TOPGEN]) == tg, bar);
            __builtin_amdgcn_fence(__ATOMIC_ACQUIRE, "agent");
            xb_add(&bar[XB_XGEN(b.x)], 1u);
            asm volatile("s_waitcnt vmcnt(0)" ::: "memory");
        } else {
            XB_SPIN(xb_ld(&bar[XB_XGEN(b.x)]) == gen, bar);
            __builtin_amdgcn_fence(__ATOMIC_ACQUIRE, "agent");
            asm volatile("s_waitcnt vmcnt(0)" ::: "memory");
        }
    }
    __syncthreads();
}

#define GAS __attribute__((address_space(1)))
struct Params { const GAS float* in[25]; GAS float* out; GAS unsigned char* ws; };
typedef const Params __attribute__((address_space(4)))* KP;
__device__ __forceinline__ KP kargs() { KP k = (KP)__builtin_amdgcn_kernarg_segment_ptr(); asm volatile("" : "+s"(k)); return k; }
__device__ __forceinline__ const float* gin(KP k, int i) { return (const float*)k->in[i]; }
__device__ __forceinline__ float* gout(KP k) { return (float*)k->out; }
__device__ __forceinline__ unsigned char* gws(KP k) { return (unsigned char*)k->ws; }
__device__ __forceinline__ int lane_id_asm() { int l; asm volatile("v_mbcnt_lo_u32_b32 %0, -1, 0\n\tv_mbcnt_hi_u32_b32 %0, -1, %0" : "=v"(l)); return l; }
__device__ __forceinline__ int launder_s(int v) { asm volatile("" : "+s"(v)); return v; }
__device__ __forceinline__ int launder_v(int v) { asm volatile("" : "+v"(v)); return v; }
enum { I_X = 0, I_MEM, I_RELB, I_FNORM, I_NFF1, I_WGU1, I_WDN1, I_NMIX, I_WIN, I_CONVW, I_CONVB, I_WA, I_BA, I_WI, I_BI, I_LAM, I_LNG, I_LNB, I_MEMNORM, I_WMKV, I_WBR, I_WOUT, I_NFF2, I_WGU2, I_WDN2 };

__device__ __forceinline__ float wave_sum(float v) {
#pragma unroll
    for (int o = 1; o < 64; o <<= 1) v += __shfl_xor(v, o);
    return v;
}
__device__ __forceinline__ f32x4 mfma16(bf16x8 a, bf16x8 b, f32x4 c) { return __builtin_amdgcn_mfma_f32_16x16x32_bf16(a, b, c, 0, 0, 0); }
__device__ __forceinline__ f32x16 mfma32(bf16x8 a, bf16x8 b, f32x16 c) { return __builtin_amdgcn_mfma_f32_32x32x16_bf16(a, b, c, 0, 0, 0); }

__device__ __forceinline__ void tr_item(const float* W, int ldw, int scol0, int nvalid, bf16* WT, int ldt, int drow0, int k0, LAS float* scr, int lane) {
    if (nvalid == 32) {
#pragma unroll
        for (int i = 0; i < 8; ++i) { const int kk = 8 * i + (lane >> 3), c4 = (lane & 7) * 4;
            const f32x4 v = *(const f32x4*)(W + (size_t)(k0 + kk) * ldw + scol0 + c4);
            LAS float* d = scr + kk * 33 + c4; d[0] = v.x; d[1] = v.y; d[2] = v.z; d[3] = v.w; }
    } else {
#pragma unroll 8
        for (int i = 0; i < 32; ++i) { const int kk = 2 * i + (lane >> 5), c = lane & 31; scr[kk * 33 + c] = (c < nvalid) ? W[(size_t)(k0 + kk) * ldw + scol0 + c] : 0.f; }
    }
    LDS_WAIT(); asm volatile("" ::: "memory");
    const int c = lane & 7;
#pragma unroll
    for (int j = 0; j < 4; ++j) { const int n = (lane >> 3) + 8 * j; const LAS float* s = scr + (8 * c) * 33 + n;
        u32x4 o; o.x = pkbf(s[0 * 33], s[1 * 33]); o.y = pkbf(s[2 * 33], s[3 * 33]); o.z = pkbf(s[4 * 33], s[5 * 33]); o.w = pkbf(s[6 * 33], s[7 * 33]);
        *(u32x4*)(WT + (size_t)(drow0 + n) * ldt + k0 + 8 * c) = o; }
    LDS_WAIT(); asm volatile("" ::: "memory");
}
__device__ __forceinline__ void tr_plain(const float* W, int K, int N, bf16* WT, int item, LAS float* scr, int lane) {
    const int nblk = N / 32, kb = item / nblk, nb = item % nblk;
    tr_item(W, N, 32 * nb, 32, WT, K, 32 * nb, 64 * kb, scr, lane);
}
__device__ __forceinline__ void tr_gu(const float* W, bf16* WT, int item, LAS float* scr, int lane) {
    const int nblk = 2 * DFF / 32, kb = item / nblk, nb = item % nblk, n0 = 32 * nb, T = n0 >> 8, wi = n0 & 255;
    const int sc = wi < 128 ? 128 * T + wi : DFF + 128 * T + (wi - 128);
    tr_item(W, 2 * DFF, sc, 32, WT, DM, n0, 64 * kb, scr, lane);
}
__device__ __forceinline__ void tr_win(const float* W, bf16* WT, int item, LAS float* scr, int lane) {
    const int nblk = DIN_PAD / 32, kb = item / nblk, nb = item % nblk, n0 = 32 * nb;
    int sc, nv;
    if (n0 < 1792) { sc = n0; nv = 32; }
    else if (n0 < 2048) { const int off = n0 - 1792; sc = 1792 + off; nv = 68 - off; nv = nv < 0 ? 0 : (nv > 32 ? 32 : nv); if (nv == 0) sc = 0; }
    else { sc = n0 - 188; nv = 32; }
    tr_item(W, DIN, sc, nv, WT, DM, n0, 64 * kb, scr, lane);
}

__device__ __forceinline__ void rms_row_bf16(const float* xrow, const float* g, bf16* orow, int lane) {
    const f32x4* xr = (const f32x4*)xrow + lane; const f32x4* gr = (const f32x4*)g + lane;
    f32x4 v[8]; float s = 0.f;
#pragma unroll
    for (int j = 0; j < 8; ++j) { v[j] = xr[64 * j]; s += (v[j].x * v[j].x + v[j].y * v[j].y) + (v[j].z * v[j].z + v[j].w * v[j].w); }
    const float rstd = 1.0f / sqrtf(wave_sum(s) * (1.0f / DM) + EPS);
    u32x2* o8 = (u32x2*)orow + lane;
#pragma unroll
    for (int j = 0; j < 8; ++j) { const f32x4 gg = gr[64 * j]; u32x2 w; w.x = pk2(v[j].x * rstd * gg.x, v[j].y * rstd * gg.y); w.y = pk2(v[j].z * rstd * gg.z, v[j].w * rstd * gg.w); o8[64 * j] = w; }
}
__device__ __forceinline__ void rms_rows_bf16(const float* x, const float* g, bf16* out, int gw, int NGW, int lane) {
    const f32x4* gr = (const f32x4*)g + lane;
    f32x4 gg[8];
#pragma unroll
    for (int j = 0; j < 8; ++j) gg[j] = gr[64 * j];
    for (int m = gw; m < M; m += 4 * NGW) {
        f32x4 v[4][8]; float ss[4];
#pragma unroll
        for (int r = 0; r < 4; ++r) { const int mr = (m + r * NGW < M) ? m + r * NGW : m; const f32x4* xr = (const f32x4*)(x + (size_t)mr * DM) + lane;
#pragma unroll
            for (int j = 0; j < 8; ++j) v[r][j] = xr[64 * j]; }
#pragma unroll
        for (int r = 0; r < 4; ++r) { float s = 0.f;
#pragma unroll
            for (int j = 0; j < 8; ++j) s += (v[r][j].x * v[r][j].x + v[r][j].y * v[r][j].y) + (v[r][j].z * v[r][j].z + v[r][j].w * v[r][j].w);
            ss[r] = 1.0f / sqrtf(wave_sum(s) * (1.0f / DM) + EPS); }
#pragma unroll
        for (int r = 0; r < 4; ++r) if (m + r * NGW < M) { u32x2* o = (u32x2*)(out + (size_t)(m + r * NGW) * DM) + lane;
#pragma unroll
            for (int j = 0; j < 8; ++j) { u32x2 w; w.x = pkbf(v[r][j].x * ss[r] * gg[j].x, v[r][j].y * ss[r] * gg[j].y); w.y = pkbf(v[r][j].z * ss[r] * gg[j].z, v[r][j].w * ss[r] * gg[j].w); o[64 * j] = w; } }
    }
}
__device__ __forceinline__ void rms_row_f32(const float* xrow, const float* g, float* orow, int lane) {
    const f32x4* xr = (const f32x4*)xrow + lane; const f32x4* gr = (const f32x4*)g + lane;
    f32x4 v[8]; float s = 0.f;
#pragma unroll
    for (int j = 0; j < 8; ++j) { v[j] = xr[64 * j]; s += (v[j].x * v[j].x + v[j].y * v[j].y) + (v[j].z * v[j].z + v[j].w * v[j].w); }
    const float rstd = 1.0f / sqrtf(wave_sum(s) * (1.0f / DM) + EPS);
    f32x4* o = (f32x4*)orow + lane;
#pragma unroll
    for (int j = 0; j < 8; ++j) { const f32x4 gg = gr[64 * j]; o[64 * j] = v[j] * rstd * gg; }
}

template <class SC> __device__ __forceinline__ void tr_wg_item(const float* W, int ldw, SC scol, bf16* WT, int ldt, int drow0, int k0, LAS unsigned char* ldsb, int tid, int lane, int wave) {
    LAS float* tile = (LAS float*)ldsb;
    const int run = lane >> 3, c4 = (lane & 7) * 4;
    int sc, nv; scol(run, sc, nv);
    f32x4 v[16];
#pragma unroll
    for (int i = 0; i < 16; ++i) { const int kk = wave * 16 + i;
        v[i] = (f32x4){0.f, 0.f, 0.f, 0.f};
        if (nv == 32) v[i] = *(const f32x4*)(W + (size_t)(k0 + kk) * ldw + sc + c4);
        else { const float* src = W + (size_t)(k0 + kk) * ldw + sc; if (c4 + 0 < nv) v[i].x = src[c4]; if (c4 + 1 < nv) v[i].y = src[c4 + 1]; if (c4 + 2 < nv) v[i].z = src[c4 + 2]; if (c4 + 3 < nv) v[i].w = src[c4 + 3]; } }
#pragma unroll
    for (int i = 0; i < 16; ++i) { LAS float* o = tile + (wave * 16 + i) * 257 + run * 32 + c4; o[0] = v[i].x; o[1] = v[i].y; o[2] = v[i].z; o[3] = v[i].w; }
    __syncthreads();
    const int c = lane & 15;
#pragma unroll
    for (int j = 0; j < 8; ++j) { const int n = wave * 32 + (lane >> 4) + 4 * j; const LAS float* s = tile + (8 * c) * 257 + n;
        u32x4 o; o.x = pkbf(s[0 * 257], s[1 * 257]); o.y = pkbf(s[2 * 257], s[3 * 257]); o.z = pkbf(s[4 * 257], s[5 * 257]); o.w = pkbf(s[6 * 257], s[7 * 257]);
        *(u32x4*)(WT + (size_t)(drow0 + n) * ldt + k0 + 8 * c) = o; }
    __syncthreads();
}
struct ScPlain { int n0; __device__ __forceinline__ void operator()(int run, int& sc, int& nv) const { sc = n0 + 32 * run; nv = 32; } };
struct ScGu { int T; __device__ __forceinline__ void operator()(int run, int& sc, int& nv) const { sc = run < 4 ? 128 * T + 32 * run : DFF + 128 * T + 32 * (run - 4); nv = 32; } };
struct ScWin { int n0; __device__ __forceinline__ void operator()(int run, int& sc, int& nv) const { const int r0 = n0 + 32 * run;
    if (r0 < 1792) { sc = r0; nv = 32; } else if (r0 < 2048) { const int off = r0 - 1792; sc = 1792 + off; nv = 68 - off; nv = nv < 0 ? 0 : (nv > 32 ? 32 : nv); if (nv == 0) sc = 0; } else { sc = r0 - 188; nv = 32; } } };
__device__ __forceinline__ void phase_cvt(KP p, int l, LAS unsigned char* lds, int vcu_, int G, int gw, int NGW, int wave, int lane_) {
    const int vcu = launder_s(vcu_), lane = launder_v(lane_), tid = wave * 64 + lane;
    unsigned char* ws = gws(p);
    constexpr int J_GU = (DM / 128) * (2 * DFF / 256), J_DN = (DFF / 128) * (DM / 256), J_IN = (DM / 128) * (DIN_PAD / 256), J_SQ = (DM / 128) * (DM / 256), J_BR = (1024 / 128) * (DM / 256);
    constexpr int NJ = 2 * J_GU + 2 * J_DN + J_IN + 2 * J_SQ + 3 * J_BR;
    for (int it = vcu; it < NJ; it += G) {
        int r = it;
        if (r < 2 * J_GU) { const bool sec = r >= J_GU; r -= sec ? J_GU : 0; const int nb = r % (2 * DFF / 256), kb = r / (2 * DFF / 256);
            tr_wg_item(gin(p, sec ? I_WGU2 : I_WGU1) + (size_t)l * DM * 2 * DFF, 2 * DFF, ScGu{nb}, (bf16*)(ws + (sec ? WS_WGU2 : WS_WGU)), DM, 256 * nb, 128 * kb, lds, tid, lane, wave); continue; }
        r -= 2 * J_GU;
        if (r < 2 * J_DN) { const bool sec = r >= J_DN; r -= sec ? J_DN : 0; const int nb = r % (DM / 256), kb = r / (DM / 256);
            tr_wg_item(gin(p, sec ? I_WDN2 : I_WDN1) + (size_t)l * DFF * DM, DM, ScPlain{256 * nb}, (bf16*)(ws + (sec ? WS_WDN2 : WS_WDN)), DFF, 256 * nb, 128 * kb, lds, tid, lane, wave); continue; }
        r -= 2 * J_DN;
        if (r < J_IN) { const int nb = r % (DIN_PAD / 256), kb = r / (DIN_PAD / 256);
            tr_wg_item(gin(p, I_WIN) + (size_t)l * DM * DIN, DIN, ScWin{256 * nb}, (bf16*)(ws + WS_WIN), DM, 256 * nb, 128 * kb, lds, tid, lane, wave); continue; }
        r -= J_IN;
        if (r < 2 * J_SQ) { const bool sec = r >= J_SQ; r -= sec ? J_SQ : 0; const int nb = r % (DM / 256), kb = r / (DM / 256);
            tr_wg_item(gin(p, sec ? I_WOUT : I_WMKV) + (size_t)l * DM * DM, DM, ScPlain{256 * nb}, (bf16*)(ws + (sec ? WS_WOUT : WS_WMKV)), DM, 256 * nb, 128 * kb, lds, tid, lane, wave); continue; }
        r -= 2 * J_SQ;
        { const int j = r / J_BR, rr = r % J_BR, nb = rr % (DM / 256), kb = rr / (DM / 256);
          tr_wg_item(gin(p, I_WBR) + ((size_t)l * 3 + j) * 1024 * DM, DM, ScPlain{256 * nb}, (bf16*)(ws + WS_WBR) + (size_t)j * DM * 1024, 1024, 256 * nb, 128 * kb, lds, tid, lane, wave); }
    }
    { __syncthreads(); LAS float* scr = (LAS float*)(lds + wave * 8704);
      for (int it = gw; it < 16 * 8; it += NGW) { const int mtx = it >> 3, n = mtx & 7; const bool isI = mtx >= 8;
          tr_plain(gin(p, isI ? I_WI : I_WA) + ((size_t)l * 8 + n) * 128 * 128, 128, 128, (bf16*)(ws + (isI ? WS_WIT : WS_WAT)) + (size_t)n * 128 * 128, it & 7, scr, lane); } }
    for (int m = gw; m < BATCH * NMEM; m += NGW) rms_row_bf16(gin(p, I_MEM) + (size_t)m * DM, gin(p, I_MEMNORM) + (size_t)l * DM, (bf16*)(ws + WS_MEMN) + (size_t)m * DM, lane);
}

__device__ __forceinline__ float row_bcast15(float v) { return __builtin_bit_cast(float, __builtin_amdgcn_update_dpp(0, __builtin_bit_cast(int, v), 0x15F, 0xF, 0xF, false)); }
__device__ __forceinline__ float xmax32(float v) { auto rr = __builtin_amdgcn_permlane32_swap(__float_as_uint(v), __float_as_uint(v), false, false); return fmaxf(__uint_as_float(rr[0]), __uint_as_float(rr[1])); }
__device__ __forceinline__ float xadd32(float v) { auto rr = __builtin_amdgcn_permlane32_swap(__float_as_uint(v), __float_as_uint(v), false, false); return __uint_as_float(rr[0]) + __uint_as_float(rr[1]); }
__device__ __forceinline__ unsigned xor32_or(unsigned v) { auto rr = __builtin_amdgcn_permlane32_swap(v, v, false, false); return rr[0] | rr[1]; }
__device__ __forceinline__ unsigned xor16_or(unsigned v) { auto rr = __builtin_amdgcn_permlane16_swap(v, v, false, false); return rr[0] | rr[1]; }
template <int N> __device__ __forceinline__ float dpp_shr(float v, float ident) {
    return __builtin_bit_cast(float, __builtin_amdgcn_update_dpp(__builtin_bit_cast(int, ident), __builtin_bit_cast(int, v), 0x110 + N, 0xF, 0xF, false));
}
__device__ __forceinline__ float fsig(float x) { return __builtin_amdgcn_rcpf(1.0f + __builtin_amdgcn_exp2f(-LOG2E * x)); }
__device__ __forceinline__ float gelu_tanh(float x) {
    const float z = 0.7978845608028654f * (x + 0.044715f * x * x * x);
    const float e = __builtin_amdgcn_exp2f(2.0f * LOG2E * z);
    const float t = 1.0f - 2.0f * __builtin_amdgcn_rcpf(e + 1.0f);
    return 0.5f * x * (1.0f + t);
}

__device__ __forceinline__ void kidx_ln_quarter(KP p, int l, int gt) {
    const int row = gt >> 2, q = gt & 3;
    const float* s = (const float*)(gws(p) + WS_SIDE) + (size_t)row * 72 + 16 * q;
    const float* g = gin(p, I_LNG) + l * 64 + 16 * q; const float* be = gin(p, I_LNB) + l * 64 + 16 * q;
    f32x4 v[4]; float mu = 0.f;
#pragma unroll
    for (int i = 0; i < 4; ++i) { v[i] = *(const f32x4*)(s + 4 * i); mu += (v[i].x + v[i].y) + (v[i].z + v[i].w); }
    mu += __shfl_xor(mu, 1); mu += __shfl_xor(mu, 2); mu *= (1.0f / 64.0f);
    float var = 0.f;
#pragma unroll
    for (int i = 0; i < 4; ++i) { v[i] = v[i] - mu; var += (v[i].x * v[i].x + v[i].y * v[i].y) + (v[i].z * v[i].z + v[i].w * v[i].w); }
    var += __shfl_xor(var, 1); var += __shfl_xor(var, 2);
    const float rstd = 1.0f / sqrtf(var * (1.0f / 64.0f) + EPS);
    bf16* o = (bf16*)(gws(p) + WS_KIDX) + (size_t)row * 64 + 16 * q;
    unsigned w[8];
#pragma unroll
    for (int i = 0; i < 4; ++i) { const f32x4 gg = *(const f32x4*)(g + 4 * i), bb = *(const f32x4*)(be + 4 * i);
        w[2 * i] = pk2(v[i].x * rstd * gg.x + bb.x, v[i].y * rstd * gg.y + bb.y); w[2 * i + 1] = pk2(v[i].z * rstd * gg.z + bb.z, v[i].w * rstd * gg.w + bb.w); }
    *(u32x4*)o = (u32x4){w[0], w[1], w[2], w[3]}; *(u32x4*)(o + 8) = (u32x4){w[4], w[5], w[6], w[7]};
    if (q == 0) { const f32x4 wv = *(const f32x4*)(s + 64); *(f32x4*)((float*)(gws(p) + WS_WIDX) + (size_t)row * 4) = wv * 0.0625f; }
}

__device__ __forceinline__ void vt_item(KP p, int item, LAS unsigned char* scrb, int lane) {
    const int db = item & 1, tb = (item >> 1) & 127, kvh = (item >> 8) & 1, b = item >> 9;
    const bf16* P = (const bf16*)(gws(p) + WS_R1);
    LAS unsigned short* scr = (LAS unsigned short*)scrb;
#pragma unroll
    for (int i = 0; i < 8; ++i) {
        const int t = 8 * i + (lane >> 3), ch = lane & 7;
        const u32x4 v = *(const u32x4*)(P + (size_t)(b * SEQ + tb * 64 + t) * PLD + C_VA + kvh * 128 + db * 64 + 8 * ch);
        const unsigned w[4] = {v.x, v.y, v.z, v.w};
#pragma unroll
        for (int j = 0; j < 4; ++j) { scr[(8 * ch + 2 * j) * 66 + t] = (unsigned short)(w[j] & 0xffff); scr[(8 * ch + 2 * j + 1) * 66 + t] = (unsigned short)(w[j] >> 16); }
    }
    LDS_WAIT(); asm volatile("" ::: "memory");
    bf16* VT = (bf16*)(gws(p) + WS_VT);
#pragma unroll
    for (int i = 0; i < 8; ++i) {
        const int d = 8 * i + (lane >> 3), ch = lane & 7;
        const LAS unsigned* s = (const LAS unsigned*)(scr + d * 66 + 8 * ch);
        u32x4 o; o.x = s[0]; o.y = s[1]; o.z = s[2]; o.w = s[3];
        *(u32x4*)(VT + (((size_t)((b * 2 + kvh) * 128 + tb)) * 128 + db * 64 + d) * 64 + 8 * ch) = o;
    }
    LDS_WAIT(); asm volatile("" ::: "memory");
}

constexpr int LR_WA = 0, LR_WI = 34816, LR_PAR = 69632, LR_CARRY = LR_PAR + 9 * 512, LR_COMP = LR_CARRY + 512, LR_FOLD = LR_COMP + 8192;
template <int MODE> __device__ __forceinline__ void lru_job(KP p, int l, int jb, LAS unsigned char* lds, int tid, int lane, int wave, bf16* OB, int old) {
    const int n = jb & 7, jj = jb >> 3, b = jj >> 4, tile0 = 4 * (jj & 15), tok = lane & 15, h = lane >> 4;
    const bf16* P = (const bf16*)(gws(p) + WS_R1);
    float* aggA = (float*)(gws(p) + WS_AGG); float* aggH = aggA + (size_t)BATCH * 64 * 1024;
    LAS float* par = (LAS float*)(lds + LR_PAR);
    LAS float* carry = (LAS float*)(lds + LR_CARRY);
    LAS float* compA = (LAS float*)(lds + LR_COMP); LAS float* compH = compA + 1024;
    __syncthreads();
    {
        const bf16* waT = (const bf16*)(gws(p) + WS_WAT) + (size_t)n * 128 * 128; const bf16* wiT = (const bf16*)(gws(p) + WS_WIT) + (size_t)n * 128 * 128;
#pragma unroll
        for (int i = 0; i < 4; ++i) { const int ci = tid + 512 * i, r = ci >> 4, ch = ci & 15;
            *(LAS u32x4*)(lds + LR_WA + r * 272 + ch * 16) = *(const u32x4*)(waT + r * 128 + ch * 8);
            *(LAS u32x4*)(lds + LR_WI + r * 272 + ch * 16) = *(const u32x4*)(wiT + r * 128 + ch * 8); }
        if (tid < 128) { const int c = n * 128 + tid;
            par[tid] = -8.0f * LOG2E * log1pf(expf(-gin(p, I_LAM)[(size_t)l * 1024 + c]));
            par[128 + tid] = gin(p, I_BA)[(size_t)l * 1024 + c]; par[256 + tid] = gin(p, I_BI)[(size_t)l * 1024 + c]; par[384 + tid] = gin(p, I_CONVB)[(size_t)l * 1024 + c];
#pragma unroll
            for (int j = 0; j < 4; ++j) par[512 + 128 * j + tid] = gin(p, I_CONVW)[((size_t)l * 4 + j) * 1024 + c]; }
        if (MODE == 1) {
            const int ch = tid & 127, part = tid >> 7, q = tile0 >> 2;
            float ca = 1.f, chh = 0.f;
            const float* pa = aggA + ((size_t)b * 64 + part * q) * 1024 + n * 128 + ch; const float* ph = aggH + ((size_t)b * 64 + part * q) * 1024 + n * 128 + ch;
            for (int i = 0; i < q; ++i) { const float a = pa[(size_t)i * 1024], hh = ph[(size_t)i * 1024]; chh = a * chh + hh; ca *= a; }
            LAS float* fold = (LAS float*)(lds + LR_FOLD);
            fold[(part * 128 + ch) * 2] = ca; fold[(part * 128 + ch) * 2 + 1] = chh;
        }
        __syncthreads();
        if (MODE == 1 && tid < 128) { const LAS float* fold = (const LAS float*)(lds + LR_FOLD); float c = 0.f;
#pragma unroll
            for (int part = 0; part < 4; ++part) c = fold[(part * 128 + tid) * 2] * c + fold[(part * 128 + tid) * 2 + 1];
            carry[tid] = c; }
        if (MODE == 1) __syncthreads();
    }
#pragma unroll 1
    for (int tt = 0; tt < 4; ++tt) {
        const int tile = tile0 + tt, t = tile * 128 + wave * 16 + tok; const size_t row = (size_t)b * SEQ + t;
        const int hofs = launder_v(4 * h);
        float xc[4][2][4]; bf16x8 xb[4];
#pragma unroll
        for (int ks = 0; ks < 4; ++ks) {
#pragma unroll
            for (int hf = 0; hf < 2; ++hf) {
                const int cl = 32 * ks + 16 * hf + hofs;
                f32x4 a = *(const LAS f32x4*)(par + 384 + cl);
#pragma unroll
                for (int j = 0; j < 4; ++j) {
                    if (t - 3 + j >= 0) {
                        const u32x2 xv = *(const u32x2*)(P + (row - 3 + j) * PLD + C_XL + n * 128 + cl);
                        const f32x4 cw = *(const LAS f32x4*)(par + 512 + 128 * j + cl);
                        a.x += cw.x * bflo(xv.x); a.y += cw.y * bfhi(xv.x); a.z += cw.z * bflo(xv.y); a.w += cw.w * bfhi(xv.y);
                    }
                }
                xc[ks][hf][0] = a.x; xc[ks][hf][1] = a.y; xc[ks][hf][2] = a.z; xc[ks][hf][3] = a.w;
            }
            u32x4 w; w.x = pk2(xc[ks][0][0], xc[ks][0][1]); w.y = pk2(xc[ks][0][2], xc[ks][0][3]); w.z = pk2(xc[ks][1][0], xc[ks][1][1]); w.w = pk2(xc[ks][1][2], xc[ks][1][3]);
            xb[ks] = __builtin_bit_cast(bf16x8, w);
        }
        float acum[8][4], hloc[8][4];
#pragma unroll
        for (int dt = 0; dt < 8; ++dt) {
            f32x4 acca = {0.f, 0.f, 0.f, 0.f}, acci = {0.f, 0.f, 0.f, 0.f};
            const LAS unsigned char* wa = lds + LR_WA + (16 * dt + tok) * 272 + 2 * hofs; const LAS unsigned char* wi = lds + LR_WI + (16 * dt + tok) * 272 + 2 * hofs;
#pragma unroll
            for (int ks = 0; ks < 4; ++ks) {
                const u32x2 a0 = *(const LAS u32x2*)(wa + 64 * ks), a1 = *(const LAS u32x2*)(wa + 64 * ks + 32);
                const u32x2 i0 = *(const LAS u32x2*)(wi + 64 * ks), i1 = *(const LAS u32x2*)(wi + 64 * ks + 32);
                const u32x4 fa = {a0.x, a0.y, a1.x, a1.y}, fi = {i0.x, i0.y, i1.x, i1.y};
                acca = mfma16(__builtin_bit_cast(bf16x8, fa), xb[ks], acca);
                acci = mfma16(__builtin_bit_cast(bf16x8, fi), xb[ks], acci);
            }
            const int cl0 = 16 * dt + hofs;
            const f32x4 vsp = *(const LAS f32x4*)(par + cl0), vba = *(const LAS f32x4*)(par + 128 + cl0), vbi = *(const LAS f32x4*)(par + 256 + cl0);
            f32x4 wA, wH;
#pragma unroll
            for (int r = 0; r < 4; ++r) {
                const float rg = fsig(acca[r] + vba[r]), ig = fsig(acci[r] + vbi[r]);
                const float l2a = rg * vsp[r];
                float a = __builtin_amdgcn_exp2f(l2a);
                const float x2 = 2.0f * 0.6931471805599453f * l2a;
                const float om = (x2 > -0.06f) ? -x2 * (1.0f + x2 * (0.5f + x2 * (0.16666667f + x2 * 0.041666668f))) : 1.0f - a * a;
                float u = sqrtf(fmaxf(om, 0.f)) * (ig * xc[dt >> 1][dt & 1][r]);
                { float ap = dpp_shr<1>(a, 1.f), up = dpp_shr<1>(u, 0.f); u = a * up + u; a = a * ap; }
                { float ap = dpp_shr<2>(a, 1.f), up = dpp_shr<2>(u, 0.f); u = a * up + u; a = a * ap; }
                { float ap = dpp_shr<4>(a, 1.f), up = dpp_shr<4>(u, 0.f); u = a * up + u; a = a * ap; }
                { float ap = dpp_shr<8>(a, 1.f), up = dpp_shr<8>(u, 0.f); u = a * up + u; a = a * ap; }
                acum[dt][r] = a; hloc[dt][r] = u;
                wA[r] = row_bcast15(a); wH[r] = row_bcast15(u);
            }
            if (tok == 0) { *(LAS f32x4*)(compA + wave * 128 + cl0) = wA; *(LAS f32x4*)(compH + wave * 128 + cl0) = wH; }
        }
        __syncthreads();
        if (MODE == 1 || wave == 0)
#pragma unroll
        for (int dt = 0; dt < 8; ++dt) {
            const int cl0 = 16 * dt + hofs;
            f32x4 cin = (MODE == 1) ? *(const LAS f32x4*)(carry + cl0) : (f32x4){0.f, 0.f, 0.f, 0.f};
            f32x4 pa = {1.f, 1.f, 1.f, 1.f};
            const int nw = (MODE == 0) ? 8 : wave;
            for (int w2 = 0; w2 < nw; ++w2) { const f32x4 ca = *(const LAS f32x4*)(compA + w2 * 128 + cl0), chh = *(const LAS f32x4*)(compH + w2 * 128 + cl0); cin = ca * cin + chh; pa = pa * ca; }
            if (MODE == 1) {
                const u32x2 gv = *(const u32x2*)(P + row * PLD + C_GL + n * 128 + cl0);
                float y[4];
#pragma unroll
                for (int r = 0; r < 4; ++r) y[r] = acum[dt][r] * cin[r] + hloc[dt][r];
                u32x2 w; w.x = pk2(y[0] * gelu_tanh(bflo(gv.x)), y[1] * gelu_tanh(bfhi(gv.x))); w.y = pk2(y[2] * gelu_tanh(bflo(gv.y)), y[3] * gelu_tanh(bfhi(gv.y)));
                *(u32x2*)(OB + row * old + n * 128 + cl0) = w;
            } else if (tok == 0) {
                const size_t o = ((size_t)b * 64 + tile) * 1024 + n * 128 + cl0;
                *(f32x4*)(aggA + o) = pa; *(f32x4*)(aggH + o) = cin;
            }
        }
        if (MODE == 1) {
            __syncthreads();
            if (wave == 7 && tok == 0) {
#pragma unroll
                for (int dt = 0; dt < 8; ++dt) { const int cl0 = 16 * dt + hofs;
                    f32x4 cin = *(const LAS f32x4*)(carry + cl0);
#pragma unroll
                    for (int w2 = 0; w2 < 8; ++w2) { const f32x4 ca = *(const LAS f32x4*)(compA + w2 * 128 + cl0), chh = *(const LAS f32x4*)(compH + w2 * 128 + cl0); cin = ca * cin + chh; }
                    *(LAS f32x4*)(carry + cl0) = cin; }
            }
        }
        __syncthreads();
    }
}

__device__ __forceinline__ void memattn_job(KP p, int jb, LAS unsigned char* lds, int tid, int lane_, int wave, bf16* OB, int old) {
    const int lane = launder_v(lane_);
    const int hd = jb & 3, b = (jb >> 2) & 1, j = jb >> 3, tok = lane & 15, h = lane >> 4;
    const bf16* P = (const bf16*)(gws(p) + WS_R1);
    const bf16* MK = (const bf16*)(gws(p) + WS_MK); const bf16* VTM = (const bf16*)(gws(p) + WS_VTM);
    __syncthreads();
#pragma unroll
    for (int i = 0; i < 16; ++i) { const int ci = tid + 512 * i, m = ci >> 5, c = ci & 31;
        *(LAS u32x4*)(lds + m * 512 + ((c ^ (m & 15)) << 4)) = *(const u32x4*)(MK + (size_t)(b * 256 + m) * 1024 + hd * 256 + c * 8); }
    const size_t row = (size_t)b * SEQ + j * 128 + wave * 16 + tok;
    bf16x8 qf[8];
#pragma unroll
    for (int ks = 0; ks < 8; ++ks) qf[ks] = *(const bf16x8*)(P + row * PLD + C_QM + hd * 256 + 32 * ks + 8 * h);
    unsigned ka[8];
#pragma unroll
    for (int ks = 0; ks < 8; ++ks) ka[ks] = (unsigned)launder_v(tok * 512 + (((4 * ks + h) ^ tok) << 4));
    __syncthreads();
    bf16x8 pf[8]; float inv;
    {
        f32x4 S[16];
#pragma unroll
        for (int mt = 0; mt < 16; ++mt) {
            f32x4 acc = {0.f, 0.f, 0.f, 0.f};
#pragma unroll
            for (int ks = 0; ks < 8; ++ks) acc = mfma16(*(const LAS bf16x8*)(lds + ka[ks] + mt * 8192), qf[ks], acc);
            S[mt] = acc;
        }
        float mx = -3.0e38f;
#pragma unroll
        for (int mt = 0; mt < 16; ++mt)
#pragma unroll
            for (int r = 0; r < 4; ++r) mx = fmaxf(mx, S[mt][r]);
        mx = fmaxf(mx, __shfl_xor(mx, 16)); mx = fmaxf(mx, __shfl_xor(mx, 32));
        const float sc = 0.0625f * LOG2E;
        float sum = 0.f;
#pragma unroll
        for (int mt = 0; mt < 16; ++mt)
#pragma unroll
            for (int r = 0; r < 4; ++r) { const float e = __builtin_amdgcn_exp2f((S[mt][r] - mx) * sc); S[mt][r] = e; sum += e; }
        sum += __shfl_xor(sum, 16); sum += __shfl_xor(sum, 32);
        inv = 1.0f / sum;
#pragma unroll
        for (int T = 0; T < 8; ++T) { u32x4 w; w.x = pk2(S[2 * T][0], S[2 * T][1]); w.y = pk2(S[2 * T][2], S[2 * T][3]); w.z = pk2(S[2 * T + 1][0], S[2 * T + 1][1]); w.w = pk2(S[2 * T + 1][2], S[2 * T + 1][3]);
            pf[T] = __builtin_bit_cast(bf16x8, w); }
    }
    __syncthreads();
#pragma unroll
    for (int i = 0; i < 16; ++i) { const int ci = tid + 512 * i, d = ci >> 5, c = ci & 31;
        *(LAS u32x4*)(lds + d * 512 + ((c ^ (d & 15)) << 4)) = *(const u32x4*)(VTM + (size_t)(hd * 256 + d) * 512 + b * 256 + c * 8); }
    unsigned va[8][2];
#pragma unroll
    for (int T = 0; T < 8; ++T) { va[T][0] = (unsigned)launder_v(tok * 512 + 8 * (h & 1) + (((4 * T + (h >> 1)) ^ tok) << 4)); va[T][1] = (unsigned)launder_v(tok * 512 + 8 * (h & 1) + (((4 * T + 2 + (h >> 1)) ^ tok) << 4)); }
    __syncthreads();
#pragma unroll
    for (int dt = 0; dt < 16; ++dt) {
        f32x4 acc = {0.f, 0.f, 0.f, 0.f};
#pragma unroll
        for (int T = 0; T < 8; ++T) { const u32x2 v0 = *(const LAS u32x2*)(lds + va[T][0] + dt * 8192), v1 = *(const LAS u32x2*)(lds + va[T][1] + dt * 8192); const u32x4 f = {v0.x, v0.y, v1.x, v1.y};
            acc = mfma16(__builtin_bit_cast(bf16x8, f), pf[T], acc); }
        u32x2 w; w.x = pk2(acc[0] * inv, acc[1] * inv); w.y = pk2(acc[2] * inv, acc[3] * inv);
        *(u32x2*)(OB + row * old + hd * 256 + 16 * dt + 4 * h) = w;
    }
}

struct KFr { bf16x8 a0, a1, b0, b1; };
__device__ __forceinline__ KFr idx_load(const bf16* kidx, size_t krow, int lane) {
    const bf16* kp = kidx + (krow + (lane & 15)) * 64 + (lane >> 4) * 8;
    KFr f; f.a0 = *(const bf16x8*)kp; f.a1 = *(const bf16x8*)(kp + 32); f.b0 = *(const bf16x8*)(kp + 16 * 64); f.b1 = *(const bf16x8*)(kp + 16 * 64 + 32); return f;
}
__device__ __forceinline__ f32x4 idx_score4(const bf16x8 k0, const bf16x8 k1, const bf16x8 (&qf)[4][2], const f32x4 w) {
    f32x4 s = {0.f, 0.f, 0.f, 0.f};
#pragma unroll
    for (int hd = 0; hd < 4; ++hd) {
        f32x4 d = {0.f, 0.f, 0.f, 0.f};
        d = mfma16(k0, qf[hd][0], d); d = mfma16(k1, qf[hd][1], d);
#pragma unroll
        for (int r = 0; r < 4; ++r) { const int di = __float_as_int(d[r]); s[r] = __builtin_fmaf(w[hd], __int_as_float(di > 0 ? di : 0), s[r]); }
    }
    return s;
}
__device__ __forceinline__ unsigned orderable(float s) { const unsigned u = __float_as_uint(s); return u ^ ((u >> 31) ? 0xFFFFFFFFu : 0x80000000u); }

template <int NE> __device__ __forceinline__ unsigned long long rank_select(const unsigned long long (&v)[NE], unsigned long long top12, int need) {
    unsigned long long prefix = top12 << 33;
    for (int bit = 32; bit >= 0; --bit) {
        const unsigned long long cand = prefix | (1ull << bit);
        int cnt = 0;
#pragma unroll
        for (int e = 0; e < NE; ++e) cnt += __popcll(__ballot(v[e] >= cand));
        if (cnt >= need) prefix = cand;
    }
    return prefix;
}

template <int sprobe> __device__ __forceinline__ void select_item(KP p, int b, int u, LAS unsigned char* lds, int tid, int lane, int wave) {
    LAS unsigned* hist = (LAS unsigned*)lds;
    LAS unsigned long long* lists = (LAS unsigned long long*)lds;
    LAS unsigned* mstage = (LAS unsigned*)(lds + 131072);
    LAS int* qinfo = (LAS int*)(lds + 147456);
    const bf16* P = (const bf16*)(gws(p) + WS_R1); const bf16* kidx = (const bf16*)(gws(p) + WS_KIDX);
    const int q0 = u * 16, nkeys = q0 + 16, ngrp = (nkeys + 31) >> 5, nw2 = (nkeys + 63) >> 6;
    for (int i = tid; i < 32768; i += 512) hist[i] = 0u;
    for (int i = tid; i < 4096; i += 512) mstage[i] = 0u;
    if (tid < 48) qinfo[tid] = 0;
    const int ql = lane & 15, h4 = lane >> 4, tq = q0 + ql;
    const size_t qrow = (size_t)b * SEQ + tq;
    bf16x8 qf[4][2];
#pragma unroll
    for (int hd = 0; hd < 4; ++hd)
#pragma unroll
        for (int ks = 0; ks < 2; ++ks) qf[hd][ks] = *(const bf16x8*)(P + qrow * PLD + C_QI + hd * 64 + ks * 32 + h4 * 8);
    const f32x4 w = *(const f32x4*)((const float*)(gws(p) + WS_WIDX) + qrow * 4);
    __syncthreads();
    {
        const size_t kr0 = (size_t)b * SEQ;
#define SEL_BODY1(KF, gg) do { if ((gg) < ngrp) { _Pragma("unroll") for (int hf = 0; hf < 2; ++hf) { const int kb = (gg) * 32 + hf * 16; \
            if (kb < nkeys) { const f32x4 sc = (sprobe & 8) ? (f32x4){__builtin_bit_cast(float, (int)KF.a0[0] << 16), __builtin_bit_cast(float, (int)KF.a1[1] << 16), __builtin_bit_cast(float, (int)KF.b0[2] << 16), __builtin_bit_cast(float, (int)KF.b1[3] << 16)} : (hf ? idx_score4(KF.b0, KF.b1, qf, w) : idx_score4(KF.a0, KF.a1, qf, w)); \
                _Pragma("unroll") for (int r = 0; r < 4; ++r) { const int key = kb + 4 * h4 + r; \
                    if (key <= tq) { const unsigned bin = orderable(sc[r]) >> 20; if (sprobe & 4) sink ^= bin; else (void)__hip_atomic_fetch_add(&hist[ql * 2048 + (((bin >> 1) + 2 * ql) & 2047)], 1u << (16 * (bin & 1)), __ATOMIC_RELAXED, __HIP_MEMORY_SCOPE_WORKGROUP); } } } } } } while (0)
#define SEL_LOAD(gg) idx_load(kidx, kr0 + 32 * ((gg) < ngrp ? (gg) : wave), lane)
        unsigned sink = 0u;
        KFr kA = SEL_LOAD(wave), kB = SEL_LOAD(wave + 8), kC;
        for (int g = wave; g < ((sprobe & 1) ? 0 : ngrp); g += 24) {
            kC = SEL_LOAD(g + 16); SEL_BODY1(kA, g);
            kA = SEL_LOAD(g + 24); SEL_BODY1(kB, g + 8);
            kB = SEL_LOAD(g + 32); SEL_BODY1(kC, g + 16);
        }
#undef SEL_BODY1
        if (sink == 0x12345u) hist[0] = sink;
    }
    __syncthreads();
    for (int qq = 0; qq < 2; ++qq) {
        const int q = 2 * wave + qq, total = q0 + q + 1;
        if (total <= 256) { if (lane == 0) { qinfo[q] = -1; qinfo[16 + q] = 0; } continue; }
        LAS unsigned* hq = hist + q * 2048;
        int s = 0;
#pragma unroll 8
        for (int i = 0; i < 32; ++i) { const unsigned wv = hq[(lane * 32 + ((i + lane) & 31) + 2 * q) & 2047]; s += (int)(wv & 0xffffu) + (int)(wv >> 16); }
        int suf = s;
#pragma unroll
        for (int off = 1; off < 64; off <<= 1) { const int t = __shfl_down(suf, off); if (lane + off < 64) suf += t; }
        const unsigned long long ball = __ballot(suf >= 256);
        const int L = 63 - __clzll(ball);
        const int above = (L < 63) ? __shfl(suf, L + 1) : 0;
        const unsigned wv = hq[(L * 32 + (lane >> 1) + 2 * q) & 2047];
        const int c = (lane & 1) ? (int)(wv >> 16) : (int)(wv & 0xffffu);
        int suf2 = c;
#pragma unroll
        for (int off = 1; off < 64; off <<= 1) { const int t = __shfl_down(suf2, off); if (lane + off < 64) suf2 += t; }
        suf2 += above;
        const unsigned long long ball2 = __ballot(suf2 >= 256);
        const int is = 63 - __clzll(ball2);
        const int nab = __shfl(suf2, is) - __shfl(c, is);
        if (lane == 0) { qinfo[q] = 64 * L + is; qinfo[16 + q] = nab; }
    }
    __syncthreads();
    const int b1q = qinfo[ql];
    {
        const size_t kr0 = (size_t)b * SEQ;
        struct Pend { int pos; unsigned flags; int gg; unsigned ub[8]; };
#define SEL_FLUSH(PD) do { if ((PD).flags) { _Pragma("unroll") for (int k = 0; k < 8; ++k) if (((PD).flags >> k) & 1u) { \
            const int idx = (PD).pos + __popc((PD).flags & ((1u << k) - 1u)), key = (PD).gg * 32 + (k >> 2) * 16 + 4 * h4 + (k & 3); \
            if (idx < 1024) lists[ql * 1024 + idx] = ((unsigned long long)(PD).ub[k] << 13) | (unsigned long long)(8191 - key); } } } while (0)
#define SEL_BODY2(KF, gg_, PN, PO) do { (PN).flags = 0u; (PN).gg = (gg_); (PN).pos = 0; if ((gg_) < ngrp) { unsigned bits = 0u; _Pragma("unroll") for (int hf = 0; hf < 2; ++hf) { const int kb = (gg_) * 32 + hf * 16; \
            if (kb < nkeys) { const f32x4 sc = hf ? idx_score4(KF.b0, KF.b1, qf, w) : idx_score4(KF.a0, KF.a1, qf, w); \
                _Pragma("unroll") for (int r = 0; r < 4; ++r) { const int key = kb + 4 * h4 + r; const unsigned ub = orderable(sc[r]); const int bin = (int)(ub >> 20); (PN).ub[hf * 4 + r] = ub; \
                    if (key <= tq) { if (bin > b1q) bits |= 1u << (hf * 16 + 4 * h4 + r); else if (bin == b1q) (PN).flags |= 1u << (hf * 4 + r); } } } } \
            if ((PN).flags) (PN).pos = __hip_atomic_fetch_add(&qinfo[32 + ql], __popc((PN).flags), __ATOMIC_RELAXED, __HIP_MEMORY_SCOPE_WORKGROUP); \
            bits = xor16_or(bits); bits = xor32_or(bits); if (h4 == 0) mstage[ql * 256 + (gg_)] = bits; } \
            SEL_FLUSH(PO); } while (0)
        Pend pA, pB, pC; pC.flags = 0u; pC.pos = 0; pC.gg = 0;
#pragma unroll
        for (int k = 0; k < 8; ++k) pC.ub[k] = 0u;
        KFr kA = SEL_LOAD(wave), kB = SEL_LOAD(wave + 8), kC;
        for (int g = wave; g < ngrp; g += 24) {
            kC = SEL_LOAD(g + 16); SEL_BODY2(kA, g, pA, pC);
            kA = SEL_LOAD(g + 24); SEL_BODY2(kB, g + 8, pB, pA);
            kB = SEL_LOAD(g + 32); SEL_BODY2(kC, g + 16, pC, pB);
        }
        SEL_FLUSH(pC);
#undef SEL_FLUSH
#undef SEL_BODY2
#undef SEL_LOAD
    }
    __syncthreads();
    for (int qq = 0; qq < 2; ++qq) {
        const int q = 2 * wave + qq, b1 = qinfo[q];
        if (b1 < 0) continue;
        int n = qinfo[32 + q]; n = n > 1024 ? 1024 : n;
        const int need = 256 - qinfo[16 + q];
        const LAS unsigned long long* Lq = lists + q * 1024;
        unsigned long long thr;
        if (n <= 64) { unsigned long long v[1]; v[0] = lane < n ? Lq[lane] : 0ull; thr = rank_select<1>(v, (unsigned long long)b1, need); }
        else if (n <= 256) { unsigned long long v[4];
#pragma unroll
            for (int e = 0; e < 4; ++e) v[e] = (lane + 64 * e) < n ? Lq[lane + 64 * e] : 0ull;
            thr = rank_select<4>(v, (unsigned long long)b1, need); }
        else { unsigned long long v[16];
#pragma unroll
            for (int e = 0; e < 16; ++e) v[e] = (lane + 64 * e) < n ? Lq[lane + 64 * e] : 0ull;
            thr = rank_select<16>(v, (unsigned long long)b1, need); }
        for (int e = lane; e < n; e += 64) { const unsigned long long v = Lq[e]; if (v >= thr) { const int key = 8191 - (int)(v & 8191ull); (void)__hip_atomic_fetch_or(&mstage[q * 256 + (key >> 5)], 1u << (key & 31), __ATOMIC_RELAXED, __HIP_MEMORY_SCOPE_WORKGROUP); } }
    }
    __syncthreads();
    unsigned* mask = (unsigned*)(gws(p) + WS_MASK);
    for (int i = tid; i < 16 * nw2; i += 512) { const int q = i / nw2, wp = i - q * nw2; *(u32x2*)(mask + ((size_t)b * SEQ + q0 + q) * 256 + 2 * wp) = *(const LAS u32x2*)(mstage + q * 256 + 2 * wp); }
    __syncthreads();
}

__device__ __forceinline__ float bfi_sel(int sel, float x) { float r; asm("v_bfi_b32 %0, %1, %2, %3" : "=v"(r) : "v"(sel), "v"(x), "v"(0xff800000u)); return r; }
constexpr int AT_K = 0, AT_VT = 16384, AT_BUF = 32768, AT_BIAS = 3 * AT_BUF;
__device__ __forceinline__ void attn_bias_table(KP p, LAS unsigned char* lds, int tid) {
    LAS float* bt = (LAS float*)(lds + AT_BIAS);
    for (int i = tid; i < 1024; i += 512) {
        const int hd = i >> 7, dd = i & 127;
        int bk = dd;
        if (dd >= 16) { bk = 16 + (dd >= 19) + (dd >= 21) + (dd >= 24) + (dd >= 27) + (dd >= 31) + (dd >= 35) + (dd >= 40) + (dd >= 46) + (dd >= 52) + (dd >= 59) + (dd >= 67) + (dd >= 77) + (dd >= 87) + (dd >= 99) + (dd >= 113); }
        bt[i] = gin(p, I_RELB)[bk * 8 + hd] * LOG2E;
    }
}
template <int probe> __device__ __forceinline__ void attn_item(KP p, int b, int kvh, int qt, LAS unsigned char* lds, int lane_, int wave, bf16* OB, int old) {
    const int lane = launder_v(lane_);
    const bf16* P = (const bf16*)(gws(p) + WS_R1); const bf16* VT = (const bf16*)(gws(p) + WS_VT); const unsigned* mask = (const unsigned*)(gws(p) + WS_MASK);
    const int head = kvh * 4 + (wave & 3), q0 = qt * 64 + 32 * (wave >> 2), nkt = (probe == 1) ? 1 : qt + 1, ql = lane & 31, hi = lane >> 5, tq = q0 + ql;
    const size_t row = (size_t)b * SEQ + tq;
    bf16x8 qf[8];
#pragma unroll
    for (int ks = 0; ks < 8; ++ks) qf[ks] = *(const bf16x8*)(P + row * PLD + C_QA + head * 128 + 16 * ks + 8 * hi);
    f32x16 O[4];
#pragma unroll
    for (int dt = 0; dt < 4; ++dt)
#pragma unroll
        for (int r = 0; r < 16; ++r) O[dt][r] = 0.f;
    float mrun = -1.0e4f, lrun = 0.f;
    const float c1 = 0.08838834764831845f * LOG2E;
    const LAS float* btab = (const LAS float*)(lds + AT_BIAS) + head * 128;
    const float bfar = btab[127];
    const bf16* kbase = P + (size_t)b * SEQ * PLD + C_KA + kvh * 128; const bf16* vbase = VT + (size_t)(b * 2 + kvh) * 128 * SEQ; const unsigned* mrow = mask + row * 256;
    unsigned koff[2], voff[2];
#pragma unroll
    for (int i = 0; i < 2; ++i) {
        const int pos = 1024 * (wave + 8 * i) + 16 * lane;
        const int key = pos >> 8, kc = ((pos >> 4) & 15) ^ (key & 15);
        koff[i] = (unsigned)(key * PLD + kc * 8);
        const int d = pos >> 7, vc = ((pos >> 4) & 7) ^ ((d >> 1) & 7);
        voff[i] = (unsigned)(d * 64 + vc * 8);
    }
#define AT_DMA(kt, st) do { _Pragma("unroll") for (int i = 0; i < 2; ++i) { \
        __builtin_amdgcn_global_load_lds((const unsigned*)(kbase + (size_t)(kt) * 64 * PLD + koff[i]), (LAS unsigned*)(lds + (st) * AT_BUF + AT_K + 1024 * (wave + 8 * i)), 16, 0, 0); \
        __builtin_amdgcn_global_load_lds((const unsigned*)(vbase + (size_t)(kt) * 8192 + voff[i]), (LAS unsigned*)(lds + (st) * AT_BUF + AT_VT + 1024 * (wave + 8 * i)), 16, 0, 0); } } while (0)
    const int piq = (ql & 16) | ((ql & 4) << 1) | ((ql & 8) >> 1) | (ql & 3);
    unsigned ksw[8], vsw[4];
#pragma unroll
    for (int ks = 0; ks < 8; ++ks) ksw[ks] = (probe == 5) ? (unsigned)launder_v(lane * 16 + ks * 1024) : (unsigned)launder_v(piq * 256 + (((2 * ks + hi) ^ (piq & 15)) << 4));
#pragma unroll
    for (int s = 0; s < 4; ++s) vsw[s] = (probe == 5) ? (unsigned)launder_v(lane * 16 + s * 1024) : (unsigned)launder_v(ql * 128 + (((2 * s + hi) ^ ((ql >> 1) & 7)) << 4));
    const bool grpB = wave >= 4;
    AT_DMA(0, 0);
    u32x2 mw = *(const u32x2*)(mrow);
    bf16x8 pf[4];
#pragma unroll
    for (int s = 0; s < 4; ++s) pf[s] = (bf16x8){0, 0, 0, 0, 0, 0, 0, 0};
#define AT_PV(vb_) do { bf16x8 vf[2][4], vg[2][4]; \
        _Pragma("unroll") for (int dt = 0; dt < 2; ++dt) _Pragma("unroll") for (int s = 0; s < 4; ++s) vf[dt][s] = (probe == 7) ? qf[s + 4 * dt] : *(const LAS bf16x8*)((vb_) + vsw[s] + dt * 4096); \
        __builtin_amdgcn_sched_barrier(0); \
        _Pragma("unroll") for (int dt = 0; dt < 2; ++dt) _Pragma("unroll") for (int s = 0; s < 4; ++s) vg[dt][s] = (probe == 7) ? qf[s + 4 * dt] : *(const LAS bf16x8*)((vb_) + vsw[s] + (dt + 2) * 4096); \
        _Pragma("unroll") for (int dt = 0; dt < 2; ++dt) _Pragma("unroll") for (int s = 0; s < 4; ++s) { if (probe != 4 && probe < 6) O[dt] = mfma32(vf[dt][s], pf[s], O[dt]); else if (probe >= 6) O[dt][s] += __builtin_bit_cast(float, vf[dt][s][0] | (vf[dt][s][1] << 16)); } \
        __builtin_amdgcn_sched_barrier(0); \
        _Pragma("unroll") for (int dt = 0; dt < 2; ++dt) _Pragma("unroll") for (int s = 0; s < 4; ++s) { if (probe != 4 && probe < 6) O[dt + 2] = mfma32(vg[dt][s], pf[s], O[dt + 2]); else if (probe >= 6) O[dt + 2][s] += __builtin_bit_cast(float, vg[dt][s][0] | (vg[dt][s][1] << 16)); } } while (0)
    int st = 0, stp = 2;
    for (int kt = 0; kt < nkt; ++kt) {
        asm volatile("s_waitcnt vmcnt(0)" ::: "memory");
        __builtin_amdgcn_s_barrier();
        asm volatile("" ::: "memory");
        const u32x2 mcur = mw;
        const int stn = st == 2 ? 0 : st + 1;
        if (kt + 1 < nkt && probe != 2) { AT_DMA(kt + 1, stn); mw = *(const u32x2*)(mrow + 2 * (kt + 1)); }
        if (grpB && kt > 0) AT_PV(lds + stp * AT_BUF + AT_VT);
        const LAS unsigned char* kb = lds + st * AT_BUF + AT_K;
        f32x16 S[2];
        {
            bf16x8 kf[2][8];
#pragma unroll
            for (int hh = 0; hh < 2; ++hh)
#pragma unroll
                for (int ks = 0; ks < 8; ++ks) kf[hh][ks] = (probe == 7) ? qf[ks] : *(const LAS bf16x8*)(kb + ksw[ks] + hh * 8192);
            __builtin_amdgcn_sched_barrier(0);
#pragma unroll
            for (int hh = 0; hh < 2; ++hh) {
#pragma unroll
                for (int r = 0; r < 16; ++r) S[hh][r] = 0.f;
#pragma unroll
                for (int ks = 0; ks < 8; ++ks) { if (probe != 4 && probe < 6) S[hh] = mfma32(kf[hh][ks], qf[ks], S[hh]); else if (probe >= 6) S[hh][ks] += __builtin_bit_cast(float, kf[hh][ks][0] | (kf[hh][ks][1] << 16)); }
            }
        }
        const bool farr = (q0 - (64 * kt + 63)) >= 113;
        float mt = -INFINITY;
        if (farr) {
            const float boff = bfar - mrun;
#pragma unroll
            for (int hh = 0; hh < 2; ++hh) {
                const unsigned wbits = (hh ? mcur.y : mcur.x) >> (8 * hi);
#pragma unroll
                for (int r = 0; r < 16; ++r) {
                    const int kk = 16 * (r >> 3) + 4 * ((r >> 2) & 1) + (r & 3);
                    const float x = __builtin_fmaf(S[hh][r], c1, boff);
                    const int sel = __builtin_amdgcn_sbfe((int)wbits, kk, 1);
                    const float xm = bfi_sel(sel, x);
                    S[hh][r] = xm; mt = fmaxf(mt, xm);
                }
            }
        } else {
#pragma unroll
            for (int hh = 0; hh < 2; ++hh) {
                const unsigned wbits = (hh ? mcur.y : mcur.x) >> (8 * hi);
                const int dbase = tq - (64 * kt + 32 * hh + 8 * hi);
#pragma unroll
                for (int r = 0; r < 16; ++r) {
                    const int kk = 16 * (r >> 3) + 4 * ((r >> 2) & 1) + (r & 3);
                    int dist = dbase - kk; dist = dist < 0 ? 0 : (dist > 127 ? 127 : dist);
                    const float x = __builtin_fmaf(S[hh][r], c1, btab[dist] - mrun);
                    const int sel = __builtin_amdgcn_sbfe((int)wbits, kk, 1);
                    const float xm = bfi_sel(sel, x);
                    S[hh][r] = xm; mt = fmaxf(mt, xm);
                }
            }
        }
        mt = xmax32(mt);
        float alpha = 1.0f;
        if (!__all(mt <= 8.0f)) {
            const float dm = fmaxf(mt, 0.f); alpha = __builtin_amdgcn_exp2f(-dm); mrun += dm;
#pragma unroll
            for (int dt = 0; dt < 4; ++dt)
#pragma unroll
                for (int r = 0; r < 16; ++r) O[dt][r] *= alpha;
#pragma unroll
            for (int hh = 0; hh < 2; ++hh)
#pragma unroll
                for (int r = 0; r < 16; ++r) S[hh][r] -= dm;
        }
        float ps = 0.f;
#pragma unroll
        for (int hh = 0; hh < 2; ++hh)
#pragma unroll
            for (int r = 0; r < 16; ++r) { const float e = __builtin_amdgcn_exp2f(S[hh][r]); S[hh][r] = e; ps += e; }
        lrun = lrun * alpha + ps;
#pragma unroll
        for (int s = 0; s < 4; ++s) { const int hh = s >> 1, r0 = 8 * (s & 1);
            u32x4 wv; wv.x = pkbf(S[hh][r0 + 0], S[hh][r0 + 1]); wv.y = pkbf(S[hh][r0 + 2], S[hh][r0 + 3]); wv.z = pkbf(S[hh][r0 + 4], S[hh][r0 + 5]); wv.w = pkbf(S[hh][r0 + 6], S[hh][r0 + 7]);
            pf[s] = __builtin_bit_cast(bf16x8, wv); }
        if (!grpB) AT_PV(lds + st * AT_BUF + AT_VT);
        stp = st; st = stn;
    }
    if (grpB) AT_PV(lds + stp * AT_BUF + AT_VT);
#undef AT_PV
#undef AT_DMA
    const float ltot = xadd32(lrun);
    const float inv = 1.0f / ltot;
#pragma unroll
    for (int dt = 0; dt < 4; ++dt)
#pragma unroll
        for (int g = 0; g < 4; ++g) {
            u32x2 wv; wv.x = pkbf(O[dt][4 * g + 0] * inv, O[dt][4 * g + 1] * inv); wv.y = pkbf(O[dt][4 * g + 2] * inv, O[dt][4 * g + 3] * inv);
            *(u32x2*)(OB + row * old + head * 128 + 32 * dt + 8 * g + 4 * hi) = wv;
        }
    asm volatile("s_waitcnt vmcnt(0)" ::: "memory");
    __builtin_amdgcn_s_barrier();
    asm volatile("" ::: "memory");
}

#ifndef SKIP_MIXER
#define SKIP_MIXER 0
#endif
#ifndef PROBE_MIX
#define PROBE_MIX 0
#endif
#ifndef PROBE_CVT
#define PROBE_CVT 0
#endif
#ifndef ZERO_BRANCH
#define ZERO_BRANCH 0
#endif
__device__ __forceinline__ void zero_cols(bf16* P, int col0, int gw, int NGW, int lane) {
    for (int m = gw; m < M; m += NGW) { u32x4* o = (u32x4*)(P + (size_t)m * PLD + col0) + lane; o[0] = (u32x4){0u, 0u, 0u, 0u}; o[64] = (u32x4){0u, 0u, 0u, 0u}; }
}
__global__ void __launch_bounds__(512, 2) fwd(Params pdummy) {
    extern __shared__ __attribute__((aligned(16))) unsigned char lds_raw[];
    LAS unsigned char* lds = (LAS unsigned char*)lds_raw;
    const int wave0 = __builtin_amdgcn_readfirstlane(threadIdx.x >> 6);
    const int G = gridDim.x, bx = blockIdx.x;
    const int vcu = (G % 8 == 0) ? (bx % 8) * (G / 8) + bx / 8 : bx;
    const int NGW = G * 8;
    if (threadIdx.x < 64) ((LAS unsigned*)(lds + MISC_OFF))[threadIdx.x] = 0u;
    __syncthreads();
    XcdBarrier bar = xcd_barrier_post((unsigned*)(gws(kargs()) + WS_CTL) + CW_BAR, (volatile LAS unsigned*)(lds + MISC_OFF + 32));
#define GRID_BAR() xcd_barrier(bar)
#define PH_BEGIN const int lane = lane_id_asm(), wave = wave0, tid = wave * 64 + lane, gw = vcu * 8 + wave, bxl = launder_s(bx); KP p = kargs(); (void)bxl; unsigned char* ws = gws(p); (void)lane; (void)gw; (void)ws;

    for (int l = 0; l < DEPTH; ++l) {
        for (int rep = (PROBE_CVT & 1) ? 0 : 1; rep < 2; ++rep) { PH_BEGIN phase_cvt(p, l, lds, vcu, G, gw, NGW, wave, lane); }
        for (int f = 0; f < 2; ++f) {
            if (f == 1 && !SKIP_MIXER) {
                for (int rep = (PROBE_CVT & 1) ? 0 : 1; rep < 2; ++rep) { PH_BEGIN float* X = gout(p); bf16* XN = (bf16*)(ws + WS_XN);
                  rms_rows_bf16(X, gin(p, I_NMIX) + (size_t)l * DM, XN, gw, NGW, lane); }
                GRID_BAR();
                for (int rep = (PROBE_CVT & 4) ? 0 : 1; rep < 2; ++rep)
                { PH_BEGIN
                    pg8::Gemm g{(const bf16*)(ws + WS_XN), (const bf16*)(ws + WS_WIN), M, DIN_PAD, DM, DM, DM}; pg8::StaticOrder S; S.init(M, DIN_PAD, G, bxl);
                    pg8::EpiProj E{(bf16*)(ws + WS_R1), PLD, (float*)(ws + WS_SIDE)};
                    pg8::gemm_phase<pg8::EpiProj, pg8::StaticOrder, true, true>(lds, g, S, E, tid);
                }
                GRID_BAR();
                for (int rep = (PROBE_MIX & 16) ? 0 : 1; rep < 2; ++rep) {
                { PH_BEGIN
                    for (int gt = vcu * 512 + tid; gt < 4 * M; gt += G * 512) kidx_ln_quarter(p, l, gt);
                    for (int it = gw; it < 1024; it += NGW) vt_item(p, it, lds + 8192 + wave * 16384, lane);
                } }
                for (int rep = (PROBE_MIX & 32) ? 0 : 1; rep < 2; ++rep)
                { PH_BEGIN for (int it = vcu; it < 256; it += G) lru_job<0>(p, l, it, lds, tid, lane, wave, nullptr, 0); }
                for (int rep = (PROBE_MIX & 64) ? 0 : 1; rep < 2; ++rep)
                { PH_BEGIN bf16* OB = rep ? (bf16*)(ws + WS_R1) + C_QM : (bf16*)(ws + WS_SCR); const int old = rep ? PLD : 1024;
                    if (!(ZERO_BRANCH & 4)) { for (int it = vcu; it < 512; it += G) memattn_job(p, it, lds, tid, lane, wave, OB, old); __syncthreads(); } else zero_cols((bf16*)(ws + WS_R1), C_QM, gw, NGW, lane);
                }
                GRID_BAR();
                for (int rep = (PROBE_MIX & 6) ? 0 : 1; rep < 2; ++rep) {
                { PH_BEGIN
                    if (!(ZERO_BRANCH & 1) && (rep || (PROBE_MIX & 2))) for (int pi = vcu; pi < 512; pi += G) { const int b = pi >> 8, j = pi & 255;
#pragma unroll 1
                        for (int k = 0; k < 2; ++k) { if ((PROBE_MIX >> 12) && rep == 0) select_item<(PROBE_MIX >> 12)>(p, b, k ? 511 - j : j, lds, tid, lane, wave); else select_item<0>(p, b, k ? 511 - j : j, lds, tid, lane, wave); } }
                    __syncthreads();
                }
                { PH_BEGIN bf16* OB = rep ? (bf16*)(ws + WS_R1) + C_GL : (bf16*)(ws + WS_SCR); const int old = rep ? PLD : 1024;
                    if (!(ZERO_BRANCH & 2) && (rep || (PROBE_MIX & 4))) { for (int it = vcu; it < 256; it += G) lru_job<1>(p, l, it, lds, tid, lane, wave, OB, old); } else if (ZERO_BRANCH & 2) zero_cols((bf16*)(ws + WS_R1), C_GL, gw, NGW, lane);
                }
                }
                GRID_BAR();
                for (int rep = (PROBE_MIX & 8) ? 0 : 1; rep < 2; ++rep) {
                { PH_BEGIN bf16* OB = rep ? (bf16*)(ws + WS_R1) + C_QA : (bf16*)(ws + WS_SCR); const int old = rep ? PLD : 1024;
                    if (!(ZERO_BRANCH & 1)) {
                        attn_bias_table(p, lds, tid);
                        __syncthreads();
                        for (int pi = vcu; pi < 256; pi += G) { const int bk = pi >> 6, j = pi & 63;
#pragma unroll 1
                            for (int k = 0; k < 2; ++k) { if ((PROBE_MIX >> 8) && rep == 0) attn_item<(PROBE_MIX >> 8)>(p, bk >> 1, bk & 1, k ? 127 - j : j, lds, lane, wave, OB, old); else attn_item<0>(p, bk >> 1, bk & 1, k ? 127 - j : j, lds, lane, wave, OB, old); } }
                    } else zero_cols((bf16*)(ws + WS_R1), C_QA, gw, NGW, lane);
                }
                }
                GRID_BAR();
                for (int rep = (PROBE_CVT & 16) ? 0 : 1; rep < 2; ++rep) {
                { PH_BEGIN bf16* R1 = (bf16*)(ws + WS_R1); const bf16* WBR = (const bf16*)(ws + WS_WBR); pg8::StaticOrder S; S.init(M, DM, G, bxl);
                  pg8::Gemm g{R1 + C_QA, WBR, M, DM, 1024, PLD, 1024}; pg8::EpiBf16 E{(bf16*)(ws + WS_SCR), DM}; pg8::gemm_phase<pg8::EpiBf16, pg8::StaticOrder, true, true>(lds, g, S, E, tid); }
                { PH_BEGIN bf16* R1 = (bf16*)(ws + WS_R1); const bf16* WBR = (const bf16*)(ws + WS_WBR); pg8::StaticOrder S; S.init(M, DM, G, bxl);
                  pg8::Gemm g{R1 + C_GL, WBR + (size_t)DM * 1024, M, DM, 1024, PLD, 1024}; pg8::EpiBf16 E{(bf16*)(ws + WS_SCR) + (size_t)M * DM, DM}; pg8::gemm_phase<pg8::EpiBf16, pg8::StaticOrder, true, true>(lds, g, S, E, tid); }
                { PH_BEGIN bf16* R1 = (bf16*)(ws + WS_R1); const bf16* WBR = (const bf16*)(ws + WS_WBR); pg8::StaticOrder S; S.init(M, DM, G, bxl);
                  pg8::Gemm g{R1 + C_QM, WBR + (size_t)2 * DM * 1024, M, DM, 1024, PLD, 1024}; pg8::EpiMerge E{R1 + C_GT, PLD, (const bf16*)(ws + WS_SCR), (const bf16*)(ws + WS_SCR) + (size_t)M * DM, (bf16*)(ws + WS_XN), DM}; pg8::gemm_phase<pg8::EpiMerge, pg8::StaticOrder, true, true>(lds, g, S, E, tid); }
                }
                GRID_BAR();
                { PH_BEGIN
                    pg8::Gemm g{(const bf16*)(ws + WS_XN), (const bf16*)(ws + WS_WOUT), M, DM, DM, DM, DM}; pg8::StaticOrder S; S.init(M, DM, G, bxl);
                    pg8::EpiResid E{gout(p), gout(p), DM, 1.0f};
                    pg8::gemm_phase<pg8::EpiResid, pg8::StaticOrder, true, true>(lds, g, S, E, tid);
                }
                GRID_BAR();
            }
            for (int rep = (PROBE_CVT & 1) ? 0 : 1; rep < 2; ++rep) { PH_BEGIN const float* xsrc = (l == 0 && f == 0) ? gin(p, I_X) : gout(p); bf16* XN = (bf16*)(ws + WS_XN);
              rms_rows_bf16(xsrc, gin(p, f ? I_NFF2 : I_NFF1) + (size_t)l * DM, XN, gw, NGW, lane); }
            GRID_BAR();
            if (f == 0) {
                { PH_BEGIN const bf16* WM = (const bf16*)(ws + WS_WMKV); const bf16* MN = (const bf16*)(ws + WS_MEMN);
                  pg8::Gemm g{MN, WM, BATCH * NMEM, 1024, DM, DM, DM}; pg8::SimpleOrder S; S.init(BATCH * NMEM, 1024, G, bxl - 192); pg8::EpiBf16 E{(bf16*)(ws + WS_MK), 1024}; pg8::gemm_phase<pg8::EpiBf16, pg8::SimpleOrder, true, true>(lds, g, S, E, tid); }
                { PH_BEGIN const bf16* WM = (const bf16*)(ws + WS_WMKV); const bf16* MN = (const bf16*)(ws + WS_MEMN);
                  pg8::Gemm g{WM + (size_t)1024 * DM, MN, 1024, BATCH * NMEM, DM, DM, DM}; pg8::SimpleOrder S; S.init(1024, BATCH * NMEM, G, bxl - 200); pg8::EpiBf16 E{(bf16*)(ws + WS_VTM), BATCH * NMEM}; pg8::gemm_phase<pg8::EpiBf16, pg8::SimpleOrder, true, true>(lds, g, S, E, tid); }
            }
            for (int rep = (PROBE_CVT & 2) ? 0 : 1; rep < 2; ++rep)
            { PH_BEGIN
                pg8::Gemm g{(const bf16*)(ws + WS_XN), (const bf16*)(ws + (f ? WS_WGU2 : WS_WGU)), M, 2 * DFF, DM, DM, DM}; pg8::StaticOrder S; S.init(M, 2 * DFF, G, bxl);
                pg8::EpiSwiglu E{(bf16*)(ws + WS_R1), DFF};
                pg8::gemm_phase<pg8::EpiSwiglu, pg8::StaticOrder, true, true>(lds, g, S, E, tid);
            }
            GRID_BAR();
            for (int rep = (PROBE_CVT & 8) ? 0 : 1; rep < 2; ++rep)
            { PH_BEGIN
                const float* xsrc = (l == 0 && f == 0) ? gin(p, I_X) : gout(p);
                pg8::Gemm g{(const bf16*)(ws + WS_R1), (const bf16*)(ws + (f ? WS_WDN2 : WS_WDN)), M, DM, DFF, DFF, DFF}; pg8::StaticOrder S; S.init(M, DM, G, bxl);
                pg8::EpiResid E{xsrc, rep ? gout(p) : (float*)(ws + WS_SCR), DM, 0.5f};
                pg8::gemm_phase<pg8::EpiResid, pg8::StaticOrder, true, true>(lds, g, S, E, tid);
            }
            GRID_BAR();
        }
    }
    { PH_BEGIN float* X = gout(p); const f32x4* gr = (const f32x4*)gin(p, I_FNORM) + lane;
      f32x4 gg[8];
#pragma unroll
      for (int j = 0; j < 8; ++j) gg[j] = gr[64 * j];
      for (int m = gw; m < M; m += 4 * NGW) {
          f32x4 v[4][8]; float ss[4];
#pragma unroll
          for (int r = 0; r < 4; ++r) { const int mr = (m + r * NGW < M) ? m + r * NGW : m; const f32x4* xr = (const f32x4*)(X + (size_t)mr * DM) + lane;
#pragma unroll
              for (int j = 0; j < 8; ++j) v[r][j] = xr[64 * j]; }
#pragma unroll
          for (int r = 0; r < 4; ++r) { float sq = 0.f;
#pragma unroll
              for (int j = 0; j < 8; ++j) sq += (v[r][j].x * v[r][j].x + v[r][j].y * v[r][j].y) + (v[r][j].z * v[r][j].z + v[r][j].w * v[r][j].w);
              ss[r] = 1.0f / sqrtf(wave_sum(sq) * (1.0f / DM) + EPS); }
#pragma unroll
          for (int r = 0; r < 4; ++r) if (m + r * NGW < M) { f32x4* o = (f32x4*)(X + (size_t)(m + r * NGW) * DM) + lane;
#pragma unroll
              for (int j = 0; j < 8; ++j) o[64 * j] = v[r][j] * ss[r] * gg[j]; }
      } }
}

extern "C" void kernel_launch(void* const* d_in, const int* in_sizes, int n_in, void* d_out, int out_size, void* d_ws, size_t ws_size, hipStream_t stream) {
    static int grid = 0;
    if (grid == 0) {
        if (n_in != 25 || in_sizes[0] != M * DM || out_size != M * DM || ws_size < WS_END) { fprintf(stderr, "kernel_launch: unexpected shapes / workspace (n_in %d, ws %zu, need %zu); nothing launched\n", n_in, ws_size, (size_t)WS_END); grid = -1; return; }
        int dev = 0, cus = 0, per_cu = 0;
        if (hipGetDevice(&dev) != hipSuccess || hipDeviceGetAttribute(&cus, hipDeviceAttributeMultiprocessorCount, dev) != hipSuccess) { grid = -1; return; }
        if (hipFuncSetAttribute((const void*)fwd, hipFuncAttributeMaxDynamicSharedMemorySize, LDS_BYTES) != hipSuccess) { fprintf(stderr, "kernel_launch: hipFuncSetAttribute failed\n"); grid = -1; return; }
        if (hipOccupancyMaxActiveBlocksPerMultiprocessor(&per_cu, (const void*)fwd, 512, LDS_BYTES) != hipSuccess || per_cu < 1) { fprintf(stderr, "kernel_launch: occupancy query reports %d workgroups per CU; nothing launched\n", per_cu); (void)hipGetLastError(); grid = -1; return; }
        grid = cus;
    }
    if (grid < 0) return;
    if (hipMemsetAsync((char*)d_ws + WS_CTL, 0, CTL_ZERO_BYTES, stream) != hipSuccess) return;
    Params a{};
    for (int i = 0; i < 25; ++i) a.in[i] = (const GAS float*)d_in[i];
    a.out = (GAS float*)d_out; a.ws = (GAS unsigned char*)d_ws;
    hipLaunchKernelGGL(fwd, dim3(grid), dim3(512), LDS_BYTES, stream, a);
}
```

```cpp
#include <hip/hip_runtime.h>
#include <cstdio>
#include <cstdint>

namespace pg8 {
#define PG8_LAS __attribute__((address_space(3)))
typedef unsigned short bf16_t;
typedef short bf16x8 __attribute__((ext_vector_type(8)));
typedef float f32x4 __attribute__((ext_vector_type(4)));
typedef unsigned u32x4 __attribute__((ext_vector_type(4)));
typedef unsigned u32x2 __attribute__((ext_vector_type(2)));
constexpr int BM = 256, BK = 64, HALF = 128, HTB = HALF * BK * 2  , STAGE_BYTES = 8 * HTB, NXCD = 8, WGM = 8;

__host__ __device__ __forceinline__ int lds_byte(int r, int c) { const int st = (r >> 4) * 2 + (c >> 5), rr = r & 15, cc = c & 31, ob = rr * 64 + cc * 2; return st * 1024 + (ob ^ (((ob >> 9) & 1) << 5)); }
__host__ __device__ __forceinline__ void stage_rc(int b, int& R, int& C) { const int st = b / 1024, sb = b % 1024, swz = sb ^ (((sb >> 9) & 1) << 5); R = (st >> 1) * 16 + swz / 64; C = (st & 1) * 32 + (swz % 64) / 2; }
__host__ __device__ __forceinline__ int perm32(int rho) { const int n = rho >> 4, i = rho & 15; return 8 * (i >> 2) + 4 * n + (i & 3); }

struct Unit { int pm, pn; };
struct Gemm { const bf16_t* A; const bf16_t* Bt; int M, N, K, lda, ldb; };

struct StaticOrder {
    int nM, nN, nwg, G, c;
    __host__ __device__ void init(int M, int N, int G_, int c_) { nM = M / BM; nN = N / BM; nwg = nM * nN; G = G_; c = c_; }
    __host__ __device__ bool next(int i, Unit& u) const {
        const long L = (long)i * G + c; if (L >= nwg) return false;
        int wgid = (int)L; { const int q = nwg / NXCD, r = nwg % NXCD, xcd = wgid % NXCD, off = wgid / NXCD; wgid = (xcd < r ? xcd * (q + 1) : r * (q + 1) + (xcd - r) * q) + off; }
        const int nig = WGM * nN, gid = wgid / nig, fm = gid * WGM, gsz = (nM - fm) < WGM ? (nM - fm) : WGM;
        u.pm = fm + ((wgid % nig) % gsz); u.pn = (wgid % nig) / gsz; return true;
    }
    __device__ __forceinline__ void a_ready(const Unit&) const {}
    __device__ __forceinline__ void done(const Unit&) const {}
};
struct SimpleOrder {
    int nM, nN, nwg, G, c;
    __host__ __device__ void init(int M, int N, int G_, int c_) { nM = M / BM; nN = N / BM; nwg = nM * nN; G = G_; c = c_; }
    __host__ __device__ bool next(int i, Unit& u) const {
        const long L = (long)i * G + c; if (L < 0 || L >= nwg) return false;
        u.pm = (int)(L % nM); u.pn = (int)(L / nM); return true;
    }
    __device__ __forceinline__ void a_ready(const Unit&) const {}
    __device__ __forceinline__ void done(const Unit&) const {}
};

__device__ __forceinline__ unsigned cvt_pk_bf16(float lo, float hi) { unsigned r; asm volatile("v_cvt_pk_bf16_f32 %0, %1, %2" : "=v"(r) : "v"(lo), "v"(hi)); return r; }

__device__ __forceinline__ float fsigmoid(float x) { return __builtin_amdgcn_rcpf(1.0f + __builtin_amdgcn_exp2f(-1.4426950408889634f * x)); }
__device__ __forceinline__ float bf_lo(unsigned w) { return __uint_as_float(w << 16); }
__device__ __forceinline__ float bf_hi(unsigned w) { return __uint_as_float(w & 0xffff0000u); }

struct EpiSwiglu {
    static constexpr bool PERM = true, AFTER_DRAIN = false;
    bf16_t* H; int ldh;
    __device__ __forceinline__ void operator()(const f32x4 (&acc)[2][2][4][2], const Unit& u, int wr, int wc, int fr, int fq) const {
        const int row0 = u.pm * BM + wr * 64 + fr, col0 = u.pn * HALF + wc * 32 + 8 * fq;
#pragma unroll
        for (int ai = 0; ai < 2; ++ai)
#pragma unroll
            for (int m = 0; m < 4; ++m) {
                bf16_t* rowp = H + (size_t)(row0 + ai * HALF + m * 16) * ldh + col0;
                const f32x4 g0 = acc[ai][0][m][0], g1 = acc[ai][0][m][1], u0 = acc[ai][1][m][0], u1 = acc[ai][1][m][1];
                float o[8];
#pragma unroll
                for (int j = 0; j < 4; ++j) { o[j] = g0[j] * fsigmoid(g0[j]) * u0[j]; o[4 + j] = g1[j] * fsigmoid(g1[j]) * u1[j]; }
                u32x4 w; w.x = cvt_pk_bf16(o[0], o[1]); w.y = cvt_pk_bf16(o[2], o[3]); w.z = cvt_pk_bf16(o[4], o[5]); w.w = cvt_pk_bf16(o[6], o[7]);
                *(u32x4*)rowp = w;
            }
    }
};
struct EpiResid {
    static constexpr bool PERM = false, AFTER_DRAIN = false;
    const float* src; float* out; int ldc; float alpha;
    __device__ __forceinline__ void operator()(const f32x4 (&acc)[2][2][4][2], const Unit& u, int wr, int wc, int fr, int fq) const {
        const int row0 = u.pm * BM + wr * 64 + fr, col0 = u.pn * BM + wc * 32 + 4 * fq;
#pragma unroll
        for (int ai = 0; ai < 2; ++ai)
#pragma unroll
            for (int m = 0; m < 4; ++m) {
                const size_t off = (size_t)(row0 + ai * HALF + m * 16) * ldc + col0;
                f32x4 s[2][2];
#pragma unroll
                for (int bj = 0; bj < 2; ++bj)
#pragma unroll
                    for (int n = 0; n < 2; ++n) s[bj][n] = *(const f32x4*)(src + off + bj * HALF + n * 16);
#pragma unroll
                for (int bj = 0; bj < 2; ++bj)
#pragma unroll
                    for (int n = 0; n < 2; ++n) *(f32x4*)(out + off + bj * HALF + n * 16) = s[bj][n] + acc[ai][bj][m][n] * alpha;
                if (m & 1) asm volatile("" ::: "memory");
            }
    }
};
struct EpiProj {
    static constexpr bool PERM = true, AFTER_DRAIN = false;
    bf16_t* P; int ldp; float* side;
    __device__ __forceinline__ void operator()(const f32x4 (&acc)[2][2][4][2], const Unit& u, int wr, int wc, int fr, int fq) const {
        const int row0 = u.pm * BM + wr * 64 + fr, cw = wc * 32 + 8 * fq;
        if (u.pn == 7) {
            if (cw < 72) {
#pragma unroll
                for (int ai = 0; ai < 2; ++ai)
#pragma unroll
                    for (int m = 0; m < 4; ++m) { float* rp = side + (size_t)(row0 + ai * HALF + m * 16) * 72 + cw; *(f32x4*)rp = acc[ai][0][m][0]; *(f32x4*)(rp + 4) = acc[ai][0][m][1]; }
            }
            return;
        }
        const int colbase = 256 * (u.pn > 7 ? u.pn - 1 : u.pn) + cw; const bool sig = u.pn >= 20;
#pragma unroll
        for (int ai = 0; ai < 2; ++ai)
#pragma unroll
            for (int m = 0; m < 4; ++m) {
                bf16_t* rowp = P + (size_t)(row0 + ai * HALF + m * 16) * ldp + colbase;
#pragma unroll
                for (int bj = 0; bj < 2; ++bj) {
                    f32x4 v0 = acc[ai][bj][m][0] + 0.0f, v1 = acc[ai][bj][m][1] + 0.0f;
                    if (sig) {
#pragma unroll
                        for (int j = 0; j < 4; ++j) { v0[j] = fsigmoid(v0[j]); v1[j] = fsigmoid(v1[j]); }
                    }
                    u32x4 w; w.x = cvt_pk_bf16(v0[0], v0[1]); w.y = cvt_pk_bf16(v0[2], v0[3]); w.z = cvt_pk_bf16(v1[0], v1[1]); w.w = cvt_pk_bf16(v1[2], v1[3]);
                    *(u32x4*)(rowp + bj * HALF) = w;
                }
            }
    }
};
template <int J> struct EpiBranch {
    static constexpr bool PERM = true, AFTER_DRAIN = false;
    const bf16_t* gate; int ldg; float* tmp; bf16_t* outb; int ldc;
    __device__ __forceinline__ void operator()(const f32x4 (&acc)[2][2][4][2], const Unit& u, int wr, int wc, int fr, int fq) const {
        const int row0 = u.pm * BM + wr * 64 + fr, col0 = u.pn * BM + wc * 32 + 8 * fq;
#pragma unroll
        for (int ai = 0; ai < 2; ++ai)
#pragma unroll
            for (int m = 0; m < 4; ++m) {
                const int row = row0 + ai * HALF + m * 16;
#pragma unroll
                for (int bj = 0; bj < 2; ++bj) {
                    const int c = col0 + bj * HALF;
                    const u32x4 gv = *(const u32x4*)(gate + (size_t)row * ldg + c);
                    f32x4 t0, t1;
                    t0[0] = bf_lo(gv.x) * acc[ai][bj][m][0][0]; t0[1] = bf_hi(gv.x) * acc[ai][bj][m][0][1]; t0[2] = bf_lo(gv.y) * acc[ai][bj][m][0][2]; t0[3] = bf_hi(gv.y) * acc[ai][bj][m][0][3];
                    t1[0] = bf_lo(gv.z) * acc[ai][bj][m][1][0]; t1[1] = bf_hi(gv.z) * acc[ai][bj][m][1][1]; t1[2] = bf_lo(gv.w) * acc[ai][bj][m][1][2]; t1[3] = bf_hi(gv.w) * acc[ai][bj][m][1][3];
                    float* tp = tmp + (size_t)row * ldc + c;
                    if (J > 0) { t0 += *(const f32x4*)tp; t1 += *(const f32x4*)(tp + 4); }
                    if (J < 2) { *(f32x4*)tp = t0; *(f32x4*)(tp + 4) = t1; }
                    else { u32x4 w; w.x = cvt_pk_bf16(t0[0], t0[1]); w.y = cvt_pk_bf16(t0[2], t0[3]); w.z = cvt_pk_bf16(t1[0], t1[1]); w.w = cvt_pk_bf16(t1[2], t1[3]);
                        *(u32x4*)(outb + (size_t)row * ldc + c) = w; }
                }
                asm volatile("" ::: "memory");
            }
    }
};
struct EpiMerge {
    static constexpr bool PERM = true, AFTER_DRAIN = false;
    const bf16_t* gate; int ldg; const bf16_t* z0; const bf16_t* z1; bf16_t* outb; int ldc;
    __device__ __forceinline__ void operator()(const f32x4 (&acc)[2][2][4][2], const Unit& u, int wr, int wc, int fr, int fq) const {
        const int row0 = u.pm * BM + wr * 64 + fr, col0 = u.pn * BM + wc * 32 + 8 * fq;
#pragma unroll
        for (int ai = 0; ai < 2; ++ai)
#pragma unroll
            for (int m = 0; m < 4; ++m) {
                const int row = row0 + ai * HALF + m * 16;
                u32x4 g0[2], g1[2], g2[2], a0[2], a1[2];
#pragma unroll
                for (int bj = 0; bj < 2; ++bj) { const int c = col0 + bj * HALF; const bf16_t* gp = gate + (size_t)row * ldg + c;
                    g0[bj] = *(const u32x4*)gp; g1[bj] = *(const u32x4*)(gp + 2048); g2[bj] = *(const u32x4*)(gp + 4096);
                    a0[bj] = *(const u32x4*)(z0 + (size_t)row * ldc + c); a1[bj] = *(const u32x4*)(z1 + (size_t)row * ldc + c); }
#pragma unroll
                for (int bj = 0; bj < 2; ++bj) {
                    const unsigned G0[4] = {g0[bj].x, g0[bj].y, g0[bj].z, g0[bj].w}, G1[4] = {g1[bj].x, g1[bj].y, g1[bj].z, g1[bj].w}, G2[4] = {g2[bj].x, g2[bj].y, g2[bj].z, g2[bj].w};
                    const unsigned A0[4] = {a0[bj].x, a0[bj].y, a0[bj].z, a0[bj].w}, A1[4] = {a1[bj].x, a1[bj].y, a1[bj].z, a1[bj].w};
                    unsigned w[4];
#pragma unroll
                    for (int k = 0; k < 4; ++k) {
                        const float lo = bf_lo(G0[k]) * bf_lo(A0[k]) + bf_lo(G1[k]) * bf_lo(A1[k]) + bf_lo(G2[k]) * acc[ai][bj][m][k >> 1][2 * (k & 1)];
                        const float hi = bf_hi(G0[k]) * bf_hi(A0[k]) + bf_hi(G1[k]) * bf_hi(A1[k]) + bf_hi(G2[k]) * acc[ai][bj][m][k >> 1][2 * (k & 1) + 1];
                        w[k] = cvt_pk_bf16(lo, hi); }
                    *(u32x4*)(outb + (size_t)row * ldc + col0 + bj * HALF) = (u32x4){w[0], w[1], w[2], w[3]};
                }
                asm volatile("" ::: "memory");
            }
    }
};
struct EpiBf16 {
    static constexpr bool PERM = true, AFTER_DRAIN = false;
    bf16_t* C; int ldc;
    __device__ __forceinline__ void operator()(const f32x4 (&acc)[2][2][4][2], const Unit& u, int wr, int wc, int fr, int fq) const {
        const int row0 = u.pm * BM + wr * 64 + fr, col0 = u.pn * BM + wc * 32 + 8 * fq;
#pragma unroll
        for (int ai = 0; ai < 2; ++ai)
#pragma unroll
            for (int m = 0; m < 4; ++m) {
                bf16_t* rowp = C + (size_t)(row0 + ai * HALF + m * 16) * ldc + col0;
#pragma unroll
                for (int bj = 0; bj < 2; ++bj) {
                    const f32x4 v0 = acc[ai][bj][m][0] + 0.0f, v1 = acc[ai][bj][m][1] + 0.0f;
                    u32x4 w; w.x = cvt_pk_bf16(v0[0], v0[1]); w.y = cvt_pk_bf16(v0[2], v0[3]); w.z = cvt_pk_bf16(v1[0], v1[1]); w.w = cvt_pk_bf16(v1[2], v1[3]);
                    *(u32x4*)(rowp + bj * HALF) = w;
                }
            }
    }
};

template <class Epi, class Sched, bool ALIGN_EPI = false, bool SP2 = false>
__device__ __forceinline__ void gemm_phase(PG8_LAS unsigned char* lds, const Gemm g, const Sched& S, const Epi& E, const int tid) {
    const int wid = __builtin_amdgcn_readfirstlane(tid >> 6), lane = tid & 63, wr = wid >> 2, wc = wid & 3, fr = lane & 15, fq = lane >> 4;
    const int K = g.K, nt = K / BK;
    unsigned voffA[2], voffB[2];
#pragma unroll
    for (int i = 0; i < 2; ++i) { int R, C; stage_rc(tid * 16 + i * 8192, R, C); const int Rb = Epi::PERM ? ((R & ~31) + perm32(R & 31)) : R;
        voffA[i] = (unsigned)(R * g.lda + C) * 2u; voffB[i] = (unsigned)(Rb * g.ldb + C) * 2u; }
    const size_t kstep = (size_t)(BK * 2);
    const size_t hstepA = (size_t)HALF * g.lda * 2, hstepB = (size_t)HALF * g.ldb * 2;
    const size_t tstepA = 2 * hstepA, tstepB = 2 * hstepB;
    const unsigned ldsw = (unsigned)wid * 1024u;
    const int aoff = lds_byte(wr * 64 + fr, fq * 8), boff = lds_byte(wc * 32 + fr, fq * 8);
#define PG8_SA(b, h) (((b) * 2 + (h)) * HTB)
#define PG8_SB(b, h) ((4 + (b) * 2 + (h)) * HTB)
#define PG8_STAGE(bufoff, gbase, voff) do { _Pragma("unroll") for (int _i = 0; _i < 2; ++_i) \
        __builtin_amdgcn_global_load_lds((const unsigned*)((const char*)(gbase) + (voff)[_i]), (PG8_LAS unsigned*)(lds + (bufoff) + ldsw + _i * 8192), 16, 0, 0); } while (0)
#define PG8_LDA(dst, b, h) do { _Pragma("unroll") for (int m = 0; m < 4; ++m) _Pragma("unroll") for (int k = 0; k < 2; ++k) dst[m][k] = *(const PG8_LAS bf16x8*)(lds + PG8_SA(b, h) + aoff + m * 2048 + k * 1024); } while (0)
#define PG8_LDB(dst, b, h) do { _Pragma("unroll") for (int n = 0; n < 2; ++n) _Pragma("unroll") for (int k = 0; k < 2; ++k) dst[n][k] = *(const PG8_LAS bf16x8*)(lds + PG8_SB(b, h) + boff + n * 2048 + k * 1024); } while (0)
#define PG8_MMA(ai, bj, At, Bt) do { __builtin_amdgcn_s_setprio(1); _Pragma("unroll") for (int m = 0; m < 4; ++m) _Pragma("unroll") for (int n = 0; n < 2; ++n) _Pragma("unroll") for (int k = 0; k < 2; ++k) \
        acc[ai][bj][m][n] = __builtin_amdgcn_mfma_f32_16x16x32_bf16(Bt[n][k], At[m][k], acc[ai][bj][m][n], 0, 0, 0); __builtin_amdgcn_s_setprio(0); } while (0)
#define PG8_WAIT_V(n) asm volatile("s_waitcnt vmcnt(" #n ")" ::: "memory")
#define PG8_WAIT_L(n) asm volatile("s_waitcnt lgkmcnt(" #n ")" ::: "memory")
#define PG8_BAR __builtin_amdgcn_s_barrier()
#define PG8_SCHED __builtin_amdgcn_sched_barrier(0)
    Unit cur, nxt; int ui = 0;
    if (!S.next(0, cur)) return;
    f32x4 acc[2][2][4][2];
#pragma unroll
    for (int a = 0; a < 2; ++a)
#pragma unroll
        for (int b = 0; b < 2; ++b)
#pragma unroll
            for (int m = 0; m < 4; ++m)
#pragma unroll
                for (int n = 0; n < 2; ++n) acc[a][b][m][n] = (f32x4){0.f, 0.f, 0.f, 0.f};
    bf16x8 At[4][2], B0[2][2], B1[2][2];
    const char* cA = (const char*)g.A + (size_t)cur.pm * tstepA; const char* cB = (const char*)g.Bt + (size_t)cur.pn * tstepB;
    S.a_ready(cur);
    if constexpr (SP2) {
        PG8_STAGE(PG8_SB(0, 0), cB, voffB); PG8_STAGE(PG8_SB(0, 1), cB + hstepB, voffB); PG8_STAGE(PG8_SA(0, 0), cA, voffA); PG8_STAGE(PG8_SA(0, 1), cA + hstepA, voffA);
        if (wr == 1) PG8_BAR;
        PG8_WAIT_V(2); PG8_BAR;
        PG8_STAGE(PG8_SB(1, 0), cB + kstep, voffB); PG8_STAGE(PG8_SA(1, 0), cA + kstep, voffA); PG8_STAGE(PG8_SB(1, 1), cB + hstepB + kstep, voffB);
        PG8_WAIT_V(6); PG8_BAR;
    } else {
        PG8_STAGE(PG8_SB(0, 0), cB, voffB); PG8_STAGE(PG8_SA(0, 0), cA, voffA); PG8_STAGE(PG8_SB(0, 1), cB + hstepB, voffB); PG8_STAGE(PG8_SA(0, 1), cA + hstepA, voffA);
        if (wr == 1) PG8_BAR;
        PG8_WAIT_V(4); PG8_BAR;
        PG8_STAGE(PG8_SB(1, 0), cB + kstep, voffB); PG8_STAGE(PG8_SA(1, 0), cA + kstep, voffA); PG8_STAGE(PG8_SB(1, 1), cB + hstepB + kstep, voffB);
        PG8_WAIT_V(6); PG8_BAR;
    }
    for (;;) {
        const bool has_next = S.next(ui + 1, nxt);
        const char* nA = has_next ? (const char*)g.A + (size_t)nxt.pm * tstepA : cA; const char* nB = has_next ? (const char*)g.Bt + (size_t)nxt.pn * tstepB : cB;
        for (int t = 0; t < nt; t += 2) {
            const bool last = (t == nt - 2);
            const char* a1 = cA + (size_t)(t + 1) * kstep;
            const char* a2 = last ? nA : cA + (size_t)(t + 2) * kstep; const char* b2 = last ? nB : cB + (size_t)(t + 2) * kstep;
            const char* a3 = a2 + kstep; const char* b3 = b2 + kstep;
            if (last && has_next) S.a_ready(nxt);
            if constexpr (SP2) {
            PG8_LDB(B0, 0, 0); PG8_LDB(B1, 0, 1); PG8_SCHED; PG8_LDA(At, 0, 0); PG8_STAGE(PG8_SA(1, 1), a1 + hstepA, voffA);
            PG8_WAIT_V(8); PG8_WAIT_L(0); PG8_BAR; PG8_MMA(0, 0, At, B0); PG8_MMA(0, 1, At, B1); PG8_BAR; PG8_SCHED;
            PG8_LDA(At, 0, 1); PG8_STAGE(PG8_SB(0, 0), b2, voffB); PG8_STAGE(PG8_SB(0, 1), b2 + hstepB, voffB); PG8_STAGE(PG8_SA(0, 0), a2, voffA);
            PG8_WAIT_V(8); PG8_WAIT_L(0); PG8_BAR; PG8_MMA(1, 0, At, B0); PG8_MMA(1, 1, At, B1); PG8_BAR; PG8_SCHED;
            PG8_LDB(B0, 1, 0); PG8_LDB(B1, 1, 1); PG8_SCHED; PG8_LDA(At, 1, 0); PG8_STAGE(PG8_SA(0, 1), a2 + hstepA, voffA);
            PG8_WAIT_V(8); PG8_WAIT_L(0); PG8_BAR; PG8_MMA(0, 0, At, B0); PG8_MMA(0, 1, At, B1); PG8_BAR; PG8_SCHED;
            PG8_LDA(At, 1, 1); PG8_STAGE(PG8_SB(1, 0), b3, voffB); PG8_STAGE(PG8_SB(1, 1), b3 + hstepB, voffB); PG8_STAGE(PG8_SA(1, 0), a3, voffA);
            PG8_WAIT_V(8); PG8_WAIT_L(0); PG8_BAR; PG8_MMA(1, 0, At, B0); PG8_MMA(1, 1, At, B1); PG8_BAR; PG8_SCHED;
            } else {
            PG8_LDB(B0, 0, 0); PG8_SCHED; PG8_LDA(At, 0, 0); PG8_STAGE(PG8_SA(1, 1), a1 + hstepA, voffA);
            PG8_WAIT_L(8); PG8_BAR; PG8_WAIT_L(0); PG8_MMA(0, 0, At, B0); PG8_BAR; PG8_SCHED;
            PG8_LDB(B1, 0, 1); PG8_STAGE(PG8_SB(0, 0), b2, voffB);
            PG8_BAR; PG8_WAIT_L(0); PG8_MMA(0, 1, At, B1); PG8_BAR;
            PG8_LDA(At, 0, 1); PG8_STAGE(PG8_SA(0, 0), a2, voffA);
            PG8_BAR; PG8_WAIT_L(0); PG8_MMA(1, 0, At, B0); PG8_BAR; PG8_SCHED;
            PG8_STAGE(PG8_SB(0, 1), b2 + hstepB, voffB);
            PG8_WAIT_V(6); PG8_BAR; PG8_MMA(1, 1, At, B1); PG8_BAR;
            PG8_LDB(B0, 1, 0); PG8_SCHED; PG8_LDA(At, 1, 0); PG8_STAGE(PG8_SA(0, 1), a2 + hstepA, voffA);
            PG8_WAIT_L(8); PG8_BAR; PG8_WAIT_L(0); PG8_MMA(0, 0, At, B0); PG8_BAR; PG8_SCHED;
            PG8_LDB(B1, 1, 1); PG8_STAGE(PG8_SB(1, 0), b3, voffB);
            PG8_BAR; PG8_WAIT_L(0); PG8_MMA(0, 1, At, B1); PG8_BAR;
            PG8_LDA(At, 1, 1); PG8_STAGE(PG8_SA(1, 0), a3, voffA);
            PG8_BAR; PG8_WAIT_L(0); PG8_MMA(1, 0, At, B0); PG8_BAR; PG8_SCHED;
            PG8_STAGE(PG8_SB(1, 1), b3 + hstepB, voffB);
            PG8_WAIT_V(6); PG8_BAR; PG8_MMA(1, 1, At, B1); PG8_BAR;
            }
        }
        if constexpr (ALIGN_EPI) { if (wr == 0) PG8_BAR; }
        if constexpr (!Epi::AFTER_DRAIN) { E(acc, cur, wr, wc, fr, fq); S.done(cur); }
        if (!has_next) break;
#pragma unroll
        for (int a = 0; a < 2; ++a)
#pragma unroll
            for (int b = 0; b < 2; ++b)
#pragma unroll
                for (int m = 0; m < 4; ++m)
#pragma unroll
                    for (int n = 0; n < 2; ++n) acc[a][b][m][n] = (f32x4){0.f, 0.f, 0.f, 0.f};
        cur = nxt; cA = nA; cB = nB; ++ui;
        if constexpr (ALIGN_EPI) { if (wr == 1) PG8_BAR; }
    }
    PG8_WAIT_V(0);
    if constexpr (!ALIGN_EPI) { if (wr == 0) PG8_BAR; }
    PG8_BAR;
    if constexpr (Epi::AFTER_DRAIN) { E.fused(acc, cur, wr, wc, fr, fq, lds, wid, lane); S.done(cur); }
#undef PG8_SA
#undef PG8_SB
#undef PG8_STAGE
#undef PG8_LDA
#undef PG8_LDB
#undef PG8_MMA
#undef PG8_WAIT_V
#undef PG8_WAIT_L
#undef PG8_BAR
#undef PG8_SCHED
}
}

constexpr int BATCH = 2, SEQ = 8192, M = BATCH * SEQ, DM = 2048, DFF = 5504, NMEM = 256, DEPTH = 2;
constexpr int DIN = 11076, DIN_PAD = 11264, PLD = 11008;
constexpr int C_QA = 0, C_KA = 1024, C_VA = 1280, C_QI = 1536, C_XL = 1792, C_GL = 2816, C_QM = 3840, C_GT = 4864;
constexpr float EPS = 1e-6f, LOG2E = 1.4426950408889634f;

constexpr size_t MiB = 1u << 20;
constexpr size_t WS_CTL = 0, CTL_ZERO_BYTES = 1 * MiB;
constexpr size_t WS_WGU = 2 * MiB, WS_WDN = 45 * MiB, WS_WIN = 67 * MiB, WS_WMKV = 111 * MiB, WS_WBR = 119 * MiB, WS_WOUT = 131 * MiB;
constexpr size_t WS_WGU2 = 139 * MiB, WS_WDN2 = 182 * MiB, WS_WAT = 204 * MiB, WS_WIT = 204 * MiB + 512 * 1024;
constexpr size_t WS_XN = 206 * MiB, WS_R1 = 270 * MiB, WS_SCR = 614 * MiB, WS_SIDE = 742 * MiB, WS_KIDX = 747 * MiB, WS_WIDX = 749 * MiB;
constexpr size_t WS_MASK = 750 * MiB, WS_VT = 766 * MiB, WS_MK = 774 * MiB, WS_VTM = 775 * MiB, WS_MEMN = 776 * MiB, WS_AGG = 778 * MiB, WS_END = 780 * MiB;
constexpr int CW_BAR = 4096;

constexpr int LDS_BYTES = 163840, MISC_OFF = LDS_BYTES - 256;

#define LAS __attribute__((address_space(3)))
typedef unsigned short bf16;
typedef short bf16x8 __attribute__((ext_vector_type(8)));
typedef float f32x4 __attribute__((ext_vector_type(4)));
typedef float f32x16 __attribute__((ext_vector_type(16)));
typedef unsigned u32x4 __attribute__((ext_vector_type(4)));
typedef unsigned u32x2 __attribute__((ext_vector_type(2)));
#define LDS_WAIT() asm volatile("s_waitcnt lgkmcnt(0)" ::: "memory")
#define VM_WAIT() asm volatile("s_waitcnt vmcnt(0)" ::: "memory")
__device__ __forceinline__ unsigned f2bf(float f) { unsigned u = __builtin_bit_cast(unsigned, f); return (u + 0x7fffu + ((u >> 16) & 1u)) >> 16; }
__device__ __forceinline__ unsigned pk2(float lo, float hi) { return f2bf(lo) | (f2bf(hi) << 16); }
__device__ __forceinline__ unsigned pkbf(float lo, float hi) { unsigned r; asm("v_cvt_pk_bf16_f32 %0, %1, %2" : "=v"(r) : "v"(lo), "v"(hi)); return r; }
__device__ __forceinline__ float bflo(unsigned w) { return __uint_as_float(w << 16); }
__device__ __forceinline__ float bfhi(unsigned w) { return __uint_as_float(w & 0xffff0000u); }

#define XB_TMO      128
#define XB_XCNT(j)  (256  + 64 * (j))
#define XB_XSUB(j)  (1280 + 64 * (j))
#define XB_XGEN(j)  (2304 + 64 * (j))
#define XB_TOP      3328
#define XB_TOPGEN   3392
#define XCD_BAR_WORDS 3456
#define XB_SPIN_CAP (1u << 18)

__device__ __forceinline__ unsigned xb_ld(unsigned* p)              { return __hip_atomic_load(p, __ATOMIC_RELAXED, __HIP_MEMORY_SCOPE_AGENT); }
__device__ __forceinline__ unsigned xb_add(unsigned* p, unsigned v) { return __hip_atomic_fetch_add(p, v, __ATOMIC_RELAXED, __HIP_MEMORY_SCOPE_AGENT); }
__device__ __forceinline__ unsigned xb_xcc_id() { return (unsigned)__builtin_amdgcn_s_getreg((3 << 11) | 20) & 0xFu; }
#define XB_SPIN(cond, bar) do { unsigned _sp = 0; while (cond) { __builtin_amdgcn_s_sleep(1); \
    if ((++_sp & 255u) == 0u) { if (xb_ld(&(bar)[XB_TMO])) break; if (_sp > XB_SPIN_CAP) { atomicAdd(&(bar)[XB_TMO], 1u); break; } } } } while (0)

struct XcdBarrier {
    unsigned* bar; unsigned x;
    volatile LAS unsigned* st;
};
__device__ __forceinline__ XcdBarrier xcd_barrier_post(unsigned* bar, volatile LAS unsigned* st) {
    XcdBarrier b; b.bar = bar; b.x = xb_xcc_id(); b.st = st;
    if (threadIdx.x == 0) (void)xb_add(&bar[XB_XCNT(b.x)], 1u);
    return b;
}
__device__ __forceinline__ void xcd_barrier_complete(unsigned* bar, unsigned x, unsigned& nloc, unsigned& nx) {
    const unsigned G = gridDim.x * gridDim.y * gridDim.z;
    unsigned sum, cnt, mine, sp = 0u;
    for (;;) {
        sum = 0u; cnt = 0u; mine = 0u;
#pragma unroll
        for (unsigned j = 0; j < 16; ++j) { const unsigned c = xb_ld(&bar[XB_XCNT(j)]); sum += c; cnt += (c > 0u) ? 1u : 0u; mine = (j == x) ? c : mine; }
        if (sum == G) break;
        __builtin_amdgcn_s_sleep(1);
        if ((++sp & 255u) == 0u) { if (xb_ld(&bar[XB_TMO])) break; if (sp > XB_SPIN_CAP) { atomicAdd(&bar[XB_TMO], 1u); break; } }
    }
    nloc = mine > 0u ? mine : 1u; nx = cnt > 0u ? cnt : 1u;
}
__device__ __forceinline__ void xcd_barrier(const XcdBarrier& b) {
    asm volatile("s_waitcnt vmcnt(0)" ::: "memory");
    __syncthreads();
    if (threadIdx.x == 0) {
        unsigned* bar = b.bar;
        __builtin_amdgcn_s_waitcnt(0);
        unsigned nloc = b.st[0], nx = b.st[1];
        if (nloc == 0u) { xcd_barrier_complete(bar, b.x, nloc, nx); b.st[0] = nloc; b.st[1] = nx; }
        const unsigned old = xb_add(&bar[XB_XSUB(b.x)], 1u);
        const unsigned gen = old / nloc;
        if (old + 1u == (gen + 1u) * nloc) {
            __builtin_amdgcn_fence(__ATOMIC_RELEASE, "agent");
            asm volatile("s_waitcnt vmcnt(0)" ::: "memory");
            const unsigned og = xb_add(&bar[XB_TOP], 1u);
            const unsigned tg = og / nx;
            if (og + 1u == (tg + 1u) * nx) xb_add(&bar[XB_TOPGEN], 1u);
            else XB_SPIN(xb_ld(&bar[XB_TOPGEN]) == tg, bar);
            __builtin_amdgcn_fence(__ATOMIC_ACQUIRE, "agent");
            xb_add(&bar[XB_XGEN(b.x)], 1u);
            asm volatile("s_waitcnt vmcnt(0)" ::: "memory");
        } else {
            XB_SPIN(xb_ld(&bar[XB_XGEN(b.x)]) == gen, bar);
            __builtin_amdgcn_fence(__ATOMIC_ACQUIRE, "agent");
            asm volatile("s_waitcnt vmcnt(0)" ::: "memory");
        }
    }
    __syncthreads();
}

#define GAS __attribute__((address_space(1)))
struct Params { const GAS float* in[25]; GAS float* out; GAS unsigned char* ws; };
typedef const Params __attribute__((address_space(4)))* KP;
__device__ __forceinline__ KP kargs() { KP k = (KP)__builtin_amdgcn_kernarg_segment_ptr(); asm volatile("" : "+s"(k)); return k; }
__device__ __forceinline__ const float* gin(KP k, int i) { return (const float*)k->in[i]; }
__device__ __forceinline__ float* gout(KP k) { return (float*)k->out; }
__device__ __forceinline__ unsigned char* gws(KP k) { return (unsigned char*)k->ws; }
__device__ __forceinline__ int lane_id_asm() { int l; asm volatile("v_mbcnt_lo_u32_b32 %0, -1, 0\n\tv_mbcnt_hi_u32_b32 %0, -1, %0" : "=v"(l)); return l; }
__device__ __forceinline__ int launder_s(int v) { asm volatile("" : "+s"(v)); return v; }
__device__ __forceinline__ int launder_v(int v) { asm volatile("" : "+v"(v)); return v; }
enum { I_X = 0, I_MEM, I_RELB, I_FNORM, I_NFF1, I_WGU1, I_WDN1, I_NMIX, I_WIN, I_CONVW, I_CONVB, I_WA, I_BA, I_WI, I_BI, I_LAM, I_LNG, I_LNB, I_MEMNORM, I_WMKV, I_WBR, I_WOUT, I_NFF2, I_WGU2, I_WDN2 };

__device__ __forceinline__ float wave_sum(float v) {
#pragma unroll
    for (int o = 1; o < 64; o <<= 1) v += __shfl_xor(v, o);
    return v;
}
__device__ __forceinline__ f32x4 mfma16(bf16x8 a, bf16x8 b, f32x4 c) { return __builtin_amdgcn_mfma_f32_16x16x32_bf16(a, b, c, 0, 0, 0); }
__device__ __forceinline__ f32x16 mfma32(bf16x8 a, bf16x8 b, f32x16 c) { return __builtin_amdgcn_mfma_f32_32x32x16_bf16(a, b, c, 0, 0, 0); }

__device__ __forceinline__ void tr_item(const float* W, int ldw, int scol0, int nvalid, bf16* WT, int ldt, int drow0, int k0, LAS float* scr, int lane) {
    if (nvalid == 32) {
#pragma unroll
        for (int i = 0; i < 8; ++i) { const int kk = 8 * i + (lane >> 3), c4 = (lane & 7) * 4;
            const f32x4 v = *(const f32x4*)(W + (size_t)(k0 + kk) * ldw + scol0 + c4);
            LAS float* d = scr + kk * 33 + c4; d[0] = v.x; d[1] = v.y; d[2] = v.z; d[3] = v.w; }
    } else {
#pragma unroll 8
        for (int i = 0; i < 32; ++i) { const int kk = 2 * i + (lane >> 5), c = lane & 31; scr[kk * 33 + c] = (c < nvalid) ? W[(size_t)(k0 + kk) * ldw + scol0 + c] : 0.f; }
    }
    LDS_WAIT(); asm volatile("" ::: "memory");
    const int c = lane & 7;
#pragma unroll
    for (int j = 0; j < 4; ++j) { const int n = (lane >> 3) + 8 * j; const LAS float* s = scr + (8 * c) * 33 + n;
        u32x4 o; o.x = pkbf(s[0 * 33], s[1 * 33]); o.y = pkbf(s[2 * 33], s[3 * 33]); o.z = pkbf(s[4 * 33], s[5 * 33]); o.w = pkbf(s[6 * 33], s[7 * 33]);
        *(u32x4*)(WT + (size_t)(drow0 + n) * ldt + k0 + 8 * c) = o; }
    LDS_WAIT(); asm volatile("" ::: "memory");
}
__device__ __forceinline__ void tr_plain(const float* W, int K, int N, bf16* WT, int item, LAS float* scr, int lane) {
    const int nblk = N / 32, kb = item / nblk, nb = item % nblk;
    tr_item(W, N, 32 * nb, 32, WT, K, 32 * nb, 64 * kb, scr, lane);
}
__device__ __forceinline__ void tr_gu(const float* W, bf16* WT, int item, LAS float* scr, int lane) {
    const int nblk = 2 * DFF / 32, kb = item / nblk, nb = item % nblk, n0 = 32 * nb, T = n0 >> 8, wi = n0 & 255;
    const int sc = wi < 128 ? 128 * T + wi : DFF + 128 * T + (wi - 128);
    tr_item(W, 2 * DFF, sc, 32, WT, DM, n0, 64 * kb, scr, lane);
}
__device__ __forceinline__ void tr_win(const float* W, bf16* WT, int item, LAS float* scr, int lane) {
    const int nblk = DIN_PAD / 32, kb = item / nblk, nb = item % nblk, n0 = 32 * nb;
    int sc, nv;
    if (n0 < 1792) { sc = n0; nv = 32; }
    else if (n0 < 2048) { const int off = n0 - 1792; sc = 1792 + off; nv = 68 - off; nv = nv < 0 ? 0 : (nv > 32 ? 32 : nv); if (nv == 0) sc = 0; }
    else { sc = n0 - 188; nv = 32; }
    tr_item(W, DIN, sc, nv, WT, DM, n0, 64 * kb, scr, lane);
}

__device__ __forceinline__ void rms_row_bf16(const float* xrow, const float* g, bf16* orow, int lane) {
    const f32x4* xr = (const f32x4*)xrow + lane; const f32x4* gr = (const f32x4*)g + lane;
    f32x4 v[8]; float s = 0.f;
#pragma unroll
    for (int j = 0; j < 8; ++j) { v[j] = xr[64 * j]; s += (v[j].x * v[j].x + v[j].y * v[j].y) + (v[j].z * v[j].z + v[j].w * v[j].w); }
    const float rstd = 1.0f / sqrtf(wave_sum(s) * (1.0f / DM) + EPS);
    u32x2* o8 = (u32x2*)orow + lane;
#pragma unroll
    for (int j = 0; j < 8; ++j) { const f32x4 gg = gr[64 * j]; u32x2 w; w.x = pk2(v[j].x * rstd * gg.x, v[j].y * rstd * gg.y); w.y = pk2(v[j].z * rstd * gg.z, v[j].w * rstd * gg.w); o8[64 * j] = w; }
}
__device__ __forceinline__ void rms_rows_bf16(const float* x, const float* g, bf16* out, int gw, int NGW, int lane) {
    const f32x4* gr = (const f32x4*)g + lane;
    f32x4 gg[8];
#pragma unroll
    for (int j = 0; j < 8; ++j) gg[j] = gr[64 * j];
    for (int m = gw; m < M; m += 4 * NGW) {
        f32x4 v[4][8]; float ss[4];
#pragma unroll
        for (int r = 0; r < 4; ++r) { const int mr = (m + r * NGW < M) ? m + r * NGW : m; const f32x4* xr = (const f32x4*)(x + (size_t)mr * DM) + lane;
#pragma unroll
            for (int j = 0; j < 8; ++j) v[r][j] = xr[64 * j]; }
#pragma unroll
        for (int r = 0; r < 4; ++r) { float s = 0.f;
#pragma unroll
            for (int j = 0; j < 8; ++j) s += (v[r][j].x * v[r][j].x + v[r][j].y * v[r][j].y) + (v[r][j].z * v[r][j].z + v[r][j].w * v[r][j].w);
            ss[r] = 1.0f / sqrtf(wave_sum(s) * (1.0f / DM) + EPS); }
#pragma unroll
        for (int r = 0; r < 4; ++r) if (m + r * NGW < M) { u32x2* o = (u32x2*)(out + (size_t)(m + r * NGW) * DM) + lane;
#pragma unroll
            for (int j = 0; j < 8; ++j) { u32x2 w; w.x = pkbf(v[r][j].x * ss[r] * gg[j].x, v[r][j].y * ss[r] * gg[j].y); w.y = pkbf(v[r][j].z * ss[r] * gg[j].z, v[r][j].w * ss[r] * gg[j].w); o[64 * j] = w; } }
    }
}
__device__ __forceinline__ void rms_row_f32(const float* xrow, const float* g, float* orow, int lane) {
    const f32x4* xr = (const f32x4*)xrow + lane; const f32x4* gr = (const f32x4*)g + lane;
    f32x4 v[8]; float s = 0.f;
#pragma unroll
    for (int j = 0; j < 8; ++j) { v[j] = xr[64 * j]; s += (v[j].x * v[j].x + v[j].y * v[j].y) + (v[j].z * v[j].z + v[j].w * v[j].w); }
    const float rstd = 1.0f / sqrtf(wave_sum(s) * (1.0f / DM) + EPS);
    f32x4* o = (f32x4*)orow + lane;
#pragma unroll
    for (int j = 0; j < 8; ++j) { const f32x4 gg = gr[64 * j]; o[64 * j] = v[j] * rstd * gg; }
}

template <class SC> __device__ __forceinline__ void tr_wg_item(const float* W, int ldw, SC scol, bf16* WT, int ldt, int drow0, int k0, LAS unsigned char* ldsb, int tid, int lane, int wave) {
    LAS float* tile = (LAS float*)ldsb;
    const int run = lane >> 3, c4 = (lane & 7) * 4;
    int sc, nv; scol(run, sc, nv);
    f32x4 v[16];
#pragma unroll
    for (int i = 0; i < 16; ++i) { const int kk = wave * 16 + i;
        v[i] = (f32x4){0.f, 0.f, 0.f, 0.f};
        if (nv == 32) v[i] = *(const f32x4*)(W + (size_t)(k0 + kk) * ldw + sc + c4);
        else { const float* src = W + (size_t)(k0 + kk) * ldw + sc; if (c4 + 0 < nv) v[i].x = src[c4]; if (c4 + 1 < nv) v[i].y = src[c4 + 1]; if (c4 + 2 < nv) v[i].z = src[c4 + 2]; if (c4 + 3 < nv) v[i].w = src[c4 + 3]; } }
#pragma unroll
    for (int i = 0; i < 16; ++i) { LAS float* o = tile + (wave * 16 + i) * 257 + run * 32 + c4; o[0] = v[i].x; o[1] = v[i].y; o[2] = v[i].z; o[3] = v[i].w; }
    __syncthreads();
    const int c = lane & 15;
#pragma unroll
    for (int j = 0; j < 8; ++j) { const int n = wave * 32 + (lane >> 4) + 4 * j; const LAS float* s = tile + (8 * c) * 257 + n;
        u32x4 o; o.x = pkbf(s[0 * 257], s[1 * 257]); o.y = pkbf(s[2 * 257], s[3 * 257]); o.z = pkbf(s[4 * 257], s[5 * 257]); o.w = pkbf(s[6 * 257], s[7 * 257]);
        *(u32x4*)(WT + (size_t)(drow0 + n) * ldt + k0 + 8 * c) = o; }
    __syncthreads();
}
struct ScPlain { int n0; __device__ __forceinline__ void operator()(int run, int& sc, int& nv) const { sc = n0 + 32 * run; nv = 32; } };
struct ScGu { int T; __device__ __forceinline__ void operator()(int run, int& sc, int& nv) const { sc = run < 4 ? 128 * T + 32 * run : DFF + 128 * T + 32 * (run - 4); nv = 32; } };
struct ScWin { int n0; __device__ __forceinline__ void operator()(int run, int& sc, int& nv) const { const int r0 = n0 + 32 * run;
    if (r0 < 1792) { sc = r0; nv = 32; } else if (r0 < 2048) { const int off = r0 - 1792; sc = 1792 + off; nv = 68 - off; nv = nv < 0 ? 0 : (nv > 32 ? 32 : nv); if (nv == 0) sc = 0; } else { sc = r0 - 188; nv = 32; } } };
__device__ __forceinline__ void phase_cvt(KP p, int l, LAS unsigned char* lds, int vcu_, int G, int gw, int NGW, int wave, int lane_) {
    const int vcu = launder_s(vcu_), lane = launder_v(lane_), tid = wave * 64 + lane;
    unsigned char* ws = gws(p);
    constexpr int J_GU = (DM / 128) * (2 * DFF / 256), J_DN = (DFF / 128) * (DM / 256), J_IN = (DM / 128) * (DIN_PAD / 256), J_SQ = (DM / 128) * (DM / 256), J_BR = (1024 / 128) * (DM / 256);
    constexpr int NJ = 2 * J_GU + 2 * J_DN + J_IN + 2 * J_SQ + 3 * J_BR;
    for (int it = vcu; it < NJ; it += G) {
        int r = it;
        if (r < 2 * J_GU) { const bool sec = r >= J_GU; r -= sec ? J_GU : 0; const int nb = r % (2 * DFF / 256), kb = r / (2 * DFF / 256);
            tr_wg_item(gin(p, sec ? I_WGU2 : I_WGU1) + (size_t)l * DM * 2 * DFF, 2 * DFF, ScGu{nb}, (bf16*)(ws + (sec ? WS_WGU2 : WS_WGU)), DM, 256 * nb, 128 * kb, lds, tid, lane, wave); continue; }
        r -= 2 * J_GU;
        if (r < 2 * J_DN) { const bool sec = r >= J_DN; r -= sec ? J_DN : 0; const int nb = r % (DM / 256), kb = r / (DM / 256);
            tr_wg_item(gin(p, sec ? I_WDN2 : I_WDN1) + (size_t)l * DFF * DM, DM, ScPlain{256 * nb}, (bf16*)(ws + (sec ? WS_WDN2 : WS_WDN)), DFF, 256 * nb, 128 * kb, lds, tid, lane, wave); continue; }
        r -= 2 * J_DN;
        if (r < J_IN) { const int nb = r % (DIN_PAD / 256), kb = r / (DIN_PAD / 256);
            tr_wg_item(gin(p, I_WIN) + (size_t)l * DM * DIN, DIN, ScWin{256 * nb}, (bf16*)(ws + WS_WIN), DM, 256 * nb, 128 * kb, lds, tid, lane, wave); continue; }
        r -= J_IN;
        if (r < 2 * J_SQ) { const bool sec = r >= J_SQ; r -= sec ? J_SQ : 0; const int nb = r % (DM / 256), kb = r / (DM / 256);
            tr_wg_item(gin(p, sec ? I_WOUT : I_WMKV) + (size_t)l * DM * DM, DM, ScPlain{256 * nb}, (bf16*)(ws + (sec ? WS_WOUT : WS_WMKV)), DM, 256 * nb, 128 * kb, lds, tid, lane, wave); continue; }
        r -= 2 * J_SQ;
        { const int j = r / J_BR, rr = r % J_BR, nb = rr % (DM / 256), kb = rr / (DM / 256);
          tr_wg_item(gin(p, I_WBR) + ((size_t)l * 3 + j) * 1024 * DM, DM, ScPlain{256 * nb}, (bf16*)(ws + WS_WBR) + (size_t)j * DM * 1024, 1024, 256 * nb, 128 * kb, lds, tid, lane, wave); }
    }
    { __syncthreads(); LAS float* scr = (LAS float*)(lds + wave * 8704);
      for (int it = gw; it < 16 * 8; it += NGW) { const int mtx = it >> 3, n = mtx & 7; const bool isI = mtx >= 8;
          tr_plain(gin(p, isI ? I_WI : I_WA) + ((size_t)l * 8 + n) * 128 * 128, 128, 128, (bf16*)(ws + (isI ? WS_WIT : WS_WAT)) + (size_t)n * 128 * 128, it & 7, scr, lane); } }
    for (int m = gw; m < BATCH * NMEM; m += NGW) rms_row_bf16(gin(p, I_MEM) + (size_t)m * DM, gin(p, I_MEMNORM) + (size_t)l * DM, (bf16*)(ws + WS_MEMN) + (size_t)m * DM, lane);
}

__device__ __forceinline__ float row_bcast15(float v) { return __builtin_bit_cast(float, __builtin_amdgcn_update_dpp(0, __builtin_bit_cast(int, v), 0x15F, 0xF, 0xF, false)); }
__device__ __forceinline__ float xmax32(float v) { auto rr = __builtin_amdgcn_permlane32_swap(__float_as_uint(v), __float_as_uint(v), false, false); return fmaxf(__uint_as_float(rr[0]), __uint_as_float(rr[1])); }
__device__ __forceinline__ float xadd32(float v) { auto rr = __builtin_amdgcn_permlane32_swap(__float_as_uint(v), __float_as_uint(v), false, false); return __uint_as_float(rr[0]) + __uint_as_float(rr[1]); }
__device__ __forceinline__ unsigned xor32_or(unsigned v) { auto rr = __builtin_amdgcn_permlane32_swap(v, v, false, false); return rr[0] | rr[1]; }
__device__ __forceinline__ unsigned xor16_or(unsigned v) { auto rr = __builtin_amdgcn_permlane16_swap(v, v, false, false); return rr[0] | rr[1]; }
template <int N> __device__ __forceinline__ float dpp_shr(float v, float ident) {
    return __builtin_bit_cast(float, __builtin_amdgcn_update_dpp(__builtin_bit_cast(int, ident), __builtin_bit_cast(int, v), 0x110 + N, 0xF, 0xF, false));
}
__device__ __forceinline__ float fsig(float x) { return __builtin_amdgcn_rcpf(1.0f + __builtin_amdgcn_exp2f(-LOG2E * x)); }
__device__ __forceinline__ float gelu_tanh(float x) {
    const float z = 0.7978845608028654f * (x + 0.044715f * x * x * x);
    const float e = __builtin_amdgcn_exp2f(2.0f * LOG2E * z);
    const float t = 1.0f - 2.0f * __builtin_amdgcn_rcpf(e + 1.0f);
    return 0.5f * x * (1.0f + t);
}

__device__ __forceinline__ void kidx_ln_quarter(KP p, int l, int gt) {
    const int row = gt >> 2, q = gt & 3;
    const float* s = (const float*)(gws(p) + WS_SIDE) + (size_t)row * 72 + 16 * q;
    const float* g = gin(p, I_LNG) + l * 64 + 16 * q; const float* be = gin(p, I_LNB) + l * 64 + 16 * q;
    f32x4 v[4]; float mu = 0.f;
#pragma unroll
    for (int i = 0; i < 4; ++i) { v[i] = *(const f32x4*)(s + 4 * i); mu += (v[i].x + v[i].y) + (v[i].z + v[i].w); }
    mu += __shfl_xor(mu, 1); mu += __shfl_xor(mu, 2); mu *= (1.0f / 64.0f);
    float var = 0.f;
#pragma unroll
    for (int i = 0; i < 4; ++i) { v[i] = v[i] - mu; var += (v[i].x * v[i].x + v[i].y * v[i].y) + (v[i].z * v[i].z + v[i].w * v[i].w); }
    var += __shfl_xor(var, 1); var += __shfl_xor(var, 2);
    const float rstd = 1.0f / sqrtf(var * (1.0f / 64.0f) + EPS);
    bf16* o = (bf16*)(gws(p) + WS_KIDX) + (size_t)row * 64 + 16 * q;
    unsigned w[8];
#pragma unroll
    for (int i = 0; i < 4; ++i) { const f32x4 gg = *(const f32x4*)(g + 4 * i), bb = *(const f32x4*)(be + 4 * i);
        w[2 * i] = pk2(v[i].x * rstd * gg.x + bb.x, v[i].y * rstd * gg.y + bb.y); w[2 * i + 1] = pk2(v[i].z * rstd * gg.z + bb.z, v[i].w * rstd * gg.w + bb.w); }
    *(u32x4*)o = (u32x4){w[0], w[1], w[2], w[3]}; *(u32x4*)(o + 8) = (u32x4){w[4], w[5], w[6], w[7]};
    if (q == 0) { const f32x4 wv = *(const f32x4*)(s + 64); *(f32x4*)((float*)(gws(p) + WS_WIDX) + (size_t)row * 4) = wv * 0.0625f; }
}

__device__ __forceinline__ void vt_item(KP p, int item, LAS unsigned char* scrb, int lane) {
    const int db = item & 1, tb = (item >> 1) & 127, kvh = (item >> 8) & 1, b = item >> 9;
    const bf16* P = (const bf16*)(gws(p) + WS_R1);
    LAS unsigned short* scr = (LAS unsigned short*)scrb;
#pragma unroll
    for (int i = 0; i < 8; ++i) {
        const int t = 8 * i + (lane >> 3), ch = lane & 7;
        const u32x4 v = *(const u32x4*)(P + (size_t)(b * SEQ + tb * 64 + t) * PLD + C_VA + kvh * 128 + db * 64 + 8 * ch);
        const unsigned w[4] = {v.x, v.y, v.z, v.w};
#pragma unroll
        for (int j = 0; j < 4; ++j) { scr[(8 * ch + 2 * j) * 66 + t] = (unsigned short)(w[j] & 0xffff); scr[(8 * ch + 2 * j + 1) * 66 + t] = (unsigned short)(w[j] >> 16); }
    }
    LDS_WAIT(); asm volatile("" ::: "memory");
    bf16* VT = (bf16*)(gws(p) + WS_VT);
#pragma unroll
    for (int i = 0; i < 8; ++i) {
        const int d = 8 * i + (lane >> 3), ch = lane & 7;
        const LAS unsigned* s = (const LAS unsigned*)(scr + d * 66 + 8 * ch);
        u32x4 o; o.x = s[0]; o.y = s[1]; o.z = s[2]; o.w = s[3];
        *(u32x4*)(VT + (((size_t)((b * 2 + kvh) * 128 + tb)) * 128 + db * 64 + d) * 64 + 8 * ch) = o;
    }
    LDS_WAIT(); asm volatile("" ::: "memory");
}

constexpr int LR_WA = 0, LR_WI = 34816, LR_PAR = 69632, LR_CARRY = LR_PAR + 9 * 512, LR_COMP = LR_CARRY + 512, LR_FOLD = LR_COMP + 8192;
template <int MODE> __device__ __forceinline__ void lru_job(KP p, int l, int jb, LAS unsigned char* lds, int tid, int lane, int wave, bf16* OB, int old) {
    const int n = jb & 7, jj = jb >> 3, b = jj >> 4, tile0 = 4 * (jj & 15), tok = lane & 15, h = lane >> 4;
    const bf16* P = (const bf16*)(gws(p) + WS_R1);
    float* aggA = (float*)(gws(p) + WS_AGG); float* aggH = aggA + (size_t)BATCH * 64 * 1024;
    LAS float* par = (LAS float*)(lds + LR_PAR);
    LAS float* carry = (LAS float*)(lds + LR_CARRY);
    LAS float* compA = (LAS float*)(lds + LR_COMP); LAS float* compH = compA + 1024;
    __syncthreads();
    {
        const bf16* waT = (const bf16*)(gws(p) + WS_WAT) + (size_t)n * 128 * 128; const bf16* wiT = (const bf16*)(gws(p) + WS_WIT) + (size_t)n * 128 * 128;
#pragma unroll
        for (int i = 0; i < 4; ++i) { const int ci = tid + 512 * i, r = ci >> 4, ch = ci & 15;
            *(LAS u32x4*)(lds + LR_WA + r * 272 + ch * 16) = *(const u32x4*)(waT + r * 128 + ch * 8);
            *(LAS u32x4*)(lds + LR_WI + r * 272 + ch * 16) = *(const u32x4*)(wiT + r * 128 + ch * 8); }
        if (tid < 128) { const int c = n * 128 + tid;
            par[tid] = -8.0f * LOG2E * log1pf(expf(-gin(p, I_LAM)[(size_t)l * 1024 + c]));
            par[128 + tid] = gin(p, I_BA)[(size_t)l * 1024 + c]; par[256 + tid] = gin(p, I_BI)[(size_t)l * 1024 + c]; par[384 + tid] = gin(p, I_CONVB)[(size_t)l * 1024 + c];
#pragma unroll
            for (int j = 0; j < 4; ++j) par[512 + 128 * j + tid] = gin(p, I_CONVW)[((size_t)l * 4 + j) * 1024 + c]; }
        if (MODE == 1) {
            const int ch = tid & 127, part = tid >> 7, q = tile0 >> 2;
            float ca = 1.f, chh = 0.f;
            const float* pa = aggA + ((size_t)b * 64 + part * q) * 1024 + n * 128 + ch; const float* ph = aggH + ((size_t)b * 64 + part * q) * 1024 + n * 128 + ch;
            for (int i = 0; i < q; ++i) { const float a = pa[(size_t)i * 1024], hh = ph[(size_t)i * 1024]; chh = a * chh + hh; ca *= a; }
            LAS float* fold = (LAS float*)(lds + LR_FOLD);
            fold[(part * 128 + ch) * 2] = ca; fold[(part * 128 + ch) * 2 + 1] = chh;
        }
        __syncthreads();
        if (MODE == 1 && tid < 128) { const LAS float* fold = (const LAS float*)(lds + LR_FOLD); float c = 0.f;
#pragma unroll
            for (int part = 0; part < 4; ++part) c = fold[(part * 128 + tid) * 2] * c + fold[(part * 128 + tid) * 2 + 1];
            carry[tid] = c; }
        if (MODE == 1) __syncthreads();
    }
#pragma unroll 1
    for (int tt = 0; tt < 4; ++tt) {
        const int tile = tile0 + tt, t = tile * 128 + wave * 16 + tok; const size_t row = (size_t)b * SEQ + t;
        const int hofs = launder_v(4 * h);
        float xc[4][2][4]; bf16x8 xb[4];
#pragma unroll
        for (int ks = 0; ks < 4; ++ks) {
#pragma unroll
            for (int hf = 0; hf < 2; ++hf) {
                const int cl = 32 * ks + 16 * hf + hofs;
                f32x4 a = *(const LAS f32x4*)(par + 384 + cl);
#pragma unroll
                for (int j = 0; j < 4; ++j) {
                    if (t - 3 + j >= 0) {
                        const u32x2 xv = *(const u32x2*)(P + (row - 3 + j) * PLD + C_XL + n * 128 + cl);
                        const f32x4 cw = *(const LAS f32x4*)(par + 512 + 128 * j + cl);
                        a.x += cw.x * bflo(xv.x); a.y += cw.y * bfhi(xv.x); a.z += cw.z * bflo(xv.y); a.w += cw.w * bfhi(xv.y);
                    }
                }
                xc[ks][hf][0] = a.x; xc[ks][hf][1] = a.y; xc[ks][hf][2] = a.z; xc[ks][hf][3] = a.w;
            }
            u32x4 w; w.x = pk2(xc[ks][0][0], xc[ks][0][1]); w.y = pk2(xc[ks][0][2], xc[ks][0][3]); w.z = pk2(xc[ks][1][0], xc[ks][1][1]); w.w = pk2(xc[ks][1][2], xc[ks][1][3]);
            xb[ks] = __builtin_bit_cast(bf16x8, w);
        }
        float acum[8][4], hloc[8][4];
#pragma unroll
        for (int dt = 0; dt < 8; ++dt) {
            f32x4 acca = {0.f, 0.f, 0.f, 0.f}, acci = {0.f, 0.f, 0.f, 0.f};
            const LAS unsigned char* wa = lds + LR_WA + (16 * dt + tok) * 272 + 2 * hofs; const LAS unsigned char* wi = lds + LR_WI + (16 * dt + tok) * 272 + 2 * hofs;
#pragma unroll
            for (int ks = 0; ks < 4; ++ks) {
                const u32x2 a0 = *(const LAS u32x2*)(wa + 64 * ks), a1 = *(const LAS u32x2*)(wa + 64 * ks + 32);
                const u32x2 i0 = *(const LAS u32x2*)(wi + 64 * ks), i1 = *(const LAS u32x2*)(wi + 64 * ks + 32);
                const u32x4 fa = {a0.x, a0.y, a1.x, a1.y}, fi = {i0.x, i0.y, i1.x, i1.y};
                acca = mfma16(__builtin_bit_cast(bf16x8, fa), xb[ks], acca);
                acci = mfma16(__builtin_bit_cast(bf16x8, fi), xb[ks], acci);
            }
            const int cl0 = 16 * dt + hofs;
            const f32x4 vsp = *(const LAS f32x4*)(par + cl0), vba = *(const LAS f32x4*)(par + 128 + cl0), vbi = *(const LAS f32x4*)(par + 256 + cl0);
            f32x4 wA, wH;
#pragma unroll
            for (int r = 0; r < 4; ++r) {
                const float rg = fsig(acca[r] + vba[r]), ig = fsig(acci[r] + vbi[r]);
                const float l2a = rg * vsp[r];
                float a = __builtin_amdgcn_exp2f(l2a);
                const float x2 = 2.0f * 0.6931471805599453f * l2a;
                const float om = (x2 > -0.06f) ? -x2 * (1.0f + x2 * (0.5f + x2 * (0.16666667f + x2 * 0.041666668f))) : 1.0f - a * a;
                float u = sqrtf(fmaxf(om, 0.f)) * (ig * xc[dt >> 1][dt & 1][r]);
                { float ap = dpp_shr<1>(a, 1.f), up = dpp_shr<1>(u, 0.f); u = a * up + u; a = a * ap; }
                { float ap = dpp_shr<2>(a, 1.f), up = dpp_shr<2>(u, 0.f); u = a * up + u; a = a * ap; }
                { float ap = dpp_shr<4>(a, 1.f), up = dpp_shr<4>(u, 0.f); u = a * up + u; a = a * ap; }
                { float ap = dpp_shr<8>(a, 1.f), up = dpp_shr<8>(u, 0.f); u = a * up + u; a = a * ap; }
                acum[dt][r] = a; hloc[dt][r] = u;
                wA[r] = row_bcast15(a); wH[r] = row_bcast15(u);
            }
            if (tok == 0) { *(LAS f32x4*)(compA + wave * 128 + cl0) = wA; *(LAS f32x4*)(compH + wave * 128 + cl0) = wH; }
        }
        __syncthreads();
        if (MODE == 1 || wave == 0)
#pragma unroll
        for (int dt = 0; dt < 8; ++dt) {
            const int cl0 = 16 * dt + hofs;
            f32x4 cin = (MODE == 1) ? *(const LAS f32x4*)(carry + cl0) : (f32x4){0.f, 0.f, 0.f, 0.f};
            f32x4 pa = {1.f, 1.f, 1.f, 1.f};
            const int nw = (MODE == 0) ? 8 : wave;
            for (int w2 = 0; w2 < nw; ++w2) { const f32x4 ca = *(const LAS f32x4*)(compA + w2 * 128 + cl0), chh = *(const LAS f32x4*)(compH + w2 * 128 + cl0); cin = ca * cin + chh; pa = pa * ca; }
            if (MODE == 1) {
                const u32x2 gv = *(const u32x2*)(P + row * PLD + C_GL + n * 128 + cl0);
                float y[4];
#pragma unroll
                for (int r = 0; r < 4; ++r) y[r] = acum[dt][r] * cin[r] + hloc[dt][r];
                u32x2 w; w.x = pk2(y[0] * gelu_tanh(bflo(gv.x)), y[1] * gelu_tanh(bfhi(gv.x))); w.y = pk2(y[2] * gelu_tanh(bflo(gv.y)), y[3] * gelu_tanh(bfhi(gv.y)));
                *(u32x2*)(OB + row * old + n * 128 + cl0) = w;
            } else if (tok == 0) {
                const size_t o = ((size_t)b * 64 + tile) * 1024 + n * 128 + cl0;
                *(f32x4*)(aggA + o) = pa; *(f32x4*)(aggH + o) = cin;
            }
        }
        if (MODE == 1) {
            __syncthreads();
            if (wave == 7 && tok == 0) {
#pragma unroll
                for (int dt = 0; dt < 8; ++dt) { const int cl0 = 16 * dt + hofs;
                    f32x4 cin = *(const LAS f32x4*)(carry + cl0);
#pragma unroll
                    for (int w2 = 0; w2 < 8; ++w2) { const f32x4 ca = *(const LAS f32x4*)(compA + w2 * 128 + cl0), chh = *(const LAS f32x4*)(compH + w2 * 128 + cl0); cin = ca * cin + chh; }
                    *(LAS f32x4*)(carry + cl0) = cin; }
            }
        }
        __syncthreads();
    }
}

__device__ __forceinline__ void memattn_job(KP p, int jb, LAS unsigned char* lds, int tid, int lane_, int wave, bf16* OB, int old) {
    const int lane = launder_v(lane_);
    const int hd = jb & 3, b = (jb >> 2) & 1, j = jb >> 3, tok = lane & 15, h = lane >> 4;
    const bf16* P = (const bf16*)(gws(p) + WS_R1);
    const bf16* MK = (const bf16*)(gws(p) + WS_MK); const bf16* VTM = (const bf16*)(gws(p) + WS_VTM);
    __syncthreads();
#pragma unroll
    for (int i = 0; i < 16; ++i) { const int ci = tid + 512 * i, m = ci >> 5, c = ci & 31;
        *(LAS u32x4*)(lds + m * 512 + ((c ^ (m & 15)) << 4)) = *(const u32x4*)(MK + (size_t)(b * 256 + m) * 1024 + hd * 256 + c * 8); }
    const size_t row = (size_t)b * SEQ + j * 128 + wave * 16 + tok;
    bf16x8 qf[8];
#pragma unroll
    for (int ks = 0; ks < 8; ++ks) qf[ks] = *(const bf16x8*)(P + row * PLD + C_QM + hd * 256 + 32 * ks + 8 * h);
    unsigned ka[8];
#pragma unroll
    for (int ks = 0; ks < 8; ++ks) ka[ks] = (unsigned)launder_v(tok * 512 + (((4 * ks + h) ^ tok) << 4));
    __syncthreads();
    bf16x8 pf[8]; float inv;
    {
        f32x4 S[16];
#pragma unroll
        for (int mt = 0; mt < 16; ++mt) {
            f32x4 acc = {0.f, 0.f, 0.f, 0.f};
#pragma unroll
            for (int ks = 0; ks < 8; ++ks) acc = mfma16(*(const LAS bf16x8*)(lds + ka[ks] + mt * 8192), qf[ks], acc);
            S[mt] = acc;
        }
        float mx = -3.0e38f;
#pragma unroll
        for (int mt = 0; mt < 16; ++mt)
#pragma unroll
            for (int r = 0; r < 4; ++r) mx = fmaxf(mx, S[mt][r]);
        mx = fmaxf(mx, __shfl_xor(mx, 16)); mx = fmaxf(mx, __shfl_xor(mx, 32));
        const float sc = 0.0625f * LOG2E;
        float sum = 0.f;
#pragma unroll
        for (int mt = 0; mt < 16; ++mt)
#pragma unroll
            for (int r = 0; r < 4; ++r) { const float e = __builtin_amdgcn_exp2f((S[mt][r] - mx) * sc); S[mt][r] = e; sum += e; }
        sum += __shfl_xor(sum, 16); sum += __shfl_xor(sum, 32);
        inv = 1.0f / sum;
#pragma unroll
        for (int T = 0; T < 8; ++T) { u32x4 w; w.x = pk2(S[2 * T][0], S[2 * T][1]); w.y = pk2(S[2 * T][2], S[2 * T][3]); w.z = pk2(S[2 * T + 1][0], S[2 * T + 1][1]); w.w = pk2(S[2 * T + 1][2], S[2 * T + 1][3]);
            pf[T] = __builtin_bit_cast(bf16x8, w); }
    }
    __syncthreads();
#pragma unroll
    for (int i = 0; i < 16; ++i) { const int ci = tid + 512 * i, d = ci >> 5, c = ci & 31;
        *(LAS u32x4*)(lds + d * 512 + ((c ^ (d & 15)) << 4)) = *(const u32x4*)(VTM + (size_t)(hd * 256 + d) * 512 + b * 256 + c * 8); }
    unsigned va[8][2];
#pragma unroll
    for (int T = 0; T < 8; ++T) { va[T][0] = (unsigned)launder_v(tok * 512 + 8 * (h & 1) + (((4 * T + (h >> 1)) ^ tok) << 4)); va[T][1] = (unsigned)launder_v(tok * 512 + 8 * (h & 1) + (((4 * T + 2 + (h >> 1)) ^ tok) << 4)); }
    __syncthreads();
#pragma unroll
    for (int dt = 0; dt < 16; ++dt) {
        f32x4 acc = {0.f, 0.f, 0.f, 0.f};
#pragma unroll
        for (int T = 0; T < 8; ++T) { const u32x2 v0 = *(const LAS u32x2*)(lds + va[T][0] + dt * 8192), v1 = *(const LAS u32x2*)(lds + va[T][1] + dt * 8192); const u32x4 f = {v0.x, v0.y, v1.x, v1.y};
            acc = mfma16(__builtin_bit_cast(bf16x8, f), pf[T], acc); }
        u32x2 w; w.x = pk2(acc[0] * inv, acc[1] * inv); w.y = pk2(acc[2] * inv, acc[3] * inv);
        *(u32x2*)(OB + row * old + hd * 256 + 16 * dt + 4 * h) = w;
    }
}

struct KFr { bf16x8 a0, a1, b0, b1; };
__device__ __forceinline__ KFr idx_load(const bf16* kidx, size_t krow, int lane) {
    const bf16* kp = kidx + (krow + (lane & 15)) * 64 + (lane >> 4) * 8;
    KFr f; f.a0 = *(const bf16x8*)kp; f.a1 = *(const bf16x8*)(kp + 32); f.b0 = *(const bf16x8*)(kp + 16 * 64); f.b1 = *(const bf16x8*)(kp + 16 * 64 + 32); return f;
}
__device__ __forceinline__ f32x4 idx_score4(const bf16x8 k0, const bf16x8 k1, const bf16x8 (&qf)[4][2], const f32x4 w) {
    f32x4 s = {0.f, 0.f, 0.f, 0.f};
#pragma unroll
    for (int hd = 0; hd < 4; ++hd) {
        f32x4 d = {0.f, 0.f, 0.f, 0.f};
        d = mfma16(k0, qf[hd][0], d); d = mfma16(k1, qf[hd][1], d);
#pragma unroll
        for (int r = 0; r < 4; ++r) { const int di = __float_as_int(d[r]); s[r] = __builtin_fmaf(w[hd], __int_as_float(di > 0 ? di : 0), s[r]); }
    }
    return s;
}
__device__ __forceinline__ unsigned orderable(float s) { const unsigned u = __float_as_uint(s); return u ^ ((u >> 31) ? 0xFFFFFFFFu : 0x80000000u); }

template <int NE> __device__ __forceinline__ unsigned long long rank_select(const unsigned long long (&v)[NE], unsigned long long top12, int need) {
    unsigned long long prefix = top12 << 33;
    for (int bit = 32; bit >= 0; --bit) {
        const unsigned long long cand = prefix | (1ull << bit);
        int cnt = 0;
#pragma unroll
        for (int e = 0; e < NE; ++e) cnt += __popcll(__ballot(v[e] >= cand));
        if (cnt >= need) prefix = cand;
    }
    return prefix;
}

template <int sprobe> __device__ __forceinline__ void select_item(KP p, int b, int u, LAS unsigned char* lds, int tid, int lane, int wave) {
    LAS unsigned* hist = (LAS unsigned*)lds;
    LAS unsigned long long* lists = (LAS unsigned long long*)lds;
    LAS unsigned* mstage = (LAS unsigned*)(lds + 131072);
    LAS int* qinfo = (LAS int*)(lds + 147456);
    const bf16* P = (const bf16*)(gws(p) + WS_R1); const bf16* kidx = (const bf16*)(gws(p) + WS_KIDX);
    const int q0 = u * 16, nkeys = q0 + 16, ngrp = (nkeys + 31) >> 5, nw2 = (nkeys + 63) >> 6;
    for (int i = tid; i < 32768; i += 512) hist[i] = 0u;
    for (int i = tid; i < 4096; i += 512) mstage[i] = 0u;
    if (tid < 48) qinfo[tid] = 0;
    const int ql = lane & 15, h4 = lane >> 4, tq = q0 + ql;
    const size_t qrow = (size_t)b * SEQ + tq;
    bf16x8 qf[4][2];
#pragma unroll
    for (int hd = 0; hd < 4; ++hd)
#pragma unroll
        for (int ks = 0; ks < 2; ++ks) qf[hd][ks] = *(const bf16x8*)(P + qrow * PLD + C_QI + hd * 64 + ks * 32 + h4 * 8);
    const f32x4 w = *(const f32x4*)((const float*)(gws(p) + WS_WIDX) + qrow * 4);
    __syncthreads();
    {
        const size_t kr0 = (size_t)b * SEQ;
#define SEL_BODY1(KF, gg) do { if ((gg) < ngrp) { _Pragma("unroll") for (int hf = 0; hf < 2; ++hf) { const int kb = (gg) * 32 + hf * 16; \
            if (kb < nkeys) { const f32x4 sc = hf ? idx_score4(KF.b0, KF.b1, qf, w) : idx_score4(KF.a0, KF.a1, qf, w); \
                _Pragma("unroll") for (int r = 0; r < 4; ++r) { const int key = kb + 4 * h4 + r; \
                    if (key <= tq) { const unsigned ob = orderable(sc[r]);   \
                        (void)__hip_atomic_fetch_add((LAS unsigned*)((LAS unsigned char*)hist + hqb + ((ob >> 19) & 0x3FFCu)), 1u + ((ob >> 20) & 1u) * 0xFFFFu, __ATOMIC_RELAXED, __HIP_MEMORY_SCOPE_WORKGROUP); } } } } } } while (0)
#define SEL_LOAD(gg) idx_load(kidx, kr0 + 32 * ((gg) < ngrp ? (gg) : wave), lane)
        const unsigned hqb = (unsigned)ql * 8192u;
        KFr kA = SEL_LOAD(wave), kB = SEL_LOAD(wave + 8), kC;
        for (int g = wave; g < ngrp; g += 24) {
            kC = SEL_LOAD(g + 16); SEL_BODY1(kA, g);
            kA = SEL_LOAD(g + 24); SEL_BODY1(kB, g + 8);
            kB = SEL_LOAD(g + 32); SEL_BODY1(kC, g + 16);
        }
#undef SEL_BODY1
    }
    __syncthreads();
    for (int qq = 0; qq < 2; ++qq) {
        const int q = 2 * wave + qq, total = q0 + q + 1;
        if (total <= 256) { if (lane == 0) { qinfo[q] = -1; qinfo[16 + q] = 0; } continue; }
        LAS unsigned* hq = hist + q * 2048;
        int s = 0;
#pragma unroll 8
        for (int i = 0; i < 32; ++i) { const unsigned wv = hq[lane * 32 + ((i + lane) & 31)]; s += (int)(wv & 0xffffu) + (int)(wv >> 16); }
        int suf = s;
#pragma unroll
        for (int off = 1; off < 64; off <<= 1) { const int t = __shfl_down(suf, off); if (lane + off < 64) suf += t; }
        const unsigned long long ball = __ballot(suf >= 256);
        const int L = 63 - __clzll(ball);
        const int above = (L < 63) ? __shfl(suf, L + 1) : 0;
        const unsigned wv = hq[L * 32 + (lane >> 1)];
        const int c = (lane & 1) ? (int)(wv >> 16) : (int)(wv & 0xffffu);
        int suf2 = c;
#pragma unroll
        for (int off = 1; off < 64; off <<= 1) { const int t = __shfl_down(suf2, off); if (lane + off < 64) suf2 += t; }
        suf2 += above;
        const unsigned long long ball2 = __ballot(suf2 >= 256);
        const int is = 63 - __clzll(ball2);
        const int nab = __shfl(suf2, is) - __shfl(c, is);
        if (lane == 0) { qinfo[q] = 64 * L + is; qinfo[16 + q] = nab; }
    }
    __syncthreads();
    const int b1q = qinfo[ql];
    {
        const size_t kr0 = (size_t)b * SEQ;
        struct Pend { int pos; unsigned flags; int gg; unsigned ub[8]; };
#define SEL_FLUSH(PD) do { if ((PD).flags) { _Pragma("unroll") for (int k = 0; k < 8; ++k) if (((PD).flags >> k) & 1u) { \
            const int idx = (PD).pos + __popc((PD).flags & ((1u << k) - 1u)), key = (PD).gg * 32 + (k >> 2) * 16 + 4 * h4 + (k & 3); \
            if (idx < 1024) lists[ql * 1024 + idx] = ((unsigned long long)(PD).ub[k] << 13) | (unsigned long long)(8191 - key); } } } while (0)
#define SEL_BODY2(KF, gg_, PN, PO) do { (PN).flags = 0u; (PN).gg = (gg_); (PN).pos = 0; if ((gg_) < ngrp) { unsigned bits = 0u; _Pragma("unroll") for (int hf = 0; hf < 2; ++hf) { const int kb = (gg_) * 32 + hf * 16; \
            if (kb < nkeys) { const f32x4 sc = hf ? idx_score4(KF.b0, KF.b1, qf, w) : idx_score4(KF.a0, KF.a1, qf, w); \
                _Pragma("unroll") for (int r = 0; r < 4; ++r) { const int key = kb + 4 * h4 + r; const unsigned ub = orderable(sc[r]); (PN).ub[hf * 4 + r] = ub; \
                    const bool ok = key <= tq, gt = ub > hiT, ge = ub >= loT;        \
                    bits |= (ok && gt) ? (1u << (hf * 16 + 4 * h4 + r)) : 0u; (PN).flags |= (ok && ge && !gt) ? (1u << (hf * 4 + r)) : 0u; } } } \
            if ((PN).flags) (PN).pos = __hip_atomic_fetch_add(&qinfo[32 + ql], __popc((PN).flags), __ATOMIC_RELAXED, __HIP_MEMORY_SCOPE_WORKGROUP); \
            bits = xor16_or(bits); bits = xor32_or(bits); if (h4 == 0) mstage[ql * 256 + (gg_)] = bits; } \
            SEL_FLUSH(PO); } while (0)
        const unsigned loT = b1q < 0 ? 0u : ((unsigned)b1q << 20), hiT = b1q < 0 ? 0u : (loT | 0xFFFFFu);
        Pend pA, pB, pC; pC.flags = 0u; pC.pos = 0; pC.gg = 0;
#pragma unroll
        for (int k = 0; k < 8; ++k) pC.ub[k] = 0u;
        KFr kA = SEL_LOAD(wave), kB = SEL_LOAD(wave + 8), kC;
        for (int g = wave; g < ngrp; g += 24) {
            kC = SEL_LOAD(g + 16); SEL_BODY2(kA, g, pA, pC);
            kA = SEL_LOAD(g + 24); SEL_BODY2(kB, g + 8, pB, pA);
            kB = SEL_LOAD(g + 32); SEL_BODY2(kC, g + 16, pC, pB);
        }
        SEL_FLUSH(pC);
#undef SEL_FLUSH
#undef SEL_BODY2
#undef SEL_LOAD
    }
    __syncthreads();
    for (int qq = 0; qq < 2; ++qq) {
        const int q = 2 * wave + qq, b1 = qinfo[q];
        if (b1 < 0) continue;
        int n = qinfo[32 + q]; n = n > 1024 ? 1024 : n;
        const int need = 256 - qinfo[16 + q];
        const LAS unsigned long long* Lq = lists + q * 1024;
        unsigned long long thr;
        if (n <= 64) { unsigned long long v[1]; v[0] = lane < n ? Lq[lane] : 0ull; thr = rank_select<1>(v, (unsigned long long)b1, need); }
        else if (n <= 256) { unsigned long long v[4];
#pragma unroll
            for (int e = 0; e < 4; ++e) v[e] = (lane + 64 * e) < n ? Lq[lane + 64 * e] : 0ull;
            thr = rank_select<4>(v, (unsigned long long)b1, need); }
        else { unsigned long long v[16];
#pragma unroll
            for (int e = 0; e < 16; ++e) v[e] = (lane + 64 * e) < n ? Lq[lane + 64 * e] : 0ull;
            thr = rank_select<16>(v, (unsigned long long)b1, need); }
        for (int e = lane; e < n; e += 64) { const unsigned long long v = Lq[e]; if (v >= thr) { const int key = 8191 - (int)(v & 8191ull); (void)__hip_atomic_fetch_or(&mstage[q * 256 + (key >> 5)], 1u << (key & 31), __ATOMIC_RELAXED, __HIP_MEMORY_SCOPE_WORKGROUP); } }
    }
    __syncthreads();
    unsigned* mask = (unsigned*)(gws(p) + WS_MASK);
    for (int i = tid; i < 16 * nw2; i += 512) { const int q = i / nw2, wp = i - q * nw2; *(u32x2*)(mask + ((size_t)b * SEQ + q0 + q) * 256 + 2 * wp) = *(const LAS u32x2*)(mstage + q * 256 + 2 * wp); }
    __syncthreads();
}

__device__ __forceinline__ float bfi_sel(int sel, float x) { float r; asm("v_bfi_b32 %0, %1, %2, %3" : "=v"(r) : "v"(sel), "v"(x), "v"(0xff800000u)); return r; }
constexpr int AT_K = 0, AT_VT = 16384, AT_BUF = 32768, AT_BIAS = 3 * AT_BUF;
__device__ __forceinline__ void attn_bias_table(KP p, LAS unsigned char* lds, int tid) {
    LAS float* bt = (LAS float*)(lds + AT_BIAS);
    for (int i = tid; i < 1024; i += 512) {
        const int hd = i >> 7, dd = i & 127;
        int bk = dd;
        if (dd >= 16) { bk = 16 + (dd >= 19) + (dd >= 21) + (dd >= 24) + (dd >= 27) + (dd >= 31) + (dd >= 35) + (dd >= 40) + (dd >= 46) + (dd >= 52) + (dd >= 59) + (dd >= 67) + (dd >= 77) + (dd >= 87) + (dd >= 99) + (dd >= 113); }
        bt[i] = gin(p, I_RELB)[bk * 8 + hd] * LOG2E;
    }
}
template <int probe> __device__ __forceinline__ void attn_item(KP p, int b, int kvh, int qt, LAS unsigned char* lds, int lane_, int wave, bf16* OB, int old) {
    const int lane = launder_v(lane_);
    const bf16* P = (const bf16*)(gws(p) + WS_R1); const bf16* VT = (const bf16*)(gws(p) + WS_VT); const unsigned* mask = (const unsigned*)(gws(p) + WS_MASK);
    const int head = kvh * 4 + (wave & 3), q0 = qt * 64 + 32 * (wave >> 2), nkt = (probe == 1) ? 1 : qt + 1, ql = lane & 31, hi = lane >> 5, tq = q0 + ql;
    const size_t row = (size_t)b * SEQ + tq;
    bf16x8 qf[8];
#pragma unroll
    for (int ks = 0; ks < 8; ++ks) qf[ks] = *(const bf16x8*)(P + row * PLD + C_QA + head * 128 + 16 * ks + 8 * hi);
    f32x16 O[4];
#pragma unroll
    for (int dt = 0; dt < 4; ++dt)
#pragma unroll
        for (int r = 0; r < 16; ++r) O[dt][r] = 0.f;
    float mrun = -1.0e4f, lrun = 0.f;
    const float c1 = 0.08838834764831845f * LOG2E;
    const LAS float* btab = (const LAS float*)(lds + AT_BIAS) + head * 128;
    const float bfar = btab[127];
    const bf16* kbase = P + (size_t)b * SEQ * PLD + C_KA + kvh * 128; const bf16* vbase = VT + (size_t)(b * 2 + kvh) * 128 * SEQ; const unsigned* mrow = mask + row * 256;
    unsigned koff[2], voff[2];
#pragma unroll
    for (int i = 0; i < 2; ++i) {
        const int pos = 1024 * (wave + 8 * i) + 16 * lane;
        const int key = pos >> 8, kc = ((pos >> 4) & 15) ^ (key & 15);
        koff[i] = (unsigned)(key * PLD + kc * 8);
        const int d = pos >> 7, vc = ((pos >> 4) & 7) ^ ((d >> 1) & 7);
        voff[i] = (unsigned)(d * 64 + vc * 8);
    }
#define AT_DMA(kt, st) do { _Pragma("unroll") for (int i = 0; i < 2; ++i) { \
        __builtin_amdgcn_global_load_lds((const unsigned*)(kbase + (size_t)(kt) * 64 * PLD + koff[i]), (LAS unsigned*)(lds + (st) * AT_BUF + AT_K + 1024 * (wave + 8 * i)), 16, 0, 0); \
        __builtin_amdgcn_global_load_lds((const unsigned*)(vbase + (size_t)(kt) * 8192 + voff[i]), (LAS unsigned*)(lds + (st) * AT_BUF + AT_VT + 1024 * (wave + 8 * i)), 16, 0, 0); } } while (0)
    const int piq = (ql & 16) | ((ql & 4) << 1) | ((ql & 8) >> 1) | (ql & 3);
    unsigned ksw[8], vsw[4];
#pragma unroll
    for (int ks = 0; ks < 8; ++ks) ksw[ks] = (probe == 5) ? (unsigned)launder_v(lane * 16 + ks * 1024) : (unsigned)launder_v(piq * 256 + (((2 * ks + hi) ^ (piq & 15)) << 4));
#pragma unroll
    for (int s = 0; s < 4; ++s) vsw[s] = (probe == 5) ? (unsigned)launder_v(lane * 16 + s * 1024) : (unsigned)launder_v(ql * 128 + (((2 * s + hi) ^ ((ql >> 1) & 7)) << 4));
    const bool grpB = wave >= 4;
    AT_DMA(0, 0);
    u32x2 mw = *(const u32x2*)(mrow);
    bf16x8 pf[4];
#pragma unroll
    for (int s = 0; s < 4; ++s) pf[s] = (bf16x8){0, 0, 0, 0, 0, 0, 0, 0};
#define AT_PV(vb_) do { bf16x8 vf[2][4], vg[2][4]; \
        _Pragma("unroll") for (int dt = 0; dt < 2; ++dt) _Pragma("unroll") for (int s = 0; s < 4; ++s) vf[dt][s] = (probe == 7) ? qf[s + 4 * dt] : *(const LAS bf16x8*)((vb_) + vsw[s] + dt * 4096); \
        __builtin_amdgcn_sched_barrier(0); \
        _Pragma("unroll") for (int dt = 0; dt < 2; ++dt) _Pragma("unroll") for (int s = 0; s < 4; ++s) vg[dt][s] = (probe == 7) ? qf[s + 4 * dt] : *(const LAS bf16x8*)((vb_) + vsw[s] + (dt + 2) * 4096); \
        _Pragma("unroll") for (int dt = 0; dt < 2; ++dt) _Pragma("unroll") for (int s = 0; s < 4; ++s) { if (probe != 4 && probe < 6) O[dt] = mfma32(vf[dt][s], pf[s], O[dt]); else if (probe >= 6) O[dt][s] += __builtin_bit_cast(float, vf[dt][s][0] | (vf[dt][s][1] << 16)); } \
        __builtin_amdgcn_sched_barrier(0); \
        _Pragma("unroll") for (int dt = 0; dt < 2; ++dt) _Pragma("unroll") for (int s = 0; s < 4; ++s) { if (probe != 4 && probe < 6) O[dt + 2] = mfma32(vg[dt][s], pf[s], O[dt + 2]); else if (probe >= 6) O[dt + 2][s] += __builtin_bit_cast(float, vg[dt][s][0] | (vg[dt][s][1] << 16)); } } while (0)
    int st = 0, stp = 2;
    for (int kt = 0; kt < nkt; ++kt) {
        asm volatile("s_waitcnt vmcnt(0)" ::: "memory");
        __builtin_amdgcn_s_barrier();
        asm volatile("" ::: "memory");
        const u32x2 mcur = mw;
        const int stn = st == 2 ? 0 : st + 1;
        if (kt + 1 < nkt && probe != 2) { AT_DMA(kt + 1, stn); mw = *(const u32x2*)(mrow + 2 * (kt + 1)); }
        if (grpB && kt > 0) AT_PV(lds + stp * AT_BUF + AT_VT);
        const LAS unsigned char* kb = lds + st * AT_BUF + AT_K;
        f32x16 S[2];
        {
            bf16x8 kf[2][8];
#pragma unroll
            for (int hh = 0; hh < 2; ++hh)
#pragma unroll
                for (int ks = 0; ks < 8; ++ks) kf[hh][ks] = (probe == 7) ? qf[ks] : *(const LAS bf16x8*)(kb + ksw[ks] + hh * 8192);
            __builtin_amdgcn_sched_barrier(0);
#pragma unroll
            for (int hh = 0; hh < 2; ++hh) {
#pragma unroll
                for (int r = 0; r < 16; ++r) S[hh][r] = 0.f;
#pragma unroll
                for (int ks = 0; ks < 8; ++ks) { if (probe != 4 && probe < 6) S[hh] = mfma32(kf[hh][ks], qf[ks], S[hh]); else if (probe >= 6) S[hh][ks] += __builtin_bit_cast(float, kf[hh][ks][0] | (kf[hh][ks][1] << 16)); }
            }
        }
        const bool farr = (q0 - (64 * kt + 63)) >= 113;
        float mt = -INFINITY;
        if (farr) {
            const float boff = bfar - mrun;
#pragma unroll
            for (int hh = 0; hh < 2; ++hh) {
                const unsigned wbits = (hh ? mcur.y : mcur.x) >> (8 * hi);
#pragma unroll
                for (int r = 0; r < 16; ++r) {
                    const int kk = 16 * (r >> 3) + 4 * ((r >> 2) & 1) + (r & 3);
                    const float x = __builtin_fmaf(S[hh][r], c1, boff);
                    const int sel = __builtin_amdgcn_sbfe((int)wbits, kk, 1);
                    const float xm = bfi_sel(sel, x);
                    S[hh][r] = xm; mt = fmaxf(mt, xm);
                }
            }
        } else {
#pragma unroll
            for (int hh = 0; hh < 2; ++hh) {
                const unsigned wbits = (hh ? mcur.y : mcur.x) >> (8 * hi);
                const int dbase = tq - (64 * kt + 32 * hh + 8 * hi);
#pragma unroll
                for (int r = 0; r < 16; ++r) {
                    const int kk = 16 * (r >> 3) + 4 * ((r >> 2) & 1) + (r & 3);
                    int dist = dbase - kk; dist = dist < 0 ? 0 : (dist > 127 ? 127 : dist);
                    const float x = __builtin_fmaf(S[hh][r], c1, btab[dist] - mrun);
                    const int sel = __builtin_amdgcn_sbfe((int)wbits, kk, 1);
                    const float xm = bfi_sel(sel, x);
                    S[hh][r] = xm; mt = fmaxf(mt, xm);
                }
            }
        }
        mt = xmax32(mt);
        float alpha = 1.0f;
        if (!__all(mt <= 8.0f)) {
            const float dm = fmaxf(mt, 0.f); alpha = __builtin_amdgcn_exp2f(-dm); mrun += dm;
#pragma unroll
            for (int dt = 0; dt < 4; ++dt)
#pragma unroll
                for (int r = 0; r < 16; ++r) O[dt][r] *= alpha;
#pragma unroll
            for (int hh = 0; hh < 2; ++hh)
#pragma unroll
                for (int r = 0; r < 16; ++r) S[hh][r] -= dm;
        }
        float ps = 0.f;
#pragma unroll
        for (int hh = 0; hh < 2; ++hh)
#pragma unroll
            for (int r = 0; r < 16; ++r) { const float e = __builtin_amdgcn_exp2f(S[hh][r]); S[hh][r] = e; ps += e; }
        lrun = lrun * alpha + ps;
#pragma unroll
        for (int s = 0; s < 4; ++s) { const int hh = s >> 1, r0 = 8 * (s & 1);
            u32x4 wv; wv.x = pkbf(S[hh][r0 + 0], S[hh][r0 + 1]); wv.y = pkbf(S[hh][r0 + 2], S[hh][r0 + 3]); wv.z = pkbf(S[hh][r0 + 4], S[hh][r0 + 5]); wv.w = pkbf(S[hh][r0 + 6], S[hh][r0 + 7]);
            pf[s] = __builtin_bit_cast(bf16x8, wv); }
        if (!grpB) AT_PV(lds + st * AT_BUF + AT_VT);
        stp = st; st = stn;
    }
    if (grpB) AT_PV(lds + stp * AT_BUF + AT_VT);
#undef AT_PV
#undef AT_DMA
    const float ltot = xadd32(lrun);
    const float inv = 1.0f / ltot;
#pragma unroll
    for (int dt = 0; dt < 4; ++dt)
#pragma unroll
        for (int g = 0; g < 4; ++g) {
            u32x2 wv; wv.x = pkbf(O[dt][4 * g + 0] * inv, O[dt][4 * g + 1] * inv); wv.y = pkbf(O[dt][4 * g + 2] * inv, O[dt][4 * g + 3] * inv);
            *(u32x2*)(OB + row * old + head * 128 + 32 * dt + 8 * g + 4 * hi) = wv;
        }
    asm volatile("s_waitcnt vmcnt(0)" ::: "memory");
    __builtin_amdgcn_s_barrier();
    asm volatile("" ::: "memory");
}

#ifndef SKIP_MIXER
#define SKIP_MIXER 0
#endif
#ifndef PROBE_MIX
#define PROBE_MIX 0
#endif
#ifndef PROBE_CVT
#define PROBE_CVT 0
#endif
#ifndef ZERO_BRANCH
#define ZERO_BRANCH 0
#endif
__device__ __forceinline__ void zero_cols(bf16* P, int col0, int gw, int NGW, int lane) {
    for (int m = gw; m < M; m += NGW) { u32x4* o = (u32x4*)(P + (size_t)m * PLD + col0) + lane; o[0] = (u32x4){0u, 0u, 0u, 0u}; o[64] = (u32x4){0u, 0u, 0u, 0u}; }
}
__global__ void __launch_bounds__(512, 2) fwd(Params pdummy) {
    extern __shared__ __attribute__((aligned(16))) unsigned char lds_raw[];
    LAS unsigned char* lds = (LAS unsigned char*)lds_raw;
    const int wave0 = __builtin_amdgcn_readfirstlane(threadIdx.x >> 6);
    const int G = gridDim.x, bx = blockIdx.x;
    const int vcu = (G % 8 == 0) ? (bx % 8) * (G / 8) + bx / 8 : bx;
    const int NGW = G * 8;
    if (threadIdx.x < 64) ((LAS unsigned*)(lds + MISC_OFF))[threadIdx.x] = 0u;
    __syncthreads();
    XcdBarrier bar = xcd_barrier_post((unsigned*)(gws(kargs()) + WS_CTL) + CW_BAR, (volatile LAS unsigned*)(lds + MISC_OFF + 32));
#define GRID_BAR() xcd_barrier(bar)
#define PH_BEGIN const int lane = lane_id_asm(), wave = wave0, tid = wave * 64 + lane, gw = vcu * 8 + wave, bxl = launder_s(bx); KP p = kargs(); (void)bxl; unsigned char* ws = gws(p); (void)lane; (void)gw; (void)ws;

    for (int l = 0; l < DEPTH; ++l) {
        for (int rep = (PROBE_CVT & 1) ? 0 : 1; rep < 2; ++rep) { PH_BEGIN phase_cvt(p, l, lds, vcu, G, gw, NGW, wave, lane); }
        for (int f = 0; f < 2; ++f) {
            if (f == 1 && !SKIP_MIXER) {
                for (int rep = (PROBE_CVT & 1) ? 0 : 1; rep < 2; ++rep) { PH_BEGIN float* X = gout(p); bf16* XN = (bf16*)(ws + WS_XN);
                  rms_rows_bf16(X, gin(p, I_NMIX) + (size_t)l * DM, XN, gw, NGW, lane); }
                GRID_BAR();
                for (int rep = (PROBE_CVT & 4) ? 0 : 1; rep < 2; ++rep)
                { PH_BEGIN
                    pg8::Gemm g{(const bf16*)(ws + WS_XN), (const bf16*)(ws + WS_WIN), M, DIN_PAD, DM, DM, DM}; pg8::StaticOrder S; S.init(M, DIN_PAD, G, bxl);
                    pg8::EpiProj E{(bf16*)(ws + WS_R1), PLD, (float*)(ws + WS_SIDE)};
                    pg8::gemm_phase<pg8::EpiProj, pg8::StaticOrder, true, true>(lds, g, S, E, tid);
                }
                GRID_BAR();
                for (int rep = (PROBE_MIX & 16) ? 0 : 1; rep < 2; ++rep) {
                { PH_BEGIN
                    for (int gt = vcu * 512 + tid; gt < 4 * M; gt += G * 512) kidx_ln_quarter(p, l, gt);
                    for (int it = gw; it < 1024; it += NGW) vt_item(p, it, lds + 8192 + wave * 16384, lane);
                } }
                for (int rep = (PROBE_MIX & 32) ? 0 : 1; rep < 2; ++rep)
                { PH_BEGIN for (int it = vcu; it < 256; it += G) lru_job<0>(p, l, it, lds, tid, lane, wave, nullptr, 0); }
                for (int rep = (PROBE_MIX & 64) ? 0 : 1; rep < 2; ++rep)
                { PH_BEGIN bf16* OB = rep ? (bf16*)(ws + WS_R1) + C_QM : (bf16*)(ws + WS_SCR); const int old = rep ? PLD : 1024;
                    if (!(ZERO_BRANCH & 4)) { for (int it = vcu; it < 512; it += G) memattn_job(p, it, lds, tid, lane, wave, OB, old); __syncthreads(); } else zero_cols((bf16*)(ws + WS_R1), C_QM, gw, NGW, lane);
                }
                GRID_BAR();
                for (int rep = (PROBE_MIX & 6) ? 0 : 1; rep < 2; ++rep) {
                { PH_BEGIN
                    if (!(ZERO_BRANCH & 1) && (rep || (PROBE_MIX & 2))) for (int pi = vcu; pi < 512; pi += G) { const int b = pi >> 8, j = pi & 255;
#pragma unroll 1
                        for (int k = 0; k < 2; ++k) { if ((PROBE_MIX >> 12) && rep == 0) select_item<(PROBE_MIX >> 12)>(p, b, k ? 511 - j : j, lds, tid, lane, wave); else select_item<0>(p, b, k ? 511 - j : j, lds, tid, lane, wave); } }
                    __syncthreads();
                }
                { PH_BEGIN bf16* OB = rep ? (bf16*)(ws + WS_R1) + C_GL : (bf16*)(ws + WS_SCR); const int old = rep ? PLD : 1024;
                    if (!(ZERO_BRANCH & 2) && (rep || (PROBE_MIX & 4))) { for (int it = vcu; it < 256; it += G) lru_job<1>(p, l, it, lds, tid, lane, wave, OB, old); } else if (ZERO_BRANCH & 2) zero_cols((bf16*)(ws + WS_R1), C_GL, gw, NGW, lane);
                }
                }
                GRID_BAR();
                for (int rep = (PROBE_MIX & 8) ? 0 : 1; rep < 2; ++rep) {
                { PH_BEGIN bf16* OB = rep ? (bf16*)(ws + WS_R1) + C_QA : (bf16*)(ws + WS_SCR); const int old = rep ? PLD : 1024;
                    if (!(ZERO_BRANCH & 1)) {
                        attn_bias_table(p, lds, tid);
                        __syncthreads();
                        for (int pi = vcu; pi < 256; pi += G) { const int bk = pi >> 6, j = pi & 63;
#pragma unroll 1
                            for (int k = 0; k < 2; ++k) { if ((PROBE_MIX >> 8) && rep == 0) attn_item<(PROBE_MIX >> 8)>(p, bk >> 1, bk & 1, k ? 127 - j : j, lds, lane, wave, OB, old); else attn_item<0>(p, bk >> 1, bk & 1, k ? 127 - j : j, lds, lane, wave, OB, old); } }
                    } else zero_cols((bf16*)(ws + WS_R1), C_QA, gw, NGW, lane);
                }
                }
                GRID_BAR();
                for (int rep = (PROBE_CVT & 16) ? 0 : 1; rep < 2; ++rep) {
                { PH_BEGIN bf16* R1 = (bf16*)(ws + WS_R1); const bf16* WBR = (const bf16*)(ws + WS_WBR); pg8::StaticOrder S; S.init(M, DM, G, bxl);
                  pg8::Gemm g{R1 + C_QA, WBR, M, DM, 1024, PLD, 1024}; pg8::EpiBf16 E{(bf16*)(ws + WS_SCR), DM}; pg8::gemm_phase<pg8::EpiBf16, pg8::StaticOrder, true, true>(lds, g, S, E, tid); }
                { PH_BEGIN bf16* R1 = (bf16*)(ws + WS_R1); const bf16* WBR = (const bf16*)(ws + WS_WBR); pg8::StaticOrder S; S.init(M, DM, G, bxl);
                  pg8::Gemm g{R1 + C_GL, WBR + (size_t)DM * 1024, M, DM, 1024, PLD, 1024}; pg8::EpiBf16 E{(bf16*)(ws + WS_SCR) + (size_t)M * DM, DM}; pg8::gemm_phase<pg8::EpiBf16, pg8::StaticOrder, true, true>(lds, g, S, E, tid); }
                { PH_BEGIN bf16* R1 = (bf16*)(ws + WS_R1); const bf16* WBR = (const bf16*)(ws + WS_WBR); pg8::StaticOrder S; S.init(M, DM, G, bxl);
                  pg8::Gemm g{R1 + C_QM, WBR + (size_t)2 * DM * 1024, M, DM, 1024, PLD, 1024}; pg8::EpiMerge E{R1 + C_GT, PLD, (const bf16*)(ws + WS_SCR), (const bf16*)(ws + WS_SCR) + (size_t)M * DM, (bf16*)(ws + WS_XN), DM}; pg8::gemm_phase<pg8::EpiMerge, pg8::StaticOrder, true, true>(lds, g, S, E, tid); }
                }
                GRID_BAR();
                { PH_BEGIN
                    pg8::Gemm g{(const bf16*)(ws + WS_XN), (const bf16*)(ws + WS_WOUT), M, DM, DM, DM, DM}; pg8::StaticOrder S; S.init(M, DM, G, bxl);
                    pg8::EpiResid E{gout(p), gout(p), DM, 1.0f};
                    pg8::gemm_phase<pg8::EpiResid, pg8::StaticOrder, true, true>(lds, g, S, E, tid);
                }
                GRID_BAR();
            }
            for (int rep = (PROBE_CVT & 1) ? 0 : 1; rep < 2; ++rep) { PH_BEGIN const float* xsrc = (l == 0 && f == 0) ? gin(p, I_X) : gout(p); bf16* XN = (bf16*)(ws + WS_XN);
              rms_rows_bf16(xsrc, gin(p, f ? I_NFF2 : I_NFF1) + (size_t)l * DM, XN, gw, NGW, lane); }
            GRID_BAR();
            if (f == 0) {
                { PH_BEGIN const bf16* WM = (const bf16*)(ws + WS_WMKV); const bf16* MN = (const bf16*)(ws + WS_MEMN);
                  pg8::Gemm g{MN, WM, BATCH * NMEM, 1024, DM, DM, DM}; pg8::SimpleOrder S; S.init(BATCH * NMEM, 1024, G, bxl - 192); pg8::EpiBf16 E{(bf16*)(ws + WS_MK), 1024}; pg8::gemm_phase<pg8::EpiBf16, pg8::SimpleOrder, true, true>(lds, g, S, E, tid); }
                { PH_BEGIN const bf16* WM = (const bf16*)(ws + WS_WMKV); const bf16* MN = (const bf16*)(ws + WS_MEMN);
                  pg8::Gemm g{WM + (size_t)1024 * DM, MN, 1024, BATCH * NMEM, DM, DM, DM}; pg8::SimpleOrder S; S.init(1024, BATCH * NMEM, G, bxl - 200); pg8::EpiBf16 E{(bf16*)(ws + WS_VTM), BATCH * NMEM}; pg8::gemm_phase<pg8::EpiBf16, pg8::SimpleOrder, true, true>(lds, g, S, E, tid); }
            }
            for (int rep = (PROBE_CVT & 2) ? 0 : 1; rep < 2; ++rep)
            { PH_BEGIN
                pg8::Gemm g{(const bf16*)(ws + WS_XN), (const bf16*)(ws + (f ? WS_WGU2 : WS_WGU)), M, 2 * DFF, DM, DM, DM}; pg8::StaticOrder S; S.init(M, 2 * DFF, G, bxl);
                pg8::EpiSwiglu E{(bf16*)(ws + WS_R1), DFF};
                pg8::gemm_phase<pg8::EpiSwiglu, pg8::StaticOrder, true, true>(lds, g, S, E, tid);
            }
            GRID_BAR();
            for (int rep = (PROBE_CVT & 8) ? 0 : 1; rep < 2; ++rep)
            { PH_BEGIN
                const float* xsrc = (l == 0 && f == 0) ? gin(p, I_X) : gout(p);
                pg8::Gemm g{(const bf16*)(ws + WS_R1), (const bf16*)(ws + (f ? WS_WDN2 : WS_WDN)), M, DM, DFF, DFF, DFF}; pg8::StaticOrder S; S.init(M, DM, G, bxl);
                pg8::EpiResid E{xsrc, rep ? gout(p) : (float*)(ws + WS_SCR), DM, 0.5f};
                pg8::gemm_phase<pg8::EpiResid, pg8::StaticOrder, true, true>(lds, g, S, E, tid);
            }
            GRID_BAR();
        }
    }
    { PH_BEGIN float* X = gout(p); const f32x4* gr = (const f32x4*)gin(p, I_FNORM) + lane;
      f32x4 gg[8];
#pragma unroll
      for (int j = 0; j < 8; ++j) gg[j] = gr[64 * j];
      for (int m = gw; m < M; m += 4 * NGW) {
          f32x4 v[4][8]; float ss[4];
#pragma unroll
          for (int r = 0; r < 4; ++r) { const int mr = (m + r * NGW < M) ? m + r * NGW : m; const f32x4* xr = (const f32x4*)(X + (size_t)mr * DM) + lane;
#pragma unroll
              for (int j = 0; j < 8; ++j) v[r][j] = xr[64 * j]; }
#pragma unroll
          for (int r = 0; r < 4; ++r) { float sq = 0.f;
#pragma unroll
              for (int j = 0; j < 8; ++j) sq += (v[r][j].x * v[r][j].x + v[r][j].y * v[r][j].y) + (v[r][j].z * v[r][j].z + v[r][j].w * v[r][j].w);
              ss[r] = 1.0f / sqrtf(wave_sum(sq) * (1.0f / DM) + EPS); }
#pragma unroll
          for (int r = 0; r < 4; ++r) if (m + r * NGW < M) { f32x4* o = (f32x4*)(X + (size_t)(m + r * NGW) * DM) + lane;
#pragma unroll
              for (int j = 0; j < 8; ++j) o[64 * j] = v[r][j] * ss[r] * gg[j]; }
      } }
}

extern "C" void kernel_launch(void* const* d_in, const int* in_sizes, int n_in, void* d_out, int out_size, void* d_ws, size_t ws_size, hipStream_t stream) {
    static int grid = 0;
    if (grid == 0) {
        if (n_in != 25 || in_sizes[0] != M * DM || out_size != M * DM || ws_size < WS_END) { fprintf(stderr, "kernel_launch: unexpected shapes / workspace (n_in %d, ws %zu, need %zu); nothing launched\n", n_in, ws_size, (size_t)WS_END); grid = -1; return; }
        int dev = 0, cus = 0, per_cu = 0;
        if (hipGetDevice(&dev) != hipSuccess || hipDeviceGetAttribute(&cus, hipDeviceAttributeMultiprocessorCount, dev) != hipSuccess) { grid = -1; return; }
        if (hipFuncSetAttribute((const void*)fwd, hipFuncAttributeMaxDynamicSharedMemorySize, LDS_BYTES) != hipSuccess) { fprintf(stderr, "kernel_launch: hipFuncSetAttribute failed\n"); grid = -1; return; }
        if (hipOccupancyMaxActiveBlocksPerMultiprocessor(&per_cu, (const void*)fwd, 512, LDS_BYTES) != hipSuccess || per_cu < 1) { fprintf(stderr, "kernel_launch: occupancy query reports %d workgroups per CU; nothing launched\n", per_cu); (void)hipGetLastError(); grid = -1; return; }
        grid = cus;
    }
    if (grid < 0) return;
    if (hipMemsetAsync((char*)d_ws + WS_CTL, 0, CTL_ZERO_BYTES, stream) != hipSuccess) return;
    Params a{};
    for (int i = 0; i < 25; ++i) a.in[i] = (const GAS float*)d_in[i];
    a.out = (GAS float*)d_out; a.ws = (GAS unsigned char*)d_ws;
    hipLaunchKernelGGL(fwd, dim3(grid), dim3(512), LDS_BYTES, stream, a);
}
```

```cpp
#include <hip/hip_runtime.h>
#include <cstdio>
#include <cstdint>

namespace pg8 {
#define PG8_LAS __attribute__((address_space(3)))
typedef unsigned short bf16_t;
typedef short bf16x8 __attribute__((ext_vector_type(8)));
typedef float f32x4 __attribute__((ext_vector_type(4)));
typedef unsigned u32x4 __attribute__((ext_vector_type(4)));
typedef unsigned u32x2 __attribute__((ext_vector_type(2)));
constexpr int BM = 256, BK = 64, HALF = 128, HTB = HALF * BK * 2  , STAGE_BYTES = 8 * HTB, NXCD = 8, WGM = 8;

__host__ __device__ __forceinline__ int lds_byte(int r, int c) { const int st = (r >> 4) * 2 + (c >> 5), rr = r & 15, cc = c & 31, ob = rr * 64 + cc * 2; return st * 1024 + (ob ^ (((ob >> 9) & 1) << 5)); }
__host__ __device__ __forceinline__ void stage_rc(int b, int& R, int& C) { const int st = b / 1024, sb = b % 1024, swz = sb ^ (((sb >> 9) & 1) << 5); R = (st >> 1) * 16 + swz / 64; C = (st & 1) * 32 + (swz % 64) / 2; }
__host__ __device__ __forceinline__ int perm32(int rho) { const int n = rho >> 4, i = rho & 15; return 8 * (i >> 2) + 4 * n + (i & 3); }

struct Unit { int pm, pn; };
struct Gemm { const bf16_t* A; const bf16_t* Bt; int M, N, K, lda, ldb; };

struct StaticOrder {
    int nM, nN, nwg, G, c;
    __host__ __device__ void init(int M, int N, int G_, int c_) { nM = M / BM; nN = N / BM; nwg = nM * nN; G = G_; c = c_; }
    __host__ __device__ bool next(int i, Unit& u) const {
        const long L = (long)i * G + c; if (L >= nwg) return false;
        int wgid = (int)L; { const int q = nwg / NXCD, r = nwg % NXCD, xcd = wgid % NXCD, off = wgid / NXCD; wgid = (xcd < r ? xcd * (q + 1) : r * (q + 1) + (xcd - r) * q) + off; }
        const int nig = WGM * nN, gid = wgid / nig, fm = gid * WGM, gsz = (nM - fm) < WGM ? (nM - fm) : WGM;
        u.pm = fm + ((wgid % nig) % gsz); u.pn = (wgid % nig) / gsz; return true;
    }
    __device__ __forceinline__ void a_ready(const Unit&) const {}
    __device__ __forceinline__ void done(const Unit&) const {}
};
struct SimpleOrder {
    int nM, nN, nwg, G, c;
    __host__ __device__ void init(int M, int N, int G_, int c_) { nM = M / BM; nN = N / BM; nwg = nM * nN; G = G_; c = c_; }
    __host__ __device__ bool next(int i, Unit& u) const {
        const long L = (long)i * G + c; if (L < 0 || L >= nwg) return false;
        u.pm = (int)(L % nM); u.pn = (int)(L / nM); return true;
    }
    __device__ __forceinline__ void a_ready(const Unit&) const {}
    __device__ __forceinline__ void done(const Unit&) const {}
};

__device__ __forceinline__ unsigned cvt_pk_bf16(float lo, float hi) { unsigned r; asm volatile("v_cvt_pk_bf16_f32 %0, %1, %2" : "=v"(r) : "v"(lo), "v"(hi)); return r; }

__device__ __forceinline__ float fsigmoid(float x) { return __builtin_amdgcn_rcpf(1.0f + __builtin_amdgcn_exp2f(-1.4426950408889634f * x)); }
__device__ __forceinline__ float bf_lo(unsigned w) { return __uint_as_float(w << 16); }
__device__ __forceinline__ float bf_hi(unsigned w) { return __uint_as_float(w & 0xffff0000u); }

struct EpiSwiglu {
    static constexpr bool PERM = true, AFTER_DRAIN = false;
    bf16_t* H; int ldh;
    __device__ __forceinline__ void operator()(const f32x4 (&acc)[2][2][4][2], const Unit& u, int wr, int wc, int fr, int fq) const {
        const int row0 = u.pm * BM + wr * 64 + fr, col0 = u.pn * HALF + wc * 32 + 8 * fq;
#pragma unroll
        for (int ai = 0; ai < 2; ++ai)
#pragma unroll
            for (int m = 0; m < 4; ++m) {
                bf16_t* rowp = H + (size_t)(row0 + ai * HALF + m * 16) * ldh + col0;
                const f32x4 g0 = acc[ai][0][m][0], g1 = acc[ai][0][m][1], u0 = acc[ai][1][m][0], u1 = acc[ai][1][m][1];
                float o[8];
#pragma unroll
                for (int j = 0; j < 4; ++j) { o[j] = g0[j] * fsigmoid(g0[j]) * u0[j]; o[4 + j] = g1[j] * fsigmoid(g1[j]) * u1[j]; }
                u32x4 w; w.x = cvt_pk_bf16(o[0], o[1]); w.y = cvt_pk_bf16(o[2], o[3]); w.z = cvt_pk_bf16(o[4], o[5]); w.w = cvt_pk_bf16(o[6], o[7]);
                *(u32x4*)rowp = w;
            }
    }
};
struct EpiResid {
    static constexpr bool PERM = false, AFTER_DRAIN = false;
    const float* src; float* out; int ldc; float alpha;
    __device__ __forceinline__ void operator()(const f32x4 (&acc)[2][2][4][2], const Unit& u, int wr, int wc, int fr, int fq) const {
        const int row0 = u.pm * BM + wr * 64 + fr, col0 = u.pn * BM + wc * 32 + 4 * fq;
#pragma unroll
        for (int ai = 0; ai < 2; ++ai)
#pragma unroll
            for (int m = 0; m < 4; ++m) {
                const size_t off = (size_t)(row0 + ai * HALF + m * 16) * ldc + col0;
                f32x4 s[2][2];
#pragma unroll
                for (int bj = 0; bj < 2; ++bj)
#pragma unroll
                    for (int n = 0; n < 2; ++n) s[bj][n] = *(const f32x4*)(src + off + bj * HALF + n * 16);
#pragma unroll
                for (int bj = 0; bj < 2; ++bj)
#pragma unroll
                    for (int n = 0; n < 2; ++n) *(f32x4*)(out + off + bj * HALF + n * 16) = s[bj][n] + acc[ai][bj][m][n] * alpha;
                if (m & 1) asm volatile("" ::: "memory");
            }
    }
};
struct EpiProj {
    static constexpr bool PERM = true, AFTER_DRAIN = false;
    bf16_t* P; int ldp; float* side;
    __device__ __forceinline__ void operator()(const f32x4 (&acc)[2][2][4][2], const Unit& u, int wr, int wc, int fr, int fq) const {
        const int row0 = u.pm * BM + wr * 64 + fr, cw = wc * 32 + 8 * fq;
        if (u.pn == 7) {
            if (cw < 72) {
#pragma unroll
                for (int ai = 0; ai < 2; ++ai)
#pragma unroll
                    for (int m = 0; m < 4; ++m) { float* rp = side + (size_t)(row0 + ai * HALF + m * 16) * 72 + cw; *(f32x4*)rp = acc[ai][0][m][0]; *(f32x4*)(rp + 4) = acc[ai][0][m][1]; }
            }
            return;
        }
        const int colbase = 256 * (u.pn > 7 ? u.pn - 1 : u.pn) + cw; const bool sig = u.pn >= 20;
#pragma unroll
        for (int ai = 0; ai < 2; ++ai)
#pragma unroll
            for (int m = 0; m < 4; ++m) {
                bf16_t* rowp = P + (size_t)(row0 + ai * HALF + m * 16) * ldp + colbase;
#pragma unroll
                for (int bj = 0; bj < 2; ++bj) {
                    f32x4 v0 = acc[ai][bj][m][0] + 0.0f, v1 = acc[ai][bj][m][1] + 0.0f;
                    if (sig) {
#pragma unroll
                        for (int j = 0; j < 4; ++j) { v0[j] = fsigmoid(v0[j]); v1[j] = fsigmoid(v1[j]); }
                    }
                    u32x4 w; w.x = cvt_pk_bf16(v0[0], v0[1]); w.y = cvt_pk_bf16(v0[2], v0[3]); w.z = cvt_pk_bf16(v1[0], v1[1]); w.w = cvt_pk_bf16(v1[2], v1[3]);
                    *(u32x4*)(rowp + bj * HALF) = w;
                }
            }
    }
};
template <int J> struct EpiBranch {
    static constexpr bool PERM = true, AFTER_DRAIN = false;
    const bf16_t* gate; int ldg; float* tmp; bf16_t* outb; int ldc;
    __device__ __forceinline__ void operator()(const f32x4 (&acc)[2][2][4][2], const Unit& u, int wr, int wc, int fr, int fq) const {
        const int row0 = u.pm * BM + wr * 64 + fr, col0 = u.pn * BM + wc * 32 + 8 * fq;
#pragma unroll
        for (int ai = 0; ai < 2; ++ai)
#pragma unroll
            for (int m = 0; m < 4; ++m) {
                const int row = row0 + ai * HALF + m * 16;
#pragma unroll
                for (int bj = 0; bj < 2; ++bj) {
                    const int c = col0 + bj * HALF;
                    const u32x4 gv = *(const u32x4*)(gate + (size_t)row * ldg + c);
                    f32x4 t0, t1;
                    t0[0] = bf_lo(gv.x) * acc[ai][bj][m][0][0]; t0[1] = bf_hi(gv.x) * acc[ai][bj][m][0][1]; t0[2] = bf_lo(gv.y) * acc[ai][bj][m][0][2]; t0[3] = bf_hi(gv.y) * acc[ai][bj][m][0][3];
                    t1[0] = bf_lo(gv.z) * acc[ai][bj][m][1][0]; t1[1] = bf_hi(gv.z) * acc[ai][bj][m][1][1]; t1[2] = bf_lo(gv.w) * acc[ai][bj][m][1][2]; t1[3] = bf_hi(gv.w) * acc[ai][bj][m][1][3];
                    float* tp = tmp + (size_t)row * ldc + c;
                    if (J > 0) { t0 += *(const f32x4*)tp; t1 += *(const f32x4*)(tp + 4); }
                    if (J < 2) { *(f32x4*)tp = t0; *(f32x4*)(tp + 4) = t1; }
                    else { u32x4 w; w.x = cvt_pk_bf16(t0[0], t0[1]); w.y = cvt_pk_bf16(t0[2], t0[3]); w.z = cvt_pk_bf16(t1[0], t1[1]); w.w = cvt_pk_bf16(t1[2], t1[3]);
                        *(u32x4*)(outb + (size_t)row * ldc + c) = w; }
                }
                asm volatile("" ::: "memory");
            }
    }
};
struct EpiMerge {
    static constexpr bool PERM = true, AFTER_DRAIN = false;
    const bf16_t* gate; int ldg; const bf16_t* z0; const bf16_t* z1; bf16_t* outb; int ldc;
    __device__ __forceinline__ void operator()(const f32x4 (&acc)[2][2][4][2], const Unit& u, int wr, int wc, int fr, int fq) const {
        const int row0 = u.pm * BM + wr * 64 + fr, col0 = u.pn * BM + wc * 32 + 8 * fq;
#pragma unroll
        for (int ai = 0; ai < 2; ++ai)
#pragma unroll
            for (int m = 0; m < 4; ++m) {
                const int row = row0 + ai * HALF + m * 16;
                u32x4 g0[2], g1[2], g2[2], a0[2], a1[2];
#pragma unroll
                for (int bj = 0; bj < 2; ++bj) { const int c = col0 + bj * HALF; const bf16_t* gp = gate + (size_t)row * ldg + c;
                    g0[bj] = *(const u32x4*)gp; g1[bj] = *(const u32x4*)(gp + 2048); g2[bj] = *(const u32x4*)(gp + 4096);
                    a0[bj] = *(const u32x4*)(z0 + (size_t)row * ldc + c); a1[bj] = *(const u32x4*)(z1 + (size_t)row * ldc + c); }
#pragma unroll
                for (int bj = 0; bj < 2; ++bj) {
                    const unsigned G0[4] = {g0[bj].x, g0[bj].y, g0[bj].z, g0[bj].w}, G1[4] = {g1[bj].x, g1[bj].y, g1[bj].z, g1[bj].w}, G2[4] = {g2[bj].x, g2[bj].y, g2[bj].z, g2[bj].w};
                    const unsigned A0[4] = {a0[bj].x, a0[bj].y, a0[bj].z, a0[bj].w}, A1[4] = {a1[bj].x, a1[bj].y, a1[bj].z, a1[bj].w};
                    unsigned w[4];
#pragma unroll
                    for (int k = 0; k < 4; ++k) {
                        const float lo = bf_lo(G0[k]) * bf_lo(A0[k]) + bf_lo(G1[k]) * bf_lo(A1[k]) + bf_lo(G2[k]) * acc[ai][bj][m][k >> 1][2 * (k & 1)];
                        const float hi = bf_hi(G0[k]) * bf_hi(A0[k]) + bf_hi(G1[k]) * bf_hi(A1[k]) + bf_hi(G2[k]) * acc[ai][bj][m][k >> 1][2 * (k & 1) + 1];
                        w[k] = cvt_pk_bf16(lo, hi); }
                    *(u32x4*)(outb + (size_t)row * ldc + col0 + bj * HALF) = (u32x4){w[0], w[1], w[2], w[3]};
                }
                asm volatile("" ::: "memory");
            }
    }
};
struct EpiBf16 {
    static constexpr bool PERM = true, AFTER_DRAIN = false;
    bf16_t* C; int ldc;
    __device__ __forceinline__ void operator()(const f32x4 (&acc)[2][2][4][2], const Unit& u, int wr, int wc, int fr, int fq) const {
        const int row0 = u.pm * BM + wr * 64 + fr, col0 = u.pn * BM + wc * 32 + 8 * fq;
#pragma unroll
        for (int ai = 0; ai < 2; ++ai)
#pragma unroll
            for (int m = 0; m < 4; ++m) {
                bf16_t* rowp = C + (size_t)(row0 + ai * HALF + m * 16) * ldc + col0;
#pragma unroll
                for (int bj = 0; bj < 2; ++bj) {
                    const f32x4 v0 = acc[ai][bj][m][0] + 0.0f, v1 = acc[ai][bj][m][1] + 0.0f;
                    u32x4 w; w.x = cvt_pk_bf16(v0[0], v0[1]); w.y = cvt_pk_bf16(v0[2], v0[3]); w.z = cvt_pk_bf16(v1[0], v1[1]); w.w = cvt_pk_bf16(v1[2], v1[3]);
                    *(u32x4*)(rowp + bj * HALF) = w;
                }
            }
    }
};

template <class Epi, class Sched, bool ALIGN_EPI = false, bool SP2 = false>
__device__ __forceinline__ void gemm_phase(PG8_LAS unsigned char* lds, const Gemm g, const Sched& S, const Epi& E, const int tid) {
    const int wid = __builtin_amdgcn_readfirstlane(tid >> 6), lane = tid & 63, wr = wid >> 2, wc = wid & 3, fr = lane & 15, fq = lane >> 4;
    const int K = g.K, nt = K / BK;
    unsigned voffA[2], voffB[2];
#pragma unroll
    for (int i = 0; i < 2; ++i) { int R, C; stage_rc(tid * 16 + i * 8192, R, C); const int Rb = Epi::PERM ? ((R & ~31) + perm32(R & 31)) : R;
        voffA[i] = (unsigned)(R * g.lda + C) * 2u; voffB[i] = (unsigned)(Rb * g.ldb + C) * 2u; }
    const size_t kstep = (size_t)(BK * 2);
    const size_t hstepA = (size_t)HALF * g.lda * 2, hstepB = (size_t)HALF * g.ldb * 2;
    const size_t tstepA = 2 * hstepA, tstepB = 2 * hstepB;
    const unsigned ldsw = (unsigned)wid * 1024u;
    const int aoff = lds_byte(wr * 64 + fr, fq * 8), boff = lds_byte(wc * 32 + fr, fq * 8);
#define PG8_SA(b, h) (((b) * 2 + (h)) * HTB)
#define PG8_SB(b, h) ((4 + (b) * 2 + (h)) * HTB)
#define PG8_STAGE(bufoff, gbase, voff) do { _Pragma("unroll") for (int _i = 0; _i < 2; ++_i) \
        __builtin_amdgcn_global_load_lds((const unsigned*)((const char*)(gbase) + (voff)[_i]), (PG8_LAS unsigned*)(lds + (bufoff) + ldsw + _i * 8192), 16, 0, 0); } while (0)
#define PG8_LDA(dst, b, h) do { _Pragma("unroll") for (int m = 0; m < 4; ++m) _Pragma("unroll") for (int k = 0; k < 2; ++k) dst[m][k] = *(const PG8_LAS bf16x8*)(lds + PG8_SA(b, h) + aoff + m * 2048 + k * 1024); } while (0)
#define PG8_LDB(dst, b, h) do { _Pragma("unroll") for (int n = 0; n < 2; ++n) _Pragma("unroll") for (int k = 0; k < 2; ++k) dst[n][k] = *(const PG8_LAS bf16x8*)(lds + PG8_SB(b, h) + boff + n * 2048 + k * 1024); } while (0)
#define PG8_MMA(ai, bj, At, Bt) do { __builtin_amdgcn_s_setprio(1); _Pragma("unroll") for (int m = 0; m < 4; ++m) _Pragma("unroll") for (int n = 0; n < 2; ++n) _Pragma("unroll") for (int k = 0; k < 2; ++k) \
        acc[ai][bj][m][n] = __builtin_amdgcn_mfma_f32_16x16x32_bf16(Bt[n][k], At[m][k], acc[ai][bj][m][n], 0, 0, 0); __builtin_amdgcn_s_setprio(0); } while (0)
#define PG8_WAIT_V(n) asm volatile("s_waitcnt vmcnt(" #n ")" ::: "memory")
#define PG8_WAIT_L(n) asm volatile("s_waitcnt lgkmcnt(" #n ")" ::: "memory")
#define PG8_BAR __builtin_amdgcn_s_barrier()
#define PG8_SCHED __builtin_amdgcn_sched_barrier(0)
    Unit cur, nxt; int ui = 0;
    if (!S.next(0, cur)) return;
    f32x4 acc[2][2][4][2];
#pragma unroll
    for (int a = 0; a < 2; ++a)
#pragma unroll
        for (int b = 0; b < 2; ++b)
#pragma unroll
            for (int m = 0; m < 4; ++m)
#pragma unroll
                for (int n = 0; n < 2; ++n) acc[a][b][m][n] = (f32x4){0.f, 0.f, 0.f, 0.f};
    bf16x8 At[4][2], B0[2][2], B1[2][2];
    const char* cA = (const char*)g.A + (size_t)cur.pm * tstepA; const char* cB = (const char*)g.Bt + (size_t)cur.pn * tstepB;
    S.a_ready(cur);
    if constexpr (SP2) {
        PG8_STAGE(PG8_SB(0, 0), cB, voffB); PG8_STAGE(PG8_SB(0, 1), cB + hstepB, voffB); PG8_STAGE(PG8_SA(0, 0), cA, voffA); PG8_STAGE(PG8_SA(0, 1), cA + hstepA, voffA);
        if (wr == 1) PG8_BAR;
        PG8_WAIT_V(2); PG8_BAR;
        PG8_STAGE(PG8_SB(1, 0), cB + kstep, voffB); PG8_STAGE(PG8_SA(1, 0), cA + kstep, voffA); PG8_STAGE(PG8_SB(1, 1), cB + hstepB + kstep, voffB);
        PG8_WAIT_V(6); PG8_BAR;
    } else {
        PG8_STAGE(PG8_SB(0, 0), cB, voffB); PG8_STAGE(PG8_SA(0, 0), cA, voffA); PG8_STAGE(PG8_SB(0, 1), cB + hstepB, voffB); PG8_STAGE(PG8_SA(0, 1), cA + hstepA, voffA);
        if (wr == 1) PG8_BAR;
        PG8_WAIT_V(4); PG8_BAR;
        PG8_STAGE(PG8_SB(1, 0), cB + kstep, voffB); PG8_STAGE(PG8_SA(1, 0), cA + kstep, voffA); PG8_STAGE(PG8_SB(1, 1), cB + hstepB + kstep, voffB);
        PG8_WAIT_V(6); PG8_BAR;
    }
    for (;;) {
        const bool has_next = S.next(ui + 1, nxt);
        const char* nA = has_next ? (const char*)g.A + (size_t)nxt.pm * tstepA : cA; const char* nB = has_next ? (const char*)g.Bt + (size_t)nxt.pn * tstepB : cB;
        for (int t = 0; t < nt; t += 2) {
            const bool last = (t == nt - 2);
            const char* a1 = cA + (size_t)(t + 1) * kstep;
            const char* a2 = last ? nA : cA + (size_t)(t + 2) * kstep; const char* b2 = last ? nB : cB + (size_t)(t + 2) * kstep;
            const char* a3 = a2 + kstep; const char* b3 = b2 + kstep;
            if (last && has_next) S.a_ready(nxt);
            if constexpr (SP2) {
            PG8_LDB(B0, 0, 0); PG8_LDB(B1, 0, 1); PG8_SCHED; PG8_LDA(At, 0, 0); PG8_STAGE(PG8_SA(1, 1), a1 + hstepA, voffA);
            PG8_WAIT_V(8); PG8_WAIT_L(0); PG8_BAR; PG8_MMA(0, 0, At, B0); PG8_MMA(0, 1, At, B1); PG8_BAR; PG8_SCHED;
            PG8_LDA(At, 0, 1); PG8_STAGE(PG8_SB(0, 0), b2, voffB); PG8_STAGE(PG8_SB(0, 1), b2 + hstepB, voffB); PG8_STAGE(PG8_SA(0, 0), a2, voffA);
            PG8_WAIT_V(8); PG8_WAIT_L(0); PG8_BAR; PG8_MMA(1, 0, At, B0); PG8_MMA(1, 1, At, B1); PG8_BAR; PG8_SCHED;
            PG8_LDB(B0, 1, 0); PG8_LDB(B1, 1, 1); PG8_SCHED; PG8_LDA(At, 1, 0); PG8_STAGE(PG8_SA(0, 1), a2 + hstepA, voffA);
            PG8_WAIT_V(8); PG8_WAIT_L(0); PG8_BAR; PG8_MMA(0, 0, At, B0); PG8_MMA(0, 1, At, B1); PG8_BAR; PG8_SCHED;
            PG8_LDA(At, 1, 1); PG8_STAGE(PG8_SB(1, 0), b3, voffB); PG8_STAGE(PG8_SB(1, 1), b3 + hstepB, voffB); PG8_STAGE(PG8_SA(1, 0), a3, voffA);
            PG8_WAIT_V(8); PG8_WAIT_L(0); PG8_BAR; PG8_MMA(1, 0, At, B0); PG8_MMA(1, 1, At, B1); PG8_BAR; PG8_SCHED;
            } else {
            PG8_LDB(B0, 0, 0); PG8_SCHED; PG8_LDA(At, 0, 0); PG8_STAGE(PG8_SA(1, 1), a1 + hstepA, voffA);
            PG8_WAIT_L(8); PG8_BAR; PG8_WAIT_L(0); PG8_MMA(0, 0, At, B0); PG8_BAR; PG8_SCHED;
            PG8_LDB(B1, 0, 1); PG8_STAGE(PG8_SB(0, 0), b2, voffB);
            PG8_BAR; PG8_WAIT_L(0); PG8_MMA(0, 1, At, B1); PG8_BAR;
            PG8_LDA(At, 0, 1); PG8_STAGE(PG8_SA(0, 0), a2, voffA);
            PG8_BAR; PG8_WAIT_L(0); PG8_MMA(1, 0, At, B0); PG8_BAR; PG8_SCHED;
            PG8_STAGE(PG8_SB(0, 1), b2 + hstepB, voffB);
            PG8_WAIT_V(6); PG8_BAR; PG8_MMA(1, 1, At, B1); PG8_BAR;
            PG8_LDB(B0, 1, 0); PG8_SCHED; PG8_LDA(At, 1, 0); PG8_STAGE(PG8_SA(0, 1), a2 + hstepA, voffA);
            PG8_WAIT_L(8); PG8_BAR; PG8_WAIT_L(0); PG8_MMA(0, 0, At, B0); PG8_BAR; PG8_SCHED;
            PG8_LDB(B1, 1, 1); PG8_STAGE(PG8_SB(1, 0), b3, voffB);
            PG8_BAR; PG8_WAIT_L(0); PG8_MMA(0, 1, At, B1); PG8_BAR;
            PG8_LDA(At, 1, 1); PG8_STAGE(PG8_SA(1, 0), a3, voffA);
            PG8_BAR; PG8_WAIT_L(0); PG8_MMA(1, 0, At, B0); PG8_BAR; PG8_SCHED;
            PG8_STAGE(PG8_SB(1, 1), b3 + hstepB, voffB);
            PG8_WAIT_V(6); PG8_BAR; PG8_MMA(1, 1, At, B1); PG8_BAR;
            }
        }
        if constexpr (ALIGN_EPI) { if (wr == 0) PG8_BAR; }
        if constexpr (!Epi::AFTER_DRAIN) { E(acc, cur, wr, wc, fr, fq); S.done(cur); }
        if (!has_next) break;
#pragma unroll
        for (int a = 0; a < 2; ++a)
#pragma unroll
            for (int b = 0; b < 2; ++b)
#pragma unroll
                for (int m = 0; m < 4; ++m)
#pragma unroll
                    for (int n = 0; n < 2; ++n) acc[a][b][m][n] = (f32x4){0.f, 0.f, 0.f, 0.f};
        cur = nxt; cA = nA; cB = nB; ++ui;
        if constexpr (ALIGN_EPI) { if (wr == 1) PG8_BAR; }
    }
    PG8_WAIT_V(0);
    if constexpr (!ALIGN_EPI) { if (wr == 0) PG8_BAR; }
    PG8_BAR;
    if constexpr (Epi::AFTER_DRAIN) { E.fused(acc, cur, wr, wc, fr, fq, lds, wid, lane); S.done(cur); }
#undef PG8_SA
#undef PG8_SB
#undef PG8_STAGE
#undef PG8_LDA
#undef PG8_LDB
#undef PG8_MMA
#undef PG8_WAIT_V
#undef PG8_WAIT_L
#undef PG8_BAR
#undef PG8_SCHED
}
}

constexpr int BATCH = 2, SEQ = 8192, M = BATCH * SEQ, DM = 2048, DFF = 5504, NMEM = 256, DEPTH = 2;
constexpr int DIN = 11076, DIN_PAD = 11264, PLD = 11008;
constexpr int C_QA = 0, C_KA = 1024, C_VA = 1280, C_QI = 1536, C_XL = 1792, C_GL = 2816, C_QM = 3840, C_GT = 4864;
constexpr float EPS = 1e-6f, LOG2E = 1.4426950408889634f;

constexpr size_t MiB = 1u << 20;
constexpr size_t WS_CTL = 0, CTL_ZERO_BYTES = 1 * MiB;
constexpr size_t WS_WGU = 2 * MiB, WS_WDN = 45 * MiB, WS_WIN = 67 * MiB, WS_WMKV = 111 * MiB, WS_WBR = 119 * MiB, WS_WOUT = 131 * MiB;
constexpr size_t WS_WGU2 = 139 * MiB, WS_WDN2 = 182 * MiB, WS_WAT = 204 * MiB, WS_WIT = 204 * MiB + 512 * 1024;
constexpr size_t WS_XN = 206 * MiB, WS_R1 = 270 * MiB, WS_SCR = 614 * MiB, WS_SIDE = 742 * MiB, WS_KIDX = 747 * MiB, WS_WIDX = 749 * MiB;
constexpr size_t WS_MASK = 750 * MiB, WS_VT = 766 * MiB, WS_MK = 774 * MiB, WS_VTM = 775 * MiB, WS_MEMN = 776 * MiB, WS_AGG = 778 * MiB, WS_END = 780 * MiB;
constexpr int CW_BAR = 4096;

constexpr int LDS_BYTES = 163840, MISC_OFF = LDS_BYTES - 256;

#define LAS __attribute__((address_space(3)))
typedef unsigned short bf16;
typedef short bf16x8 __attribute__((ext_vector_type(8)));
typedef float f32x4 __attribute__((ext_vector_type(4)));
typedef float f32x16 __attribute__((ext_vector_type(16)));
typedef unsigned u32x4 __attribute__((ext_vector_type(4)));
typedef unsigned u32x2 __attribute__((ext_vector_type(2)));
#define LDS_WAIT() asm volatile("s_waitcnt lgkmcnt(0)" ::: "memory")
#define VM_WAIT() asm volatile("s_waitcnt vmcnt(0)" ::: "memory")
__device__ __forceinline__ unsigned f2bf(float f) { unsigned u = __builtin_bit_cast(unsigned, f); return (u + 0x7fffu + ((u >> 16) & 1u)) >> 16; }
__device__ __forceinline__ unsigned pk2(float lo, float hi) { return f2bf(lo) | (f2bf(hi) << 16); }
__device__ __forceinline__ unsigned pkbf(float lo, float hi) { unsigned r; asm("v_cvt_pk_bf16_f32 %0, %1, %2" : "=v"(r) : "v"(lo), "v"(hi)); return r; }
__device__ __forceinline__ float bflo(unsigned w) { return __uint_as_float(w << 16); }
__device__ __forceinline__ float bfhi(unsigned w) { return __uint_as_float(w & 0xffff0000u); }

#define XB_TMO      128
#define XB_XCNT(j)  (256  + 64 * (j))
#define XB_XSUB(j)  (1280 + 64 * (j))
#define XB_XGEN(j)  (2304 + 64 * (j))
#define XB_TOP      3328
#define XB_TOPGEN   3392
#define XCD_BAR_WORDS 3456
#define XB_SPIN_CAP (1u << 18)

__device__ __forceinline__ unsigned xb_ld(unsigned* p)              { return __hip_atomic_load(p, __ATOMIC_RELAXED, __HIP_MEMORY_SCOPE_AGENT); }
__device__ __forceinline__ unsigned xb_add(unsigned* p, unsigned v) { return __hip_atomic_fetch_add(p, v, __ATOMIC_RELAXED, __HIP_MEMORY_SCOPE_AGENT); }
__device__ __forceinline__ unsigned xb_xcc_id() { return (unsigned)__builtin_amdgcn_s_getreg((3 << 11) | 20) & 0xFu; }
#define XB_SPIN(cond, bar) do { unsigned _sp = 0; while (cond) { __builtin_amdgcn_s_sleep(1); \
    if ((++_sp & 255u) == 0u) { if (xb_ld(&(bar)[XB_TMO])) break; if (_sp > XB_SPIN_CAP) { atomicAdd(&(bar)[XB_TMO], 1u); break; } } } } while (0)

struct XcdBarrier {
    unsigned* bar; unsigned x;
    volatile LAS unsigned* st;
};
__device__ __forceinline__ XcdBarrier xcd_barrier_post(unsigned* bar, volatile LAS unsigned* st) {
    XcdBarrier b; b.bar = bar; b.x = xb_xcc_id(); b.st = st;
    if (threadIdx.x == 0) (void)xb_add(&bar[XB_XCNT(b.x)], 1u);
    return b;
}
__device__ __forceinline__ void xcd_barrier_complete(unsigned* bar, unsigned x, unsigned& nloc, unsigned& nx) {
    const unsigned G = gridDim.x * gridDim.y * gridDim.z;
    unsigned sum, cnt, mine, sp = 0u;
    for (;;) {
        sum = 0u; cnt = 0u; mine = 0u;
#pragma unroll
        for (unsigned j = 0; j < 16; ++j) { const unsigned c = xb_ld(&bar[XB_XCNT(j)]); sum += c; cnt += (c > 0u) ? 1u : 0u; mine = (j == x) ? c : mine; }
        if (sum == G) break;
        __builtin_amdgcn_s_sleep(1);
        if ((++sp & 255u) == 0u) { if (xb_ld(&bar[XB_TMO])) break; if (sp > XB_SPIN_CAP) { atomicAdd(&bar[XB_TMO], 1u); break; } }
    }
    nloc = mine > 0u ? mine : 1u; nx = cnt > 0u ? cnt : 1u;
}
__device__ __forceinline__ void xcd_barrier(const XcdBarrier& b) {
    asm volatile("s_waitcnt vmcnt(0)" ::: "memory");
    __syncthreads();
    if (threadIdx.x == 0) {
        unsigned* bar = b.bar;
        __builtin_amdgcn_s_waitcnt(0);
        unsigned nloc = b.st[0], nx = b.st[1];
        if (nloc == 0u) { xcd_barrier_complete(bar, b.x, nloc, nx); b.st[0] = nloc; b.st[1] = nx; }
        const unsigned old = xb_add(&bar[XB_XSUB(b.x)], 1u);
        const unsigned gen = old / nloc;
        if (old + 1u == (gen + 1u) * nloc) {
            __builtin_amdgcn_fence(__ATOMIC_RELEASE, "agent");
            asm volatile("s_waitcnt vmcnt(0)" ::: "memory");
            const unsigned og = xb_add(&bar[XB_TOP], 1u);
            const unsigned tg = og / nx;
            if (og + 1u == (tg + 1u) * nx) xb_add(&bar[XB_TOPGEN], 1u);
            else XB_SPIN(xb_ld(&bar[XB_TOPGEN]) == tg, bar);
            __builtin_amdgcn_fence(__ATOMIC_ACQUIRE, "agent");
            xb_add(&bar[XB_XGEN(b.x)], 1u);
            asm volatile("s_waitcnt vmcnt(0)" ::: "memory");
        } else {
            XB_SPIN(xb_ld(&bar[XB_XGEN(b.x)]) == gen, bar);
            __builtin_amdgcn_fence(__ATOMIC_ACQUIRE, "agent");
            asm volatile("s_waitcnt vmcnt(0)" ::: "memory");
        }
    }
    __syncthreads();
}

#define GAS __attribute__((address_space(1)))
struct Params { const GAS float* in[25]; GAS float* out; GAS unsigned char* ws; };
typedef const Params __attribute__((address_space(4)))* KP;
__device__ __forceinline__ KP kargs() { KP k = (KP)__builtin_amdgcn_kernarg_segment_ptr(); asm volatile("" : "+s"(k)); return k; }
__device__ __forceinline__ const float* gin(KP k, int i) { return (const float*)k->in[i]; }
__device__ __forceinline__ float* gout(KP k) { return (float*)k->out; }
__device__ __forceinline__ unsigned char* gws(KP k) { return (unsigned char*)k->ws; }
__device__ __forceinline__ int lane_id_asm() { int l; asm volatile("v_mbcnt_lo_u32_b32 %0, -1, 0\n\tv_mbcnt_hi_u32_b32 %0, -1, %0" : "=v"(l)); return l; }
__device__ __forceinline__ int launder_s(int v) { asm volatile("" : "+s"(v)); return v; }
__device__ __forceinline__ int launder_v(int v) { asm volatile("" : "+v"(v)); return v; }
enum { I_X = 0, I_MEM, I_RELB, I_FNORM, I_NFF1, I_WGU1, I_WDN1, I_NMIX, I_WIN, I_CONVW, I_CONVB, I_WA, I_BA, I_WI, I_BI, I_LAM, I_LNG, I_LNB, I_MEMNORM, I_WMKV, I_WBR, I_WOUT, I_NFF2, I_WGU2, I_WDN2 };

__device__ __forceinline__ float wave_sum(float v) {
#pragma unroll
    for (int o = 1; o < 64; o <<= 1) v += __shfl_xor(v, o);
    return v;
}
__device__ __forceinline__ f32x4 mfma16(bf16x8 a, bf16x8 b, f32x4 c) { return __builtin_amdgcn_mfma_f32_16x16x32_bf16(a, b, c, 0, 0, 0); }
__device__ __forceinline__ f32x16 mfma32(bf16x8 a, bf16x8 b, f32x16 c) { return __builtin_amdgcn_mfma_f32_32x32x16_bf16(a, b, c, 0, 0, 0); }

__device__ __forceinline__ void tr_item(const float* W, int ldw, int scol0, int nvalid, bf16* WT, int ldt, int drow0, int k0, LAS float* scr, int lane) {
    if (nvalid == 32) {
#pragma unroll
        for (int i = 0; i < 8; ++i) { const int kk = 8 * i + (lane >> 3), c4 = (lane & 7) * 4;
            const f32x4 v = *(const f32x4*)(W + (size_t)(k0 + kk) * ldw + scol0 + c4);
            LAS float* d = scr + kk * 33 + c4; d[0] = v.x; d[1] = v.y; d[2] = v.z; d[3] = v.w; }
    } else {
#pragma unroll 8
        for (int i = 0; i < 32; ++i) { const int kk = 2 * i + (lane >> 5), c = lane & 31; scr[kk * 33 + c] = (c < nvalid) ? W[(size_t)(k0 + kk) * ldw + scol0 + c] : 0.f; }
    }
    LDS_WAIT(); asm volatile("" ::: "memory");
    const int c = lane & 7;
#pragma unroll
    for (int j = 0; j < 4; ++j) { const int n = (lane >> 3) + 8 * j; const LAS float* s = scr + (8 * c) * 33 + n;
        u32x4 o; o.x = pkbf(s[0 * 33], s[1 * 33]); o.y = pkbf(s[2 * 33], s[3 * 33]); o.z = pkbf(s[4 * 33], s[5 * 33]); o.w = pkbf(s[6 * 33], s[7 * 33]);
        *(u32x4*)(WT + (size_t)(drow0 + n) * ldt + k0 + 8 * c) = o; }
    LDS_WAIT(); asm volatile("" ::: "memory");
}
__device__ __forceinline__ void tr_plain(const float* W, int K, int N, bf16* WT, int item, LAS float* scr, int lane) {
    const int nblk = N / 32, kb = item / nblk, nb = item % nblk;
    tr_item(W, N, 32 * nb, 32, WT, K, 32 * nb, 64 * kb, scr, lane);
}
__device__ __forceinline__ void tr_gu(const float* W, bf16* WT, int item, LAS float* scr, int lane) {
    const int nblk = 2 * DFF / 32, kb = item / nblk, nb = item % nblk, n0 = 32 * nb, T = n0 >> 8, wi = n0 & 255;
    const int sc = wi < 128 ? 128 * T + wi : DFF + 128 * T + (wi - 128);
    tr_item(W, 2 * DFF, sc, 32, WT, DM, n0, 64 * kb, scr, lane);
}
__device__ __forceinline__ void tr_win(const float* W, bf16* WT, int item, LAS float* scr, int lane) {
    const int nblk = DIN_PAD / 32, kb = item / nblk, nb = item % nblk, n0 = 32 * nb;
    int sc, nv;
    if (n0 < 1792) { sc = n0; nv = 32; }
    else if (n0 < 2048) { const int off = n0 - 1792; sc = 1792 + off; nv = 68 - off; nv = nv < 0 ? 0 : (nv > 32 ? 32 : nv); if (nv == 0) sc = 0; }
    else { sc = n0 - 188; nv = 32; }
    tr_item(W, DIN, sc, nv, WT, DM, n0, 64 * kb, scr, lane);
}

__device__ __forceinline__ void rms_row_bf16(const float* xrow, const float* g, bf16* orow, int lane) {
    const f32x4* xr = (const f32x4*)xrow + lane; const f32x4* gr = (const f32x4*)g + lane;
    f32x4 v[8]; float s = 0.f;
#pragma unroll
    for (int j = 0; j < 8; ++j) { v[j] = xr[64 * j]; s += (v[j].x * v[j].x + v[j].y * v[j].y) + (v[j].z * v[j].z + v[j].w * v[j].w); }
    const float rstd = 1.0f / sqrtf(wave_sum(s) * (1.0f / DM) + EPS);
    u32x2* o8 = (u32x2*)orow + lane;
#pragma unroll
    for (int j = 0; j < 8; ++j) { const f32x4 gg = gr[64 * j]; u32x2 w; w.x = pk2(v[j].x * rstd * gg.x, v[j].y * rstd * gg.y); w.y = pk2(v[j].z * rstd * gg.z, v[j].w * rstd * gg.w); o8[64 * j] = w; }
}
__device__ __forceinline__ void rms_rows_bf16(const float* x, const float* g, bf16* out, int gw, int NGW, int lane) {
    const f32x4* gr = (const f32x4*)g + lane;
    f32x4 gg[8];
#pragma unroll
    for (int j = 0; j < 8; ++j) gg[j] = gr[64 * j];
    for (int m = gw; m < M; m += 4 * NGW) {
        f32x4 v[4][8]; float ss[4];
#pragma unroll
        for (int r = 0; r < 4; ++r) { const int mr = (m + r * NGW < M) ? m + r * NGW : m; const f32x4* xr = (const f32x4*)(x + (size_t)mr * DM) + lane;
#pragma unroll
            for (int j = 0; j < 8; ++j) v[r][j] = xr[64 * j]; }
#pragma unroll
        for (int r = 0; r < 4; ++r) { float s = 0.f;
#pragma unroll
            for (int j = 0; j < 8; ++j) s += (v[r][j].x * v[r][j].x + v[r][j].y * v[r][j].y) + (v[r][j].z * v[r][j].z + v[r][j].w * v[r][j].w);
            ss[r] = 1.0f / sqrtf(wave_sum(s) * (1.0f / DM) + EPS); }
#pragma unroll
        for (int r = 0; r < 4; ++r) if (m + r * NGW < M) { u32x2* o = (u32x2*)(out + (size_t)(m + r * NGW) * DM) + lane;
#pragma unroll
            for (int j = 0; j < 8; ++j) { u32x2 w; w.x = pkbf(v[r][j].x * ss[r] * gg[j].x, v[r][j].y * ss[r] * gg[j].y); w.y = pkbf(v[r][j].z * ss[r] * gg[j].z, v[r][j].w * ss[r] * gg[j].w); o[64 * j] = w; } }
    }
}
__device__ __forceinline__ void rms_row_f32(const float* xrow, const float* g, float* orow, int lane) {
    const f32x4* xr = (const f32x4*)xrow + lane; const f32x4* gr = (const f32x4*)g + lane;
    f32x4 v[8]; float s = 0.f;
#pragma unroll
    for (int j = 0; j < 8; ++j) { v[j] = xr[64 * j]; s += (v[j].x * v[j].x + v[j].y * v[j].y) + (v[j].z * v[j].z + v[j].w * v[j].w); }
    const float rstd = 1.0f / sqrtf(wave_sum(s) * (1.0f / DM) + EPS);
    f32x4* o = (f32x4*)orow + lane;
#pragma unroll
    for (int j = 0; j < 8; ++j) { const f32x4 gg = gr[64 * j]; o[64 * j] = v[j] * rstd * gg; }
}

template <class SC> __device__ __forceinline__ void tr_wg_item(const float* W, int ldw, SC scol, bf16* WT, int ldt, int drow0, int k0, LAS unsigned char* ldsb, int tid, int lane, int wave) {
    LAS float* tile = (LAS float*)ldsb;
    const int run = lane >> 3, c4 = (lane & 7) * 4;
    int sc, nv; scol(run, sc, nv);
    f32x4 v[16];
#pragma unroll
    for (int i = 0; i < 16; ++i) { const int kk = wave * 16 + i;
        v[i] = (f32x4){0.f, 0.f, 0.f, 0.f};
        if (nv == 32) v[i] = *(const f32x4*)(W + (size_t)(k0 + kk) * ldw + sc + c4);
        else { const float* src = W + (size_t)(k0 + kk) * ldw + sc; if (c4 + 0 < nv) v[i].x = src[c4]; if (c4 + 1 < nv) v[i].y = src[c4 + 1]; if (c4 + 2 < nv) v[i].z = src[c4 + 2]; if (c4 + 3 < nv) v[i].w = src[c4 + 3]; } }
#pragma unroll
    for (int i = 0; i < 16; ++i) { LAS float* o = tile + (wave * 16 + i) * 257 + run * 32 + c4; o[0] = v[i].x; o[1] = v[i].y; o[2] = v[i].z; o[3] = v[i].w; }
    __syncthreads();
    const int c = lane & 15;
#pragma unroll
    for (int j = 0; j < 8; ++j) { const int n = wave * 32 + (lane >> 4) + 4 * j; const LAS float* s = tile + (8 * c) * 257 + n;
        u32x4 o; o.x = pkbf(s[0 * 257], s[1 * 257]); o.y = pkbf(s[2 * 257], s[3 * 257]); o.z = pkbf(s[4 * 257], s[5 * 257]); o.w = pkbf(s[6 * 257], s[7 * 257]);
        *(u32x4*)(WT + (size_t)(drow0 + n) * ldt + k0 + 8 * c) = o; }
    __syncthreads();
}
struct ScPlain { int n0; __device__ __forceinline__ void operator()(int run, int& sc, int& nv) const { sc = n0 + 32 * run; nv = 32; } };
struct ScGu { int T; __device__ __forceinline__ void operator()(int run, int& sc, int& nv) const { sc = run < 4 ? 128 * T + 32 * run : DFF + 128 * T + 32 * (run - 4); nv = 32; } };
struct ScWin { int n0; __device__ __forceinline__ void operator()(int run, int& sc, int& nv) const { const int r0 = n0 + 32 * run;
    if (r0 < 1792) { sc = r0; nv = 32; } else if (r0 < 2048) { const int off = r0 - 1792; sc = 1792 + off; nv = 68 - off; nv = nv < 0 ? 0 : (nv > 32 ? 32 : nv); if (nv == 0) sc = 0; } else { sc = r0 - 188; nv = 32; } } };
__device__ __forceinline__ void phase_cvt(KP p, int l, LAS unsigned char* lds, int vcu_, int G, int gw, int NGW, int wave, int lane_) {
    const int vcu = launder_s(vcu_), lane = launder_v(lane_), tid = wave * 64 + lane;
    unsigned char* ws = gws(p);
    constexpr int J_GU = (DM / 128) * (2 * DFF / 256), J_DN = (DFF / 128) * (DM / 256), J_IN = (DM / 128) * (DIN_PAD / 256), J_SQ = (DM / 128) * (DM / 256), J_BR = (1024 / 128) * (DM / 256);
    constexpr int NJ = 2 * J_GU + 2 * J_DN + J_IN + 2 * J_SQ + 3 * J_BR;
    for (int it = vcu; it < NJ; it += G) {
        int r = it;
        if (r < 2 * J_GU) { const bool sec = r >= J_GU; r -= sec ? J_GU : 0; const int nb = r % (2 * DFF / 256), kb = r / (2 * DFF / 256);
            tr_wg_item(gin(p, sec ? I_WGU2 : I_WGU1) + (size_t)l * DM * 2 * DFF, 2 * DFF, ScGu{nb}, (bf16*)(ws + (sec ? WS_WGU2 : WS_WGU)), DM, 256 * nb, 128 * kb, lds, tid, lane, wave); continue; }
        r -= 2 * J_GU;
        if (r < 2 * J_DN) { const bool sec = r >= J_DN; r -= sec ? J_DN : 0; const int nb = r % (DM / 256), kb = r / (DM / 256);
            tr_wg_item(gin(p, sec ? I_WDN2 : I_WDN1) + (size_t)l * DFF * DM, DM, ScPlain{256 * nb}, (bf16*)(ws + (sec ? WS_WDN2 : WS_WDN)), DFF, 256 * nb, 128 * kb, lds, tid, lane, wave); continue; }
        r -= 2 * J_DN;
        if (r < J_IN) { const int nb = r % (DIN_PAD / 256), kb = r / (DIN_PAD / 256);
            tr_wg_item(gin(p, I_WIN) + (size_t)l * DM * DIN, DIN, ScWin{256 * nb}, (bf16*)(ws + WS_WIN), DM, 256 * nb, 128 * kb, lds, tid, lane, wave); continue; }
        r -= J_IN;
        if (r < 2 * J_SQ) { const bool sec = r >= J_SQ; r -= sec ? J_SQ : 0; const int nb = r % (DM / 256), kb = r / (DM / 256);
            tr_wg_item(gin(p, sec ? I_WOUT : I_WMKV) + (size_t)l * DM * DM, DM, ScPlain{256 * nb}, (bf16*)(ws + (sec ? WS_WOUT : WS_WMKV)), DM, 256 * nb, 128 * kb, lds, tid, lane, wave); continue; }
        r -= 2 * J_SQ;
        { const int j = r / J_BR, rr = r % J_BR, nb = rr % (DM / 256), kb = rr / (DM / 256);
          tr_wg_item(gin(p, I_WBR) + ((size_t)l * 3 + j) * 1024 * DM, DM, ScPlain{256 * nb}, (bf16*)(ws + WS_WBR) + (size_t)j * DM * 1024, 1024, 256 * nb, 128 * kb, lds, tid, lane, wave); }
    }
    { __syncthreads(); LAS float* scr = (LAS float*)(lds + wave * 8704);
      for (int it = gw; it < 16 * 8; it += NGW) { const int mtx = it >> 3, n = mtx & 7; const bool isI = mtx >= 8;
          tr_plain(gin(p, isI ? I_WI : I_WA) + ((size_t)l * 8 + n) * 128 * 128, 128, 128, (bf16*)(ws + (isI ? WS_WIT : WS_WAT)) + (size_t)n * 128 * 128, it & 7, scr, lane); } }
    for (int m = gw; m < BATCH * NMEM; m += NGW) rms_row_bf16(gin(p, I_MEM) + (size_t)m * DM, gin(p, I_MEMNORM) + (size_t)l * DM, (bf16*)(ws + WS_MEMN) + (size_t)m * DM, lane);
}

__device__ __forceinline__ float row_bcast15(float v) { return __builtin_bit_cast(float, __builtin_amdgcn_update_dpp(0, __builtin_bit_cast(int, v), 0x15F, 0xF, 0xF, false)); }
__device__ __forceinline__ float xmax32(float v) { auto rr = __builtin_amdgcn_permlane32_swap(__float_as_uint(v), __float_as_uint(v), false, false); return fmaxf(__uint_as_float(rr[0]), __uint_as_float(rr[1])); }
__device__ __forceinline__ float xadd32(float v) { auto rr = __builtin_amdgcn_permlane32_swap(__float_as_uint(v), __float_as_uint(v), false, false); return __uint_as_float(rr[0]) + __uint_as_float(rr[1]); }
__device__ __forceinline__ unsigned xor32_or(unsigned v) { auto rr = __builtin_amdgcn_permlane32_swap(v, v, false, false); return rr[0] | rr[1]; }
__device__ __forceinline__ unsigned xor16_or(unsigned v) { auto rr = __builtin_amdgcn_permlane16_swap(v, v, false, false); return rr[0] | rr[1]; }
template <int N> __device__ __forceinline__ float dpp_shr(float v, float ident) {
    return __builtin_bit_cast(float, __builtin_amdgcn_update_dpp(__builtin_bit_cast(int, ident), __builtin_bit_cast(int, v), 0x110 + N, 0xF, 0xF, false));
}
__device__ __forceinline__ float fsig(float x) { return __builtin_amdgcn_rcpf(1.0f + __builtin_amdgcn_exp2f(-LOG2E * x)); }
__device__ __forceinline__ float gelu_tanh(float x) {
    const float z = 0.7978845608028654f * (x + 0.044715f * x * x * x);
    const float e = __builtin_amdgcn_exp2f(2.0f * LOG2E * z);
    const float t = 1.0f - 2.0f * __builtin_amdgcn_rcpf(e + 1.0f);
    return 0.5f * x * (1.0f + t);
}

__device__ __forceinline__ void kidx_ln_quarter(KP p, int l, int gt) {
    const int row = gt >> 2, q = gt & 3;
    const float* s = (const float*)(gws(p) + WS_SIDE) + (size_t)row * 72 + 16 * q;
    const float* g = gin(p, I_LNG) + l * 64 + 16 * q; const float* be = gin(p, I_LNB) + l * 64 + 16 * q;
    f32x4 v[4]; float mu = 0.f;
#pragma unroll
    for (int i = 0; i < 4; ++i) { v[i] = *(const f32x4*)(s + 4 * i); mu += (v[i].x + v[i].y) + (v[i].z + v[i].w); }
    mu += __shfl_xor(mu, 1); mu += __shfl_xor(mu, 2); mu *= (1.0f / 64.0f);
    float var = 0.f;
#pragma unroll
    for (int i = 0; i < 4; ++i) { v[i] = v[i] - mu; var += (v[i].x * v[i].x + v[i].y * v[i].y) + (v[i].z * v[i].z + v[i].w * v[i].w); }
    var += __shfl_xor(var, 1); var += __shfl_xor(var, 2);
    const float rstd = 1.0f / sqrtf(var * (1.0f / 64.0f) + EPS);
    bf16* o = (bf16*)(gws(p) + WS_KIDX) + (size_t)row * 64 + 16 * q;
    unsigned w[8];
#pragma unroll
    for (int i = 0; i < 4; ++i) { const f32x4 gg = *(const f32x4*)(g + 4 * i), bb = *(const f32x4*)(be + 4 * i);
        w[2 * i] = pk2(v[i].x * rstd * gg.x + bb.x, v[i].y * rstd * gg.y + bb.y); w[2 * i + 1] = pk2(v[i].z * rstd * gg.z + bb.z, v[i].w * rstd * gg.w + bb.w); }
    *(u32x4*)o = (u32x4){w[0], w[1], w[2], w[3]}; *(u32x4*)(o + 8) = (u32x4){w[4], w[5], w[6], w[7]};
    if (q == 0) { const f32x4 wv = *(const f32x4*)(s + 64); *(f32x4*)((float*)(gws(p) + WS_WIDX) + (size_t)row * 4) = wv * 0.0625f; }
}

__device__ __forceinline__ void vt_item(KP p, int item, LAS unsigned char* scrb, int lane) {
    const int db = item & 1, tb = (item >> 1) & 127, kvh = (item >> 8) & 1, b = item >> 9;
    const bf16* P = (const bf16*)(gws(p) + WS_R1);
    LAS unsigned short* scr = (LAS unsigned short*)scrb;
#pragma unroll
    for (int i = 0; i < 8; ++i) {
        const int t = 8 * i + (lane >> 3), ch = lane & 7;
        const u32x4 v = *(const u32x4*)(P + (size_t)(b * SEQ + tb * 64 + t) * PLD + C_VA + kvh * 128 + db * 64 + 8 * ch);
        const unsigned w[4] = {v.x, v.y, v.z, v.w};
#pragma unroll
        for (int j = 0; j < 4; ++j) { scr[(8 * ch + 2 * j) * 66 + t] = (unsigned short)(w[j] & 0xffff); scr[(8 * ch + 2 * j + 1) * 66 + t] = (unsigned short)(w[j] >> 16); }
    }
    LDS_WAIT(); asm volatile("" ::: "memory");
    bf16* VT = (bf16*)(gws(p) + WS_VT);
#pragma unroll
    for (int i = 0; i < 8; ++i) {
        const int d = 8 * i + (lane >> 3), ch = lane & 7;
        const LAS unsigned* s = (const LAS unsigned*)(scr + d * 66 + 8 * ch);
        u32x4 o; o.x = s[0]; o.y = s[1]; o.z = s[2]; o.w = s[3];
        *(u32x4*)(VT + (((size_t)((b * 2 + kvh) * 128 + tb)) * 128 + db * 64 + d) * 64 + 8 * ch) = o;
    }
    LDS_WAIT(); asm volatile("" ::: "memory");
}

constexpr int LR_WA = 0, LR_WI = 34816, LR_PAR = 69632, LR_COMP = LR_PAR + 9 * 512;
__device__ __forceinline__ void lru_job(KP p, int l, int jb, LAS unsigned char* lds, int tid, int lane, int wave) {
    const int n = jb & 7, jj = jb >> 3, b = jj >> 4, tile0 = 4 * (jj & 15), tok = lane & 15, h = lane >> 4;
    const bf16* P = (const bf16*)(gws(p) + WS_R1);
    float* aggA = (float*)(gws(p) + WS_AGG); float* aggH = aggA + (size_t)BATCH * 64 * 1024;
    unsigned* LRS = (unsigned*)(gws(p) + WS_SCR);
    LAS float* par = (LAS float*)(lds + LR_PAR);
    LAS float* compA = (LAS float*)(lds + LR_COMP); LAS float* compH = compA + 1024;
    __syncthreads();
    {
        const bf16* waT = (const bf16*)(gws(p) + WS_WAT) + (size_t)n * 128 * 128; const bf16* wiT = (const bf16*)(gws(p) + WS_WIT) + (size_t)n * 128 * 128;
#pragma unroll
        for (int i = 0; i < 4; ++i) { const int ci = tid + 512 * i, r = ci >> 4, ch = ci & 15;
            *(LAS u32x4*)(lds + LR_WA + r * 272 + ch * 16) = *(const u32x4*)(waT + r * 128 + ch * 8);
            *(LAS u32x4*)(lds + LR_WI + r * 272 + ch * 16) = *(const u32x4*)(wiT + r * 128 + ch * 8); }
        if (tid < 128) { const int c = n * 128 + tid;
            par[tid] = -8.0f * LOG2E * log1pf(expf(-gin(p, I_LAM)[(size_t)l * 1024 + c]));
            par[128 + tid] = gin(p, I_BA)[(size_t)l * 1024 + c]; par[256 + tid] = gin(p, I_BI)[(size_t)l * 1024 + c]; par[384 + tid] = gin(p, I_CONVB)[(size_t)l * 1024 + c];
#pragma unroll
            for (int j = 0; j < 4; ++j) par[512 + 128 * j + tid] = gin(p, I_CONVW)[((size_t)l * 4 + j) * 1024 + c]; }
        __syncthreads();
    }
#pragma unroll 1
    for (int tt = 0; tt < 4; ++tt) {
        const int tile = tile0 + tt, t = tile * 128 + wave * 16 + tok; const size_t row = (size_t)b * SEQ + t;
        const int hofs = launder_v(4 * h);
        float xc[4][2][4]; bf16x8 xb[4];
#pragma unroll
        for (int ks = 0; ks < 4; ++ks) {
#pragma unroll
            for (int hf = 0; hf < 2; ++hf) {
                const int cl = 32 * ks + 16 * hf + hofs;
                f32x4 a = *(const LAS f32x4*)(par + 384 + cl);
#pragma unroll
                for (int j = 0; j < 4; ++j) {
                    if (t - 3 + j >= 0) {
                        const u32x2 xv = *(const u32x2*)(P + (row - 3 + j) * PLD + C_XL + n * 128 + cl);
                        const f32x4 cw = *(const LAS f32x4*)(par + 512 + 128 * j + cl);
                        a.x += cw.x * bflo(xv.x); a.y += cw.y * bfhi(xv.x); a.z += cw.z * bflo(xv.y); a.w += cw.w * bfhi(xv.y);
                    }
                }
                xc[ks][hf][0] = a.x; xc[ks][hf][1] = a.y; xc[ks][hf][2] = a.z; xc[ks][hf][3] = a.w;
            }
            u32x4 w; w.x = pk2(xc[ks][0][0], xc[ks][0][1]); w.y = pk2(xc[ks][0][2], xc[ks][0][3]); w.z = pk2(xc[ks][1][0], xc[ks][1][1]); w.w = pk2(xc[ks][1][2], xc[ks][1][3]);
            xb[ks] = __builtin_bit_cast(bf16x8, w);
        }
        float acum[8][4], hloc[8][4];
#pragma unroll
        for (int dt = 0; dt < 8; ++dt) {
            f32x4 acca = {0.f, 0.f, 0.f, 0.f}, acci = {0.f, 0.f, 0.f, 0.f};
            const LAS unsigned char* wa = lds + LR_WA + (16 * dt + tok) * 272 + 2 * hofs; const LAS unsigned char* wi = lds + LR_WI + (16 * dt + tok) * 272 + 2 * hofs;
#pragma unroll
            for (int ks = 0; ks < 4; ++ks) {
                const u32x2 a0 = *(const LAS u32x2*)(wa + 64 * ks), a1 = *(const LAS u32x2*)(wa + 64 * ks + 32);
                const u32x2 i0 = *(const LAS u32x2*)(wi + 64 * ks), i1 = *(const LAS u32x2*)(wi + 64 * ks + 32);
                const u32x4 fa = {a0.x, a0.y, a1.x, a1.y}, fi = {i0.x, i0.y, i1.x, i1.y};
                acca = mfma16(__builtin_bit_cast(bf16x8, fa), xb[ks], acca);
                acci = mfma16(__builtin_bit_cast(bf16x8, fi), xb[ks], acci);
            }
            const int cl0 = 16 * dt + hofs;
            const f32x4 vsp = *(const LAS f32x4*)(par + cl0), vba = *(const LAS f32x4*)(par + 128 + cl0), vbi = *(const LAS f32x4*)(par + 256 + cl0);
            f32x4 wA, wH;
#pragma unroll
            for (int r = 0; r < 4; ++r) {
                const float rg = fsig(acca[r] + vba[r]), ig = fsig(acci[r] + vbi[r]);
                const float l2a = rg * vsp[r];
                float a = __builtin_amdgcn_exp2f(l2a);
                const float x2 = 2.0f * 0.6931471805599453f * l2a;
                const float om = (x2 > -0.06f) ? -x2 * (1.0f + x2 * (0.5f + x2 * (0.16666667f + x2 * 0.041666668f))) : 1.0f - a * a;
                float u = sqrtf(fmaxf(om, 0.f)) * (ig * xc[dt >> 1][dt & 1][r]);
                { float ap = dpp_shr<1>(a, 1.f), up = dpp_shr<1>(u, 0.f); u = a * up + u; a = a * ap; }
                { float ap = dpp_shr<2>(a, 1.f), up = dpp_shr<2>(u, 0.f); u = a * up + u; a = a * ap; }
                { float ap = dpp_shr<4>(a, 1.f), up = dpp_shr<4>(u, 0.f); u = a * up + u; a = a * ap; }
                { float ap = dpp_shr<8>(a, 1.f), up = dpp_shr<8>(u, 0.f); u = a * up + u; a = a * ap; }
                acum[dt][r] = a; hloc[dt][r] = u;
                wA[r] = row_bcast15(a); wH[r] = row_bcast15(u);
            }
            if (tok == 0) { *(LAS f32x4*)(compA + wave * 128 + cl0) = wA; *(LAS f32x4*)(compH + wave * 128 + cl0) = wH; }
        }
        __syncthreads();
#pragma unroll
        for (int dt = 0; dt < 8; ++dt) {
            const int cl0 = 16 * dt + hofs;
            f32x4 cin = {0.f, 0.f, 0.f, 0.f}, pa = {1.f, 1.f, 1.f, 1.f};
            for (int w2 = 0; w2 < wave; ++w2) { const f32x4 ca = *(const LAS f32x4*)(compA + w2 * 128 + cl0), chh = *(const LAS f32x4*)(compH + w2 * 128 + cl0); cin = ca * cin + chh; pa = pa * ca; }
            f32x4 A, H;
#pragma unroll
            for (int r = 0; r < 4; ++r) { A[r] = acum[dt][r] * pa[r]; H[r] = acum[dt][r] * cin[r] + hloc[dt][r]; }
            *(u32x4*)(LRS + row * 1024 + n * 128 + cl0) = (u32x4){pkbf(A[0], H[0]), pkbf(A[1], H[1]), pkbf(A[2], H[2]), pkbf(A[3], H[3])};
            if (wave == 7 && tok == 15) { const size_t o = ((size_t)b * 64 + tile) * 1024 + n * 128 + cl0; *(f32x4*)(aggA + o) = A; *(f32x4*)(aggH + o) = H; }
        }
        __syncthreads();
    }
}
__device__ __forceinline__ void lru_apply_job(KP p, int jb, LAS unsigned char* lds, int tid, int lane_, int wave, bf16* OB, int old) {
    const int lane = launder_v(lane_);
    const int half = jb & 1, tile = (jb >> 1) & 63, b = jb >> 7;
    const float* aggA = (const float*)(gws(p) + WS_AGG); const float* aggH = aggA + (size_t)BATCH * 64 * 1024;
    const unsigned* LRS = (const unsigned*)(gws(p) + WS_SCR);
    const bf16* P = (const bf16*)(gws(p) + WS_R1);
    LAS float* carry = (LAS float*)lds;
    __syncthreads();
    {
        const float* pa = aggA + (size_t)b * 64 * 1024 + half * 512 + tid; const float* ph = aggH + (size_t)b * 64 * 1024 + half * 512 + tid;
        float C = 0.f;
        for (int i0 = 0; i0 < tile; i0 += 16) {
            float a[16], hh[16];
#pragma unroll
            for (int j = 0; j < 16; ++j) { const bool ok = i0 + j < tile; const int ic = ok ? i0 + j : 0; a[j] = pa[(size_t)ic * 1024]; hh[j] = ph[(size_t)ic * 1024]; if (!ok) { a[j] = 1.f; hh[j] = 0.f; } }
#pragma unroll
            for (int j = 0; j < 16; ++j) C = a[j] * C + hh[j];
        }
        carry[tid] = C;
    }
    __syncthreads();
    const f32x4 c0 = *(const LAS f32x4*)(carry + 8 * lane), c1 = *(const LAS f32x4*)(carry + 8 * lane + 4);
    const size_t row0 = (size_t)b * SEQ + tile * 128 + wave * 16; const int c = half * 512 + 8 * lane;
#pragma unroll 1
    for (int r0 = 0; r0 < 16; r0 += 4) {
        u32x4 s0[4], s1[4], gv[4];
#pragma unroll
        for (int i = 0; i < 4; ++i) { const size_t row = row0 + r0 + i; const u32x4* sp = (const u32x4*)(LRS + row * 1024 + c); s0[i] = sp[0]; s1[i] = sp[1]; gv[i] = *(const u32x4*)(P + row * PLD + C_GL + c); }
#pragma unroll
        for (int i = 0; i < 4; ++i) { const size_t row = row0 + r0 + i;
            float y[8];
#pragma unroll
            for (int k = 0; k < 4; ++k) { y[k] = bflo(s0[i][k]) * c0[k] + bfhi(s0[i][k]); y[4 + k] = bflo(s1[i][k]) * c1[k] + bfhi(s1[i][k]); }
            u32x4 w;
#pragma unroll
            for (int k = 0; k < 4; ++k) w[k] = pkbf(y[2 * k] * gelu_tanh(bflo(gv[i][k])), y[2 * k + 1] * gelu_tanh(bfhi(gv[i][k])));
            *(u32x4*)(OB + row * old + c) = w; }
    }
}

__device__ __forceinline__ void memattn_job(KP p, int jb, LAS unsigned char* lds, int tid, int lane_, int wave, bf16* OB, int old) {
    const int lane = launder_v(lane_);
    const int hd = jb & 3, b = (jb >> 2) & 1, j = jb >> 3, tok = lane & 15, h = lane >> 4;
    const bf16* P = (const bf16*)(gws(p) + WS_R1);
    const bf16* MK = (const bf16*)(gws(p) + WS_MK); const bf16* VTM = (const bf16*)(gws(p) + WS_VTM);
    __syncthreads();
#pragma unroll
    for (int i = 0; i < 16; ++i) { const int ci = tid + 512 * i, m = ci >> 5, c = ci & 31;
        *(LAS u32x4*)(lds + m * 512 + ((c ^ (m & 15)) << 4)) = *(const u32x4*)(MK + (size_t)(b * 256 + m) * 1024 + hd * 256 + c * 8); }
    const size_t row = (size_t)b * SEQ + j * 128 + wave * 16 + tok;
    bf16x8 qf[8];
#pragma unroll
    for (int ks = 0; ks < 8; ++ks) qf[ks] = *(const bf16x8*)(P + row * PLD + C_QM + hd * 256 + 32 * ks + 8 * h);
    unsigned ka[8];
#pragma unroll
    for (int ks = 0; ks < 8; ++ks) ka[ks] = (unsigned)launder_v(tok * 512 + (((4 * ks + h) ^ tok) << 4));
    __syncthreads();
    bf16x8 pf[8]; float inv;
    {
        f32x4 S[16];
#pragma unroll
        for (int mt = 0; mt < 16; ++mt) {
            f32x4 acc = {0.f, 0.f, 0.f, 0.f};
#pragma unroll
            for (int ks = 0; ks < 8; ++ks) acc = mfma16(*(const LAS bf16x8*)(lds + ka[ks] + mt * 8192), qf[ks], acc);
            S[mt] = acc;
        }
        float mx = -3.0e38f;
#pragma unroll
        for (int mt = 0; mt < 16; ++mt)
#pragma unroll
            for (int r = 0; r < 4; ++r) mx = fmaxf(mx, S[mt][r]);
        mx = fmaxf(mx, __shfl_xor(mx, 16)); mx = fmaxf(mx, __shfl_xor(mx, 32));
        const float sc = 0.0625f * LOG2E;
        float sum = 0.f;
#pragma unroll
        for (int mt = 0; mt < 16; ++mt)
#pragma unroll
            for (int r = 0; r < 4; ++r) { const float e = __builtin_amdgcn_exp2f((S[mt][r] - mx) * sc); S[mt][r] = e; sum += e; }
        sum += __shfl_xor(sum, 16); sum += __shfl_xor(sum, 32);
        inv = 1.0f / sum;
#pragma unroll
        for (int T = 0; T < 8; ++T) { u32x4 w; w.x = pk2(S[2 * T][0], S[2 * T][1]); w.y = pk2(S[2 * T][2], S[2 * T][3]); w.z = pk2(S[2 * T + 1][0], S[2 * T + 1][1]); w.w = pk2(S[2 * T + 1][2], S[2 * T + 1][3]);
            pf[T] = __builtin_bit_cast(bf16x8, w); }
    }
    __syncthreads();
#pragma unroll
    for (int i = 0; i < 16; ++i) { const int ci = tid + 512 * i, d = ci >> 5, c = ci & 31;
        *(LAS u32x4*)(lds + d * 512 + ((c ^ (d & 15)) << 4)) = *(const u32x4*)(VTM + (size_t)(hd * 256 + d) * 512 + b * 256 + c * 8); }
    unsigned va[8][2];
#pragma unroll
    for (int T = 0; T < 8; ++T) { va[T][0] = (unsigned)launder_v(tok * 512 + 8 * (h & 1) + (((4 * T + (h >> 1)) ^ tok) << 4)); va[T][1] = (unsigned)launder_v(tok * 512 + 8 * (h & 1) + (((4 * T + 2 + (h >> 1)) ^ tok) << 4)); }
    __syncthreads();
#pragma unroll
    for (int dt = 0; dt < 16; ++dt) {
        f32x4 acc = {0.f, 0.f, 0.f, 0.f};
#pragma unroll
        for (int T = 0; T < 8; ++T) { const u32x2 v0 = *(const LAS u32x2*)(lds + va[T][0] + dt * 8192), v1 = *(const LAS u32x2*)(lds + va[T][1] + dt * 8192); const u32x4 f = {v0.x, v0.y, v1.x, v1.y};
            acc = mfma16(__builtin_bit_cast(bf16x8, f), pf[T], acc); }
        u32x2 w; w.x = pk2(acc[0] * inv, acc[1] * inv); w.y = pk2(acc[2] * inv, acc[3] * inv);
        *(u32x2*)(OB + row * old + hd * 256 + 16 * dt + 4 * h) = w;
    }
}

struct KFr { bf16x8 a0, a1, b0, b1; };
__device__ __forceinline__ KFr idx_load(const bf16* kidx, size_t krow, int lane) {
    const bf16* kp = kidx + (krow + (lane & 15)) * 64 + (lane >> 4) * 8;
    KFr f; f.a0 = *(const bf16x8*)kp; f.a1 = *(const bf16x8*)(kp + 32); f.b0 = *(const bf16x8*)(kp + 16 * 64); f.b1 = *(const bf16x8*)(kp + 16 * 64 + 32); return f;
}
__device__ __forceinline__ f32x4 idx_score4(const bf16x8 k0, const bf16x8 k1, const bf16x8 (&qf)[4][2], const f32x4 w) {
    f32x4 s = {0.f, 0.f, 0.f, 0.f};
#pragma unroll
    for (int hd = 0; hd < 4; ++hd) {
        f32x4 d = {0.f, 0.f, 0.f, 0.f};
        d = mfma16(k0, qf[hd][0], d); d = mfma16(k1, qf[hd][1], d);
#pragma unroll
        for (int r = 0; r < 4; ++r) { const int di = __float_as_int(d[r]); s[r] = __builtin_fmaf(w[hd], __int_as_float(di > 0 ? di : 0), s[r]); }
    }
    return s;
}
__device__ __forceinline__ unsigned orderable(float s) { const unsigned u = __float_as_uint(s); return u ^ ((u >> 31) ? 0xFFFFFFFFu : 0x80000000u); }

template <int NE> __device__ __forceinline__ unsigned long long rank_select(const unsigned long long (&v)[NE], unsigned long long top12, int need) {
    unsigned long long prefix = top12 << 33;
    for (int bit = 32; bit >= 0; --bit) {
        const unsigned long long cand = prefix | (1ull << bit);
        int cnt = 0;
#pragma unroll
        for (int e = 0; e < NE; ++e) cnt += __popcll(__ballot(v[e] >= cand));
        if (cnt >= need) prefix = cand;
    }
    return prefix;
}

template <int sprobe> __device__ __forceinline__ void select_item(KP p, int b, int u, LAS unsigned char* lds, int tid, int lane, int wave) {
    LAS unsigned* hist = (LAS unsigned*)lds;
    LAS unsigned long long* lists = (LAS unsigned long long*)lds;
    LAS unsigned* mstage = (LAS unsigned*)(lds + 131072);
    LAS int* qinfo = (LAS int*)(lds + 147456);
    const bf16* P = (const bf16*)(gws(p) + WS_R1); const bf16* kidx = (const bf16*)(gws(p) + WS_KIDX);
    const int q0 = u * 16, nkeys = q0 + 16, ngrp = (nkeys + 31) >> 5, nw2 = (nkeys + 63) >> 6;
    for (int i = tid; i < 32768; i += 512) hist[i] = 0u;
    for (int i = tid; i < 4096; i += 512) mstage[i] = 0u;
    if (tid < 48) qinfo[tid] = 0;
    const int ql = lane & 15, h4 = lane >> 4, tq = q0 + ql;
    const size_t qrow = (size_t)b * SEQ + tq;
    bf16x8 qf[4][2];
#pragma unroll
    for (int hd = 0; hd < 4; ++hd)
#pragma unroll
        for (int ks = 0; ks < 2; ++ks) qf[hd][ks] = *(const bf16x8*)(P + qrow * PLD + C_QI + hd * 64 + ks * 32 + h4 * 8);
    const f32x4 w = *(const f32x4*)((const float*)(gws(p) + WS_WIDX) + qrow * 4);
    __syncthreads();
    {
        const size_t kr0 = (size_t)b * SEQ;
#define SEL_BODY1(KF, gg) do { if ((gg) < ngrp) { _Pragma("unroll") for (int hf = 0; hf < 2; ++hf) { const int kb = (gg) * 32 + hf * 16; \
            if (kb < nkeys) { const f32x4 sc = hf ? idx_score4(KF.b0, KF.b1, qf, w) : idx_score4(KF.a0, KF.a1, qf, w); \
                _Pragma("unroll") for (int r = 0; r < 4; ++r) { const int key = kb + 4 * h4 + r; \
                    if (key <= tq) { const unsigned ob = orderable(sc[r]);   \
                        (void)__hip_atomic_fetch_add((LAS unsigned*)((LAS unsigned char*)hist + hqb + ((ob >> 19) & 0x3FFCu)), 1u + ((ob >> 20) & 1u) * 0xFFFFu, __ATOMIC_RELAXED, __HIP_MEMORY_SCOPE_WORKGROUP); } } } } } } while (0)
#define SEL_LOAD(gg) idx_load(kidx, kr0 + 32 * ((gg) < ngrp ? (gg) : wave), lane)
        const unsigned hqb = (unsigned)ql * 8192u;
        KFr kA = SEL_LOAD(wave), kB = SEL_LOAD(wave + 8), kC;
        for (int g = wave; g < ngrp; g += 24) {
            kC = SEL_LOAD(g + 16); SEL_BODY1(kA, g);
            kA = SEL_LOAD(g + 24); SEL_BODY1(kB, g + 8);
            kB = SEL_LOAD(g + 32); SEL_BODY1(kC, g + 16);
        }
#undef SEL_BODY1
    }
    __syncthreads();
    for (int qq = 0; qq < 2; ++qq) {
        const int q = 2 * wave + qq, total = q0 + q + 1;
        if (total <= 256) { if (lane == 0) { qinfo[q] = -1; qinfo[16 + q] = 0; } continue; }
        LAS unsigned* hq = hist + q * 2048;
        int s = 0;
#pragma unroll 8
        for (int i = 0; i < 32; ++i) { const unsigned wv = hq[lane * 32 + ((i + lane) & 31)]; s += (int)(wv & 0xffffu) + (int)(wv >> 16); }
        int suf = s;
#pragma unroll
        for (int off = 1; off < 64; off <<= 1) { const int t = __shfl_down(suf, off); if (lane + off < 64) suf += t; }
        const unsigned long long ball = __ballot(suf >= 256);
        const int L = 63 - __clzll(ball);
        const int above = (L < 63) ? __shfl(suf, L + 1) : 0;
        const unsigned wv = hq[L * 32 + (lane >> 1)];
        const int c = (lane & 1) ? (int)(wv >> 16) : (int)(wv & 0xffffu);
        int suf2 = c;
#pragma unroll
        for (int off = 1; off < 64; off <<= 1) { const int t = __shfl_down(suf2, off); if (lane + off < 64) suf2 += t; }
        suf2 += above;
        const unsigned long long ball2 = __ballot(suf2 >= 256);
        const int is = 63 - __clzll(ball2);
        const int nab = __shfl(suf2, is) - __shfl(c, is);
        if (lane == 0) { qinfo[q] = 64 * L + is; qinfo[16 + q] = nab; }
    }
    __syncthreads();
    const int b1q = qinfo[ql];
    {
        const size_t kr0 = (size_t)b * SEQ;
        struct Pend { int pos; unsigned flags; int gg; unsigned ub[8]; };
#define SEL_FLUSH(PD) do { if ((PD).flags) { _Pragma("unroll") for (int k = 0; k < 8; ++k) if (((PD).flags >> k) & 1u) { \
            const int idx = (PD).pos + __popc((PD).flags & ((1u << k) - 1u)), key = (PD).gg * 32 + (k >> 2) * 16 + 4 * h4 + (k & 3); \
            if (idx < 1024) lists[ql * 1024 + idx] = ((unsigned long long)(PD).ub[k] << 13) | (unsigned long long)(8191 - key); } } } while (0)
#define SEL_BODY2(KF, gg_, PN, PO) do { (PN).flags = 0u; (PN).gg = (gg_); (PN).pos = 0; if ((gg_) < ngrp) { unsigned bits = 0u; _Pragma("unroll") for (int hf = 0; hf < 2; ++hf) { const int kb = (gg_) * 32 + hf * 16; \
            if (kb < nkeys) { const f32x4 sc = hf ? idx_score4(KF.b0, KF.b1, qf, w) : idx_score4(KF.a0, KF.a1, qf, w); \
                _Pragma("unroll") for (int r = 0; r < 4; ++r) { const int key = kb + 4 * h4 + r; const unsigned ub = orderable(sc[r]); (PN).ub[hf * 4 + r] = ub; \
                    const bool ok = key <= tq, gt = ub > hiT, ge = ub >= loT;        \
                    bits |= (ok && gt) ? (1u << (hf * 16 + 4 * h4 + r)) : 0u; (PN).flags |= (ok && ge && !gt) ? (1u << (hf * 4 + r)) : 0u; } } } \
            if ((PN).flags) (PN).pos = __hip_atomic_fetch_add(&qinfo[32 + ql], __popc((PN).flags), __ATOMIC_RELAXED, __HIP_MEMORY_SCOPE_WORKGROUP); \
            bits = xor16_or(bits); bits = xor32_or(bits); if (h4 == 0) mstage[ql * 256 + (gg_)] = bits; } \
            SEL_FLUSH(PO); } while (0)
        const unsigned loT = b1q < 0 ? 0u : ((unsigned)b1q << 20), hiT = b1q < 0 ? 0u : (loT | 0xFFFFFu);
        Pend pA, pB, pC; pC.flags = 0u; pC.pos = 0; pC.gg = 0;
#pragma unroll
        for (int k = 0; k < 8; ++k) pC.ub[k] = 0u;
        KFr kA = SEL_LOAD(wave), kB = SEL_LOAD(wave + 8), kC;
        for (int g = wave; g < ngrp; g += 24) {
            kC = SEL_LOAD(g + 16); SEL_BODY2(kA, g, pA, pC);
            kA = SEL_LOAD(g + 24); SEL_BODY2(kB, g + 8, pB, pA);
            kB = SEL_LOAD(g + 32); SEL_BODY2(kC, g + 16, pC, pB);
        }
        SEL_FLUSH(pC);
#undef SEL_FLUSH
#undef SEL_BODY2
#undef SEL_LOAD
    }
    __syncthreads();
    for (int qq = 0; qq < 2; ++qq) {
        const int q = 2 * wave + qq, b1 = qinfo[q];
        if (b1 < 0) continue;
        int n = qinfo[32 + q]; n = n > 1024 ? 1024 : n;
        const int need = 256 - qinfo[16 + q];
        const LAS unsigned long long* Lq = lists + q * 1024;
        unsigned long long thr;
        if (n <= 64) { unsigned long long v[1]; v[0] = lane < n ? Lq[lane] : 0ull; thr = rank_select<1>(v, (unsigned long long)b1, need); }
        else if (n <= 256) { unsigned long long v[4];
#pragma unroll
            for (int e = 0; e < 4; ++e) v[e] = (lane + 64 * e) < n ? Lq[lane + 64 * e] : 0ull;
            thr = rank_select<4>(v, (unsigned long long)b1, need); }
        else { unsigned long long v[16];
#pragma unroll
            for (int e = 0; e < 16; ++e) v[e] = (lane + 64 * e) < n ? Lq[lane + 64 * e] : 0ull;
            thr = rank_select<16>(v, (unsigned long long)b1, need); }
        for (int e = lane; e < n; e += 64) { const unsigned long long v = Lq[e]; if (v >= thr) { const int key = 8191 - (int)(v & 8191ull); (void)__hip_atomic_fetch_or(&mstage[q * 256 + (key >> 5)], 1u << (key & 31), __ATOMIC_RELAXED, __HIP_MEMORY_SCOPE_WORKGROUP); } }
    }
    __syncthreads();
    unsigned* mask = (unsigned*)(gws(p) + WS_MASK);
    for (int i = tid; i < 16 * nw2; i += 512) { const int q = i / nw2, wp = i - q * nw2; *(u32x2*)(mask + ((size_t)b * SEQ + q0 + q) * 256 + 2 * wp) = *(const LAS u32x2*)(mstage + q * 256 + 2 * wp); }
    __syncthreads();
}

__device__ __forceinline__ float bfi_sel(int sel, float x) { float r; asm("v_bfi_b32 %0, %1, %2, %3" : "=v"(r) : "v"(sel), "v"(x), "v"(0xff800000u)); return r; }
constexpr int AT_K = 0, AT_VT = 16384, AT_BUF = 32768, AT_BIAS = 3 * AT_BUF;
__device__ __forceinline__ void attn_bias_table(KP p, LAS unsigned char* lds, int tid) {
    LAS float* bt = (LAS float*)(lds + AT_BIAS);
    for (int i = tid; i < 1024; i += 512) {
        const int hd = i >> 7, dd = i & 127;
        int bk = dd;
        if (dd >= 16) { bk = 16 + (dd >= 19) + (dd >= 21) + (dd >= 24) + (dd >= 27) + (dd >= 31) + (dd >= 35) + (dd >= 40) + (dd >= 46) + (dd >= 52) + (dd >= 59) + (dd >= 67) + (dd >= 77) + (dd >= 87) + (dd >= 99) + (dd >= 113); }
        bt[i] = gin(p, I_RELB)[bk * 8 + hd] * LOG2E;
    }
}
template <int probe> __device__ __forceinline__ void attn_item(KP p, int b, int kvh, int qt, LAS unsigned char* lds, int lane_, int wave, bf16* OB, int old) {
    const int lane = launder_v(lane_);
    const bf16* P = (const bf16*)(gws(p) + WS_R1); const bf16* VT = (const bf16*)(gws(p) + WS_VT); const unsigned* mask = (const unsigned*)(gws(p) + WS_MASK);
    const int head = kvh * 4 + (wave & 3), q0 = qt * 64 + 32 * (wave >> 2), nkt = (probe == 1) ? 1 : qt + 1, ql = lane & 31, hi = lane >> 5, tq = q0 + ql;
    const size_t row = (size_t)b * SEQ + tq;
    bf16x8 qf[8];
#pragma unroll
    for (int ks = 0; ks < 8; ++ks) qf[ks] = *(const bf16x8*)(P + row * PLD + C_QA + head * 128 + 16 * ks + 8 * hi);
    f32x16 O[4];
#pragma unroll
    for (int dt = 0; dt < 4; ++dt)
#pragma unroll
        for (int r = 0; r < 16; ++r) O[dt][r] = 0.f;
    float mrun = -1.0e4f, lrun = 0.f;
    const float c1 = 0.08838834764831845f * LOG2E;
    const LAS float* btab = (const LAS float*)(lds + AT_BIAS) + head * 128;
    const float bfar = btab[127];
    const bf16* kbase = P + (size_t)b * SEQ * PLD + C_KA + kvh * 128; const bf16* vbase = VT + (size_t)(b * 2 + kvh) * 128 * SEQ; const unsigned* mrow = mask + row * 256;
    unsigned koff[2], voff[2];
#pragma unroll
    for (int i = 0; i < 2; ++i) {
        const int pos = 1024 * (wave + 8 * i) + 16 * lane;
        const int key = pos >> 8, kc = ((pos >> 4) & 15) ^ (key & 15);
        koff[i] = (unsigned)(key * PLD + kc * 8);
        const int d = pos >> 7, vc = ((pos >> 4) & 7) ^ ((d >> 1) & 7);
        voff[i] = (unsigned)(d * 64 + vc * 8);
    }
#define AT_DMA(kt, st) do { _Pragma("unroll") for (int i = 0; i < 2; ++i) { \
        __builtin_amdgcn_global_load_lds((const unsigned*)(kbase + (size_t)(kt) * 64 * PLD + koff[i]), (LAS unsigned*)(lds + (st) * AT_BUF + AT_K + 1024 * (wave + 8 * i)), 16, 0, 0); \
        __builtin_amdgcn_global_load_lds((const unsigned*)(vbase + (size_t)(kt) * 8192 + voff[i]), (LAS unsigned*)(lds + (st) * AT_BUF + AT_VT + 1024 * (wave + 8 * i)), 16, 0, 0); } } while (0)
    const int piq = (ql & 16) | ((ql & 4) << 1) | ((ql & 8) >> 1) | (ql & 3);
    unsigned ksw[8], vsw[4];
#pragma unroll
    for (int ks = 0; ks < 8; ++ks) ksw[ks] = (probe == 5) ? (unsigned)launder_v(lane * 16 + ks * 1024) : (unsigned)launder_v(piq * 256 + (((2 * ks + hi) ^ (piq & 15)) << 4));
#pragma unroll
    for (int s = 0; s < 4; ++s) vsw[s] = (probe == 5) ? (unsigned)launder_v(lane * 16 + s * 1024) : (unsigned)launder_v(ql * 128 + (((2 * s + hi) ^ ((ql >> 1) & 7)) << 4));
    const bool grpB = wave >= 4;
    AT_DMA(0, 0);
    u32x2 mw = *(const u32x2*)(mrow);
    bf16x8 pf[4];
#pragma unroll
    for (int s = 0; s < 4; ++s) pf[s] = (bf16x8){0, 0, 0, 0, 0, 0, 0, 0};
#define AT_PV(vb_) do { bf16x8 vf[2][4], vg[2][4]; \
        _Pragma("unroll") for (int dt = 0; dt < 2; ++dt) _Pragma("unroll") for (int s = 0; s < 4; ++s) vf[dt][s] = (probe == 7) ? qf[s + 4 * dt] : *(const LAS bf16x8*)((vb_) + vsw[s] + dt * 4096); \
        __builtin_amdgcn_sched_barrier(0); \
        _Pragma("unroll") for (int dt = 0; dt < 2; ++dt) _Pragma("unroll") for (int s = 0; s < 4; ++s) vg[dt][s] = (probe == 7) ? qf[s + 4 * dt] : *(const LAS bf16x8*)((vb_) + vsw[s] + (dt + 2) * 4096); \
        _Pragma("unroll") for (int dt = 0; dt < 2; ++dt) _Pragma("unroll") for (int s = 0; s < 4; ++s) { if (probe != 4 && probe < 6) O[dt] = mfma32(vf[dt][s], pf[s], O[dt]); else if (probe >= 6) O[dt][s] += __builtin_bit_cast(float, vf[dt][s][0] | (vf[dt][s][1] << 16)); } \
        __builtin_amdgcn_sched_barrier(0); \
        _Pragma("unroll") for (int dt = 0; dt < 2; ++dt) _Pragma("unroll") for (int s = 0; s < 4; ++s) { if (probe != 4 && probe < 6) O[dt + 2] = mfma32(vg[dt][s], pf[s], O[dt + 2]); else if (probe >= 6) O[dt + 2][s] += __builtin_bit_cast(float, vg[dt][s][0] | (vg[dt][s][1] << 16)); } } while (0)
    int st = 0, stp = 2;
    for (int kt = 0; kt < nkt; ++kt) {
        asm volatile("s_waitcnt vmcnt(0)" ::: "memory");
        __builtin_amdgcn_s_barrier();
        asm volatile("" ::: "memory");
        const u32x2 mcur = mw;
        const int stn = st == 2 ? 0 : st + 1;
        if (kt + 1 < nkt && probe != 2) { AT_DMA(kt + 1, stn); mw = *(const u32x2*)(mrow + 2 * (kt + 1)); }
        if (grpB && kt > 0) AT_PV(lds + stp * AT_BUF + AT_VT);
        const LAS unsigned char* kb = lds + st * AT_BUF + AT_K;
        f32x16 S[2];
        {
            bf16x8 kf[2][8];
#pragma unroll
            for (int hh = 0; hh < 2; ++hh)
#pragma unroll
                for (int ks = 0; ks < 8; ++ks) kf[hh][ks] = (probe == 7) ? qf[ks] : *(const LAS bf16x8*)(kb + ksw[ks] + hh * 8192);
            __builtin_amdgcn_sched_barrier(0);
#pragma unroll
            for (int hh = 0; hh < 2; ++hh) {
#pragma unroll
                for (int r = 0; r < 16; ++r) S[hh][r] = 0.f;
#pragma unroll
                for (int ks = 0; ks < 8; ++ks) { if (probe != 4 && probe < 6) S[hh] = mfma32(kf[hh][ks], qf[ks], S[hh]); else if (probe >= 6) S[hh][ks] += __builtin_bit_cast(float, kf[hh][ks][0] | (kf[hh][ks][1] << 16)); }
            }
        }
        const bool farr = (q0 - (64 * kt + 63)) >= 113;
        float mt = -INFINITY;
        if (farr) {
            const float boff = bfar - mrun;
#pragma unroll
            for (int hh = 0; hh < 2; ++hh) {
                const unsigned wbits = (hh ? mcur.y : mcur.x) >> (8 * hi);
#pragma unroll
                for (int r = 0; r < 16; ++r) {
                    const int kk = 16 * (r >> 3) + 4 * ((r >> 2) & 1) + (r & 3);
                    const float x = __builtin_fmaf(S[hh][r], c1, boff);
                    const int sel = __builtin_amdgcn_sbfe((int)wbits, kk, 1);
                    const float xm = bfi_sel(sel, x);
                    S[hh][r] = xm; mt = fmaxf(mt, xm);
                }
            }
        } else {
#pragma unroll
            for (int hh = 0; hh < 2; ++hh) {
                const unsigned wbits = (hh ? mcur.y : mcur.x) >> (8 * hi);
                const int dbase = tq - (64 * kt + 32 * hh + 8 * hi);
#pragma unroll
                for (int r = 0; r < 16; ++r) {
                    const int kk = 16 * (r >> 3) + 4 * ((r >> 2) & 1) + (r & 3);
                    int dist = dbase - kk; dist = dist < 0 ? 0 : (dist > 127 ? 127 : dist);
                    const float x = __builtin_fmaf(S[hh][r], c1, btab[dist] - mrun);
                    const int sel = __builtin_amdgcn_sbfe((int)wbits, kk, 1);
                    const float xm = bfi_sel(sel, x);
                    S[hh][r] = xm; mt = fmaxf(mt, xm);
                }
            }
        }
        mt = xmax32(mt);
        float alpha = 1.0f;
        if (!__all(mt <= 8.0f)) {
            const float dm = fmaxf(mt, 0.f); alpha = __builtin_amdgcn_exp2f(-dm); mrun += dm;
#pragma unroll
            for (int dt = 0; dt < 4; ++dt)
#pragma unroll
                for (int r = 0; r < 16; ++r) O[dt][r] *= alpha;
#pragma unroll
            for (int hh = 0; hh < 2; ++hh)
#pragma unroll
                for (int r = 0; r < 16; ++r) S[hh][r] -= dm;
        }
        float ps = 0.f;
#pragma unroll
        for (int hh = 0; hh < 2; ++hh)
#pragma unroll
            for (int r = 0; r < 16; ++r) { const float e = __builtin_amdgcn_exp2f(S[hh][r]); S[hh][r] = e; ps += e; }
        lrun = lrun * alpha + ps;
#pragma unroll
        for (int s = 0; s < 4; ++s) { const int hh = s >> 1, r0 = 8 * (s & 1);
            u32x4 wv; wv.x = pkbf(S[hh][r0 + 0], S[hh][r0 + 1]); wv.y = pkbf(S[hh][r0 + 2], S[hh][r0 + 3]); wv.z = pkbf(S[hh][r0 + 4], S[hh][r0 + 5]); wv.w = pkbf(S[hh][r0 + 6], S[hh][r0 + 7]);
            pf[s] = __builtin_bit_cast(bf16x8, wv); }
        if (!grpB) AT_PV(lds + st * AT_BUF + AT_VT);
        stp = st; st = stn;
    }
    if (grpB) AT_PV(lds + stp * AT_BUF + AT_VT);
#undef AT_PV
#undef AT_DMA
    const float ltot = xadd32(lrun);
    const float inv = 1.0f / ltot;
#pragma unroll
    for (int dt = 0; dt < 4; ++dt)
#pragma unroll
        for (int g = 0; g < 4; ++g) {
            u32x2 wv; wv.x = pkbf(O[dt][4 * g + 0] * inv, O[dt][4 * g + 1] * inv); wv.y = pkbf(O[dt][4 * g + 2] * inv, O[dt][4 * g + 3] * inv);
            *(u32x2*)(OB + row * old + head * 128 + 32 * dt + 8 * g + 4 * hi) = wv;
        }
    asm volatile("s_waitcnt vmcnt(0)" ::: "memory");
    __builtin_amdgcn_s_barrier();
    asm volatile("" ::: "memory");
}

#ifndef SKIP_MIXER
#define SKIP_MIXER 0
#endif
#ifndef PROBE_MIX
#define PROBE_MIX 0
#endif
#ifndef PROBE_CVT
#define PROBE_CVT 0
#endif
#ifndef ZERO_BRANCH
#define ZERO_BRANCH 0
#endif
__device__ __forceinline__ void zero_cols(bf16* P, int col0, int gw, int NGW, int lane) {
    for (int m = gw; m < M; m += NGW) { u32x4* o = (u32x4*)(P + (size_t)m * PLD + col0) + lane; o[0] = (u32x4){0u, 0u, 0u, 0u}; o[64] = (u32x4){0u, 0u, 0u, 0u}; }
}
__global__ void __launch_bounds__(512, 2) fwd(Params pdummy) {
    extern __shared__ __attribute__((aligned(16))) unsigned char lds_raw[];
    LAS unsigned char* lds = (LAS unsigned char*)lds_raw;
    const int wave0 = __builtin_amdgcn_readfirstlane(threadIdx.x >> 6);
    const int G = gridDim.x, bx = blockIdx.x;
    const int vcu = (G % 8 == 0) ? (bx % 8) * (G / 8) + bx / 8 : bx;
    const int NGW = G * 8;
    if (threadIdx.x < 64) ((LAS unsigned*)(lds + MISC_OFF))[threadIdx.x] = 0u;
    __syncthreads();
    XcdBarrier bar = xcd_barrier_post((unsigned*)(gws(kargs()) + WS_CTL) + CW_BAR, (volatile LAS unsigned*)(lds + MISC_OFF + 32));
#define GRID_BAR() xcd_barrier(bar)
#define PH_BEGIN const int lane = lane_id_asm(), wave = wave0, tid = wave * 64 + lane, gw = vcu * 8 + wave, bxl = launder_s(bx); KP p = kargs(); (void)bxl; unsigned char* ws = gws(p); (void)lane; (void)gw; (void)ws;

    for (int l = 0; l < DEPTH; ++l) {
        for (int rep = (PROBE_CVT & 1) ? 0 : 1; rep < 2; ++rep) { PH_BEGIN phase_cvt(p, l, lds, vcu, G, gw, NGW, wave, lane); }
        for (int f = 0; f < 2; ++f) {
            if (f == 1 && !SKIP_MIXER) {
                for (int rep = (PROBE_CVT & 1) ? 0 : 1; rep < 2; ++rep) { PH_BEGIN float* X = gout(p); bf16* XN = (bf16*)(ws + WS_XN);
                  rms_rows_bf16(X, gin(p, I_NMIX) + (size_t)l * DM, XN, gw, NGW, lane); }
                GRID_BAR();
                for (int rep = (PROBE_CVT & 4) ? 0 : 1; rep < 2; ++rep)
                { PH_BEGIN
                    pg8::Gemm g{(const bf16*)(ws + WS_XN), (const bf16*)(ws + WS_WIN), M, DIN_PAD, DM, DM, DM}; pg8::StaticOrder S; S.init(M, DIN_PAD, G, bxl);
                    pg8::EpiProj E{(bf16*)(ws + WS_R1), PLD, (float*)(ws + WS_SIDE)};
                    pg8::gemm_phase<pg8::EpiProj, pg8::StaticOrder, true, true>(lds, g, S, E, tid);
                }
                GRID_BAR();
                for (int rep = (PROBE_MIX & 16) ? 0 : 1; rep < 2; ++rep) {
                { PH_BEGIN
                    for (int gt = vcu * 512 + tid; gt < 4 * M; gt += G * 512) kidx_ln_quarter(p, l, gt);
                    for (int it = gw; it < 1024; it += NGW) vt_item(p, it, lds + 8192 + wave * 16384, lane);
                } }
                for (int rep = (PROBE_MIX & 32) ? 0 : 1; rep < 2; ++rep)
                { PH_BEGIN for (int it = vcu; it < 256; it += G) lru_job(p, l, it, lds, tid, lane, wave); }
                for (int rep = (PROBE_MIX & 64) ? 0 : 1; rep < 2; ++rep)
                { PH_BEGIN bf16* OB = rep ? (bf16*)(ws + WS_R1) + C_QM : (bf16*)(ws + WS_SCR); const int old = rep ? PLD : 1024;
                    if (!(ZERO_BRANCH & 4)) { for (int it = vcu; it < 512; it += G) memattn_job(p, it, lds, tid, lane, wave, OB, old); __syncthreads(); } else zero_cols((bf16*)(ws + WS_R1), C_QM, gw, NGW, lane);
                }
                GRID_BAR();
                for (int rep = (PROBE_MIX & 6) ? 0 : 1; rep < 2; ++rep) {
                { PH_BEGIN
                    if (!(ZERO_BRANCH & 1) && (rep || (PROBE_MIX & 2))) for (int pi = vcu; pi < 512; pi += G) { const int b = pi >> 8, j = pi & 255;
#pragma unroll 1
                        for (int k = 0; k < 2; ++k) { if ((PROBE_MIX >> 12) && rep == 0) select_item<(PROBE_MIX >> 12)>(p, b, k ? 511 - j : j, lds, tid, lane, wave); else select_item<0>(p, b, k ? 511 - j : j, lds, tid, lane, wave); } }
                    __syncthreads();
                }
                { PH_BEGIN bf16* OB = rep ? (bf16*)(ws + WS_R1) + C_GL : (bf16*)(ws + WS_SCR); const int old = rep ? PLD : 1024;
                    if (!(ZERO_BRANCH & 2) && (rep || (PROBE_MIX & 4))) { for (int it = vcu; it < 256; it += G) lru_apply_job(p, it, lds, tid, lane, wave, OB, old); } else if (ZERO_BRANCH & 2) zero_cols((bf16*)(ws + WS_R1), C_GL, gw, NGW, lane);
                }
                }
                GRID_BAR();
                for (int rep = (PROBE_MIX & 8) ? 0 : 1; rep < 2; ++rep) {
                { PH_BEGIN bf16* OB = rep ? (bf16*)(ws + WS_R1) + C_QA : (bf16*)(ws + WS_SCR); const int old = rep ? PLD : 1024;
                    if (!(ZERO_BRANCH & 1)) {
                        attn_bias_table(p, lds, tid);
                        __syncthreads();
                        for (int pi = vcu; pi < 256; pi += G) { const int bk = pi >> 6, j = pi & 63;
#pragma unroll 1
                            for (int k = 0; k < 2; ++k) { if ((PROBE_MIX >> 8) && rep == 0) attn_item<(PROBE_MIX >> 8)>(p, bk >> 1, bk & 1, k ? 127 - j : j, lds, lane, wave, OB, old); else attn_item<0>(p, bk >> 1, bk & 1, k ? 127 - j : j, lds, lane, wave, OB, old); } }
                    } else zero_cols((bf16*)(ws + WS_R1), C_QA, gw, NGW, lane);
                }
                }
                GRID_BAR();
                for (int rep = (PROBE_CVT & 16) ? 0 : 1; rep < 2; ++rep) {
                { PH_BEGIN bf16* R1 = (bf16*)(ws + WS_R1); const bf16* WBR = (const bf16*)(ws + WS_WBR); pg8::StaticOrder S; S.init(M, DM, G, bxl);
                  pg8::Gemm g{R1 + C_QA, WBR, M, DM, 1024, PLD, 1024}; pg8::EpiBf16 E{(bf16*)(ws + WS_SCR), DM}; pg8::gemm_phase<pg8::EpiBf16, pg8::StaticOrder, true, true>(lds, g, S, E, tid); }
                { PH_BEGIN bf16* R1 = (bf16*)(ws + WS_R1); const bf16* WBR = (const bf16*)(ws + WS_WBR); pg8::StaticOrder S; S.init(M, DM, G, bxl);
                  pg8::Gemm g{R1 + C_GL, WBR + (size_t)DM * 1024, M, DM, 1024, PLD, 1024}; pg8::EpiBf16 E{(bf16*)(ws + WS_SCR) + (size_t)M * DM, DM}; pg8::gemm_phase<pg8::EpiBf16, pg8::StaticOrder, true, true>(lds, g, S, E, tid); }
                { PH_BEGIN bf16* R1 = (bf16*)(ws + WS_R1); const bf16* WBR = (const bf16*)(ws + WS_WBR); pg8::StaticOrder S; S.init(M, DM, G, bxl);
                  pg8::Gemm g{R1 + C_QM, WBR + (size_t)2 * DM * 1024, M, DM, 1024, PLD, 1024}; pg8::EpiMerge E{R1 + C_GT, PLD, (const bf16*)(ws + WS_SCR), (const bf16*)(ws + WS_SCR) + (size_t)M * DM, (bf16*)(ws + WS_XN), DM}; pg8::gemm_phase<pg8::EpiMerge, pg8::StaticOrder, true, true>(lds, g, S, E, tid); }
                }
                GRID_BAR();
                { PH_BEGIN
                    pg8::Gemm g{(const bf16*)(ws + WS_XN), (const bf16*)(ws + WS_WOUT), M, DM, DM, DM, DM}; pg8::StaticOrder S; S.init(M, DM, G, bxl);
                    pg8::EpiResid E{gout(p), gout(p), DM, 1.0f};
                    pg8::gemm_phase<pg8::EpiResid, pg8::StaticOrder, true, true>(lds, g, S, E, tid);
                }
                GRID_BAR();
            }
            for (int rep = (PROBE_CVT & 1) ? 0 : 1; rep < 2; ++rep) { PH_BEGIN const float* xsrc = (l == 0 && f == 0) ? gin(p, I_X) : gout(p); bf16* XN = (bf16*)(ws + WS_XN);
              rms_rows_bf16(xsrc, gin(p, f ? I_NFF2 : I_NFF1) + (size_t)l * DM, XN, gw, NGW, lane); }
            GRID_BAR();
            if (f == 0) {
                { PH_BEGIN const bf16* WM = (const bf16*)(ws + WS_WMKV); const bf16* MN = (const bf16*)(ws + WS_MEMN);
                  pg8::Gemm g{MN, WM, BATCH * NMEM, 1024, DM, DM, DM}; pg8::SimpleOrder S; S.init(BATCH * NMEM, 1024, G, bxl - 192); pg8::EpiBf16 E{(bf16*)(ws + WS_MK), 1024}; pg8::gemm_phase<pg8::EpiBf16, pg8::SimpleOrder, true, true>(lds, g, S, E, tid); }
                { PH_BEGIN const bf16* WM = (const bf16*)(ws + WS_WMKV); const bf16* MN = (const bf16*)(ws + WS_MEMN);
                  pg8::Gemm g{WM + (size_t)1024 * DM, MN, 1024, BATCH * NMEM, DM, DM, DM}; pg8::SimpleOrder S; S.init(1024, BATCH * NMEM, G, bxl - 200); pg8::EpiBf16 E{(bf16*)(ws + WS_VTM), BATCH * NMEM}; pg8::gemm_phase<pg8::EpiBf16, pg8::SimpleOrder, true, true>(lds, g, S, E, tid); }
            }
            for (int rep = (PROBE_CVT & 2) ? 0 : 1; rep < 2; ++rep)
            { PH_BEGIN
                pg8::Gemm g{(const bf16*)(ws + WS_XN), (const bf16*)(ws + (f ? WS_WGU2 : WS_WGU)), M, 2 * DFF, DM, DM, DM}; pg8::StaticOrder S; S.init(M, 2 * DFF, G, bxl);
                pg8::EpiSwiglu E{(bf16*)(ws + WS_R1), DFF};
                pg8::gemm_phase<pg8::EpiSwiglu, pg8::StaticOrder, true, true>(lds, g, S, E, tid);
            }
            GRID_BAR();
            for (int rep = (PROBE_CVT & 8) ? 0 : 1; rep < 2; ++rep)
            { PH_BEGIN
                const float* xsrc = (l == 0 && f == 0) ? gin(p, I_X) : gout(p);
                pg8::Gemm g{(const bf16*)(ws + WS_R1), (const bf16*)(ws + (f ? WS_WDN2 : WS_WDN)), M, DM, DFF, DFF, DFF}; pg8::StaticOrder S; S.init(M, DM, G, bxl);
                pg8::EpiResid E{xsrc, rep ? gout(p) : (float*)(ws + WS_SCR), DM, 0.5f};
                pg8::gemm_phase<pg8::EpiResid, pg8::StaticOrder, true, true>(lds, g, S, E, tid);
            }
            GRID_BAR();
        }
    }
    { PH_BEGIN float* X = gout(p); const f32x4* gr = (const f32x4*)gin(p, I_FNORM) + lane;
      f32x4 gg[8];
#pragma unroll
      for (int j = 0; j < 8; ++j) gg[j] = gr[64 * j];
      for (int m = gw; m < M; m += 4 * NGW) {
          f32x4 v[4][8]; float ss[4];
#pragma unroll
          for (int r = 0; r < 4; ++r) { const int mr = (m + r * NGW < M) ? m + r * NGW : m; const f32x4* xr = (const f32x4*)(X + (size_t)mr * DM) + lane;
#pragma unroll
              for (int j = 0; j < 8; ++j) v[r][j] = xr[64 * j]; }
#pragma unroll
          for (int r = 0; r < 4; ++r) { float sq = 0.f;
#pragma unroll
              for (int j = 0; j < 8; ++j) sq += (v[r][j].x * v[r][j].x + v[r][j].y * v[r][j].y) + (v[r][j].z * v[r][j].z + v[r][j].w * v[r][j].w);
              ss[r] = 1.0f / sqrtf(wave_sum(sq) * (1.0f / DM) + EPS); }
#pragma unroll
          for (int r = 0; r < 4; ++r) if (m + r * NGW < M) { f32x4* o = (f32x4*)(X + (size_t)(m + r * NGW) * DM) + lane;
#pragma unroll
              for (int j = 0; j < 8; ++j) o[64 * j] = v[r][j] * ss[r] * gg[j]; }
      } }
}

extern "C" void kernel_launch(void* const* d_in, const int* in_sizes, int n_in, void* d_out, int out_size, void* d_ws, size_t ws_size, hipStream_t stream) {
    static int grid = 0;
    if (grid == 0) {
        if (n_in != 25 || in_sizes[0] != M * DM || out_size != M * DM || ws_size < WS_END) { fprintf(stderr, "kernel_launch: unexpected shapes / workspace (n_in %d, ws %zu, need %zu); nothing launched\n", n_in, ws_size, (size_t)WS_END); grid = -1; return; }
        int dev = 0, cus = 0, per_cu = 0;
        if (hipGetDevice(&dev) != hipSuccess || hipDeviceGetAttribute(&cus, hipDeviceAttributeMultiprocessorCount, dev) != hipSuccess) { grid = -1; return; }
        if (hipFuncSetAttribute((const void*)fwd, hipFuncAttributeMaxDynamicSharedMemorySize, LDS_BYTES) != hipSuccess) { fprintf(stderr, "kernel_launch: hipFuncSetAttribute failed\n"); grid = -1; return; }
        if (hipOccupancyMaxActiveBlocksPerMultiprocessor(&per_cu, (const void*)fwd, 512, LDS_BYTES) != hipSuccess || per_cu < 1) { fprintf(stderr, "kernel_launch: occupancy query reports %d workgroups per CU; nothing launched\n", per_cu); (void)hipGetLastError(); grid = -1; return; }
        grid = cus;
    }
    if (grid < 0) return;
    if (hipMemsetAsync((char*)d_ws + WS_CTL, 0, CTL_ZERO_BYTES, stream) != hipSuccess) return;
    Params a{};
    for (int i = 0; i < 25; ++i) a.in[i] = (const GAS float*)d_in[i];
    a.out = (GAS float*)d_out; a.ws = (GAS unsigned char*)d_ws;
    hipLaunchKernelGGL(fwd, dim3(grid), dim3(512), LDS_BYTES, stream, a);
}
```

```cpp
#include <hip/hip_runtime.h>
#include <cstdio>
#include <cstdint>

namespace pg8 {
#define PG8_LAS __attribute__((address_space(3)))
typedef unsigned short bf16_t;
typedef short bf16x8 __attribute__((ext_vector_type(8)));
typedef float f32x4 __attribute__((ext_vector_type(4)));
typedef unsigned u32x4 __attribute__((ext_vector_type(4)));
typedef unsigned u32x2 __attribute__((ext_vector_type(2)));
constexpr int BM = 256, BK = 64, HALF = 128, HTB = HALF * BK * 2  , STAGE_BYTES = 8 * HTB, NXCD = 8, WGM = 8;

__host__ __device__ __forceinline__ int lds_byte(int r, int c) { const int st = (r >> 4) * 2 + (c >> 5), rr = r & 15, cc = c & 31, ob = rr * 64 + cc * 2; return st * 1024 + (ob ^ (((ob >> 9) & 1) << 5)); }
__host__ __device__ __forceinline__ void stage_rc(int b, int& R, int& C) { const int st = b / 1024, sb = b % 1024, swz = sb ^ (((sb >> 9) & 1) << 5); R = (st >> 1) * 16 + swz / 64; C = (st & 1) * 32 + (swz % 64) / 2; }
__host__ __device__ __forceinline__ int perm32(int rho) { const int n = rho >> 4, i = rho & 15; return 8 * (i >> 2) + 4 * n + (i & 3); }

struct Unit { int pm, pn; };
struct Gemm { const bf16_t* A; const bf16_t* Bt; int M, N, K, lda, ldb; };

struct StaticOrder {
    int nM, nN, nwg, G, c;
    __host__ __device__ void init(int M, int N, int G_, int c_) { nM = M / BM; nN = N / BM; nwg = nM * nN; G = G_; c = c_; }
    __host__ __device__ bool next(int i, Unit& u) const {
        const long L = (long)i * G + c; if (L >= nwg) return false;
        int wgid = (int)L; { const int q = nwg / NXCD, r = nwg % NXCD, xcd = wgid % NXCD, off = wgid / NXCD; wgid = (xcd < r ? xcd * (q + 1) : r * (q + 1) + (xcd - r) * q) + off; }
        const int nig = WGM * nN, gid = wgid / nig, fm = gid * WGM, gsz = (nM - fm) < WGM ? (nM - fm) : WGM;
        u.pm = fm + ((wgid % nig) % gsz); u.pn = (wgid % nig) / gsz; return true;
    }
    __device__ __forceinline__ void a_ready(const Unit&) const {}
    __device__ __forceinline__ void done(const Unit&) const {}
};
struct SimpleOrder {
    int nM, nN, nwg, G, c;
    __host__ __device__ void init(int M, int N, int G_, int c_) { nM = M / BM; nN = N / BM; nwg = nM * nN; G = G_; c = c_; }
    __host__ __device__ bool next(int i, Unit& u) const {
        const long L = (long)i * G + c; if (L < 0 || L >= nwg) return false;
        u.pm = (int)(L % nM); u.pn = (int)(L / nM); return true;
    }
    __device__ __forceinline__ void a_ready(const Unit&) const {}
    __device__ __forceinline__ void done(const Unit&) const {}
};

__device__ __forceinline__ unsigned cvt_pk_bf16(float lo, float hi) { unsigned r; asm volatile("v_cvt_pk_bf16_f32 %0, %1, %2" : "=v"(r) : "v"(lo), "v"(hi)); return r; }

__device__ __forceinline__ float fsigmoid(float x) { return __builtin_amdgcn_rcpf(1.0f + __builtin_amdgcn_exp2f(-1.4426950408889634f * x)); }
__device__ __forceinline__ float bf_lo(unsigned w) { return __uint_as_float(w << 16); }
__device__ __forceinline__ float bf_hi(unsigned w) { return __uint_as_float(w & 0xffff0000u); }

struct EpiSwiglu {
    static constexpr bool PERM = true, AFTER_DRAIN = false;
    bf16_t* H; int ldh;
    __device__ __forceinline__ void operator()(const f32x4 (&acc)[2][2][4][2], const Unit& u, int wr, int wc, int fr, int fq) const {
        const int row0 = u.pm * BM + wr * 64 + fr, col0 = u.pn * HALF + wc * 32 + 8 * fq;
#pragma unroll
        for (int ai = 0; ai < 2; ++ai)
#pragma unroll
            for (int m = 0; m < 4; ++m) {
                bf16_t* rowp = H + (size_t)(row0 + ai * HALF + m * 16) * ldh + col0;
                const f32x4 g0 = acc[ai][0][m][0], g1 = acc[ai][0][m][1], u0 = acc[ai][1][m][0], u1 = acc[ai][1][m][1];
                float o[8];
#pragma unroll
                for (int j = 0; j < 4; ++j) { o[j] = g0[j] * fsigmoid(g0[j]) * u0[j]; o[4 + j] = g1[j] * fsigmoid(g1[j]) * u1[j]; }
                u32x4 w; w.x = cvt_pk_bf16(o[0], o[1]); w.y = cvt_pk_bf16(o[2], o[3]); w.z = cvt_pk_bf16(o[4], o[5]); w.w = cvt_pk_bf16(o[6], o[7]);
                *(u32x4*)rowp = w;
            }
    }
};
struct EpiResid {
    static constexpr bool PERM = false, AFTER_DRAIN = false;
    const float* src; float* out; int ldc; float alpha;
    __device__ __forceinline__ void operator()(const f32x4 (&acc)[2][2][4][2], const Unit& u, int wr, int wc, int fr, int fq) const {
        const int row0 = u.pm * BM + wr * 64 + fr, col0 = u.pn * BM + wc * 32 + 4 * fq;
#pragma unroll
        for (int ai = 0; ai < 2; ++ai)
#pragma unroll
            for (int m = 0; m < 4; ++m) {
                const size_t off = (size_t)(row0 + ai * HALF + m * 16) * ldc + col0;
                f32x4 s[2][2];
#pragma unroll
                for (int bj = 0; bj < 2; ++bj)
#pragma unroll
                    for (int n = 0; n < 2; ++n) s[bj][n] = *(const f32x4*)(src + off + bj * HALF + n * 16);
#pragma unroll
                for (int bj = 0; bj < 2; ++bj)
#pragma unroll
                    for (int n = 0; n < 2; ++n) *(f32x4*)(out + off + bj * HALF + n * 16) = s[bj][n] + acc[ai][bj][m][n] * alpha;
                if (m & 1) asm volatile("" ::: "memory");
            }
    }
};
struct EpiProj {
    static constexpr bool PERM = true, AFTER_DRAIN = false;
    bf16_t* P; int ldp; float* side;
    __device__ __forceinline__ void operator()(const f32x4 (&acc)[2][2][4][2], const Unit& u, int wr, int wc, int fr, int fq) const {
        const int row0 = u.pm * BM + wr * 64 + fr, cw = wc * 32 + 8 * fq;
        if (u.pn == 7) {
            if (cw < 72) {
#pragma unroll
                for (int ai = 0; ai < 2; ++ai)
#pragma unroll
                    for (int m = 0; m < 4; ++m) { float* rp = side + (size_t)(row0 + ai * HALF + m * 16) * 72 + cw; *(f32x4*)rp = acc[ai][0][m][0]; *(f32x4*)(rp + 4) = acc[ai][0][m][1]; }
            }
            return;
        }
        const int colbase = 256 * (u.pn > 7 ? u.pn - 1 : u.pn) + cw; const bool sig = u.pn >= 20;
#pragma unroll
        for (int ai = 0; ai < 2; ++ai)
#pragma unroll
            for (int m = 0; m < 4; ++m) {
                bf16_t* rowp = P + (size_t)(row0 + ai * HALF + m * 16) * ldp + colbase;
#pragma unroll
                for (int bj = 0; bj < 2; ++bj) {
                    f32x4 v0 = acc[ai][bj][m][0] + 0.0f, v1 = acc[ai][bj][m][1] + 0.0f;
                    if (sig) {
#pragma unroll
                        for (int j = 0; j < 4; ++j) { v0[j] = fsigmoid(v0[j]); v1[j] = fsigmoid(v1[j]); }
                    }
                    u32x4 w; w.x = cvt_pk_bf16(v0[0], v0[1]); w.y = cvt_pk_bf16(v0[2], v0[3]); w.z = cvt_pk_bf16(v1[0], v1[1]); w.w = cvt_pk_bf16(v1[2], v1[3]);
                    *(u32x4*)(rowp + bj * HALF) = w;
                }
            }
    }
};
template <int J> struct EpiBranch {
    static constexpr bool PERM = true, AFTER_DRAIN = false;
    const bf16_t* gate; int ldg; float* tmp; bf16_t* outb; int ldc;
    __device__ __forceinline__ void operator()(const f32x4 (&acc)[2][2][4][2], const Unit& u, int wr, int wc, int fr, int fq) const {
        const int row0 = u.pm * BM + wr * 64 + fr, col0 = u.pn * BM + wc * 32 + 8 * fq;
#pragma unroll
        for (int ai = 0; ai < 2; ++ai)
#pragma unroll
            for (int m = 0; m < 4; ++m) {
                const int row = row0 + ai * HALF + m * 16;
#pragma unroll
                for (int bj = 0; bj < 2; ++bj) {
                    const int c = col0 + bj * HALF;
                    const u32x4 gv = *(const u32x4*)(gate + (size_t)row * ldg + c);
                    f32x4 t0, t1;
                    t0[0] = bf_lo(gv.x) * acc[ai][bj][m][0][0]; t0[1] = bf_hi(gv.x) * acc[ai][bj][m][0][1]; t0[2] = bf_lo(gv.y) * acc[ai][bj][m][0][2]; t0[3] = bf_hi(gv.y) * acc[ai][bj][m][0][3];
                    t1[0] = bf_lo(gv.z) * acc[ai][bj][m][1][0]; t1[1] = bf_hi(gv.z) * acc[ai][bj][m][1][1]; t1[2] = bf_lo(gv.w) * acc[ai][bj][m][1][2]; t1[3] = bf_hi(gv.w) * acc[ai][bj][m][1][3];
                    float* tp = tmp + (size_t)row * ldc + c;
                    if (J > 0) { t0 += *(const f32x4*)tp; t1 += *(const f32x4*)(tp + 4); }
                    if (J < 2) { *(f32x4*)tp = t0; *(f32x4*)(tp + 4) = t1; }
                    else { u32x4 w; w.x = cvt_pk_bf16(t0[0], t0[1]); w.y = cvt_pk_bf16(t0[2], t0[3]); w.z = cvt_pk_bf16(t1[0], t1[1]); w.w = cvt_pk_bf16(t1[2], t1[3]);
                        *(u32x4*)(outb + (size_t)row * ldc + c) = w; }
                }
                asm volatile("" ::: "memory");
            }
    }
};
struct EpiMerge {
    static constexpr bool PERM = true, AFTER_DRAIN = false;
    const bf16_t* gate; int ldg; const bf16_t* z0; const bf16_t* z1; bf16_t* outb; int ldc;
    __device__ __forceinline__ void operator()(const f32x4 (&acc)[2][2][4][2], const Unit& u, int wr, int wc, int fr, int fq) const {
        const int row0 = u.pm * BM + wr * 64 + fr, col0 = u.pn * BM + wc * 32 + 8 * fq;
#pragma unroll
        for (int ai = 0; ai < 2; ++ai)
#pragma unroll
            for (int m = 0; m < 4; ++m) {
                const int row = row0 + ai * HALF + m * 16;
                u32x4 g0[2], g1[2], g2[2], a0[2], a1[2];
#pragma unroll
                for (int bj = 0; bj < 2; ++bj) { const int c = col0 + bj * HALF; const bf16_t* gp = gate + (size_t)row * ldg + c;
                    g0[bj] = *(const u32x4*)gp; g1[bj] = *(const u32x4*)(gp + 2048); g2[bj] = *(const u32x4*)(gp + 4096);
                    a0[bj] = *(const u32x4*)(z0 + (size_t)row * ldc + c); a1[bj] = *(const u32x4*)(z1 + (size_t)row * ldc + c); }
#pragma unroll
                for (int bj = 0; bj < 2; ++bj) {
                    const unsigned G0[4] = {g0[bj].x, g0[bj].y, g0[bj].z, g0[bj].w}, G1[4] = {g1[bj].x, g1[bj].y, g1[bj].z, g1[bj].w}, G2[4] = {g2[bj].x, g2[bj].y, g2[bj].z, g2[bj].w};
                    const unsigned A0[4] = {a0[bj].x, a0[bj].y, a0[bj].z, a0[bj].w}, A1[4] = {a1[bj].x, a1[bj].y, a1[bj].z, a1[bj].w};
                    unsigned w[4];
#pragma unroll
                    for (int k = 0; k < 4; ++k) {
                        const float lo = bf_lo(G0[k]) * bf_lo(A0[k]) + bf_lo(G1[k]) * bf_lo(A1[k]) + bf_lo(G2[k]) * acc[ai][bj][m][k >> 1][2 * (k & 1)];
                        const float hi = bf_hi(G0[k]) * bf_hi(A0[k]) + bf_hi(G1[k]) * bf_hi(A1[k]) + bf_hi(G2[k]) * acc[ai][bj][m][k >> 1][2 * (k & 1) + 1];
                        w[k] = cvt_pk_bf16(lo, hi); }
                    *(u32x4*)(outb + (size_t)row * ldc + col0 + bj * HALF) = (u32x4){w[0], w[1], w[2], w[3]};
                }
                asm volatile("" ::: "memory");
            }
    }
};
struct EpiBf16 {
    static constexpr bool PERM = true, AFTER_DRAIN = false;
    bf16_t* C; int ldc;
    __device__ __forceinline__ void operator()(const f32x4 (&acc)[2][2][4][2], const Unit& u, int wr, int wc, int fr, int fq) const {
        const int row0 = u.pm * BM + wr * 64 + fr, col0 = u.pn * BM + wc * 32 + 8 * fq;
#pragma unroll
        for (int ai = 0; ai < 2; ++ai)
#pragma unroll
            for (int m = 0; m < 4; ++m) {
                bf16_t* rowp = C + (size_t)(row0 + ai * HALF + m * 16) * ldc + col0;
#pragma unroll
                for (int bj = 0; bj < 2; ++bj) {
                    const f32x4 v0 = acc[ai][bj][m][0] + 0.0f, v1 = acc[ai][bj][m][1] + 0.0f;
                    u32x4 w; w.x = cvt_pk_bf16(v0[0], v0[1]); w.y = cvt_pk_bf16(v0[2], v0[3]); w.z = cvt_pk_bf16(v1[0], v1[1]); w.w = cvt_pk_bf16(v1[2], v1[3]);
                    *(u32x4*)(rowp + bj * HALF) = w;
                }
            }
    }
};

template <class Epi, class Sched, bool ALIGN_EPI = false, bool SP2 = false>
__device__ __forceinline__ void gemm_phase(PG8_LAS unsigned char* lds, const Gemm g, const Sched& S, const Epi& E, const int tid) {
    const int wid = __builtin_amdgcn_readfirstlane(tid >> 6), lane = tid & 63, wr = wid >> 2, wc = wid & 3, fr = lane & 15, fq = lane >> 4;
    const int K = g.K, nt = K / BK;
    unsigned voffA[2], voffB[2];
#pragma unroll
    for (int i = 0; i < 2; ++i) { int R, C; stage_rc(tid * 16 + i * 8192, R, C); const int Rb = Epi::PERM ? ((R & ~31) + perm32(R & 31)) : R;
        voffA[i] = (unsigned)(R * g.lda + C) * 2u; voffB[i] = (unsigned)(Rb * g.ldb + C) * 2u; }
    const size_t kstep = (size_t)(BK * 2);
    const size_t hstepA = (size_t)HALF * g.lda * 2, hstepB = (size_t)HALF * g.ldb * 2;
    const size_t tstepA = 2 * hstepA, tstepB = 2 * hstepB;
    const unsigned ldsw = (unsigned)wid * 1024u;
    const int aoff = lds_byte(wr * 64 + fr, fq * 8), boff = lds_byte(wc * 32 + fr, fq * 8);
#define PG8_SA(b, h) (((b) * 2 + (h)) * HTB)
#define PG8_SB(b, h) ((4 + (b) * 2 + (h)) * HTB)
#define PG8_STAGE(bufoff, gbase, voff) do { _Pragma("unroll") for (int _i = 0; _i < 2; ++_i) \
        __builtin_amdgcn_global_load_lds((const unsigned*)((const char*)(gbase) + (voff)[_i]), (PG8_LAS unsigned*)(lds + (bufoff) + ldsw + _i * 8192), 16, 0, 0); } while (0)
#define PG8_LDA(dst, b, h) do { _Pragma("unroll") for (int m = 0; m < 4; ++m) _Pragma("unroll") for (int k = 0; k < 2; ++k) dst[m][k] = *(const PG8_LAS bf16x8*)(lds + PG8_SA(b, h) + aoff + m * 2048 + k * 1024); } while (0)
#define PG8_LDB(dst, b, h) do { _Pragma("unroll") for (int n = 0; n < 2; ++n) _Pragma("unroll") for (int k = 0; k < 2; ++k) dst[n][k] = *(const PG8_LAS bf16x8*)(lds + PG8_SB(b, h) + boff + n * 2048 + k * 1024); } while (0)
#define PG8_MMA(ai, bj, At, Bt) do { __builtin_amdgcn_s_setprio(1); _Pragma("unroll") for (int m = 0; m < 4; ++m) _Pragma("unroll") for (int n = 0; n < 2; ++n) _Pragma("unroll") for (int k = 0; k < 2; ++k) \
        acc[ai][bj][m][n] = __builtin_amdgcn_mfma_f32_16x16x32_bf16(Bt[n][k], At[m][k], acc[ai][bj][m][n], 0, 0, 0); __builtin_amdgcn_s_setprio(0); } while (0)
#define PG8_WAIT_V(n) asm volatile("s_waitcnt vmcnt(" #n ")" ::: "memory")
#define PG8_WAIT_L(n) asm volatile("s_waitcnt lgkmcnt(" #n ")" ::: "memory")
#define PG8_BAR __builtin_amdgcn_s_barrier()
#define PG8_SCHED __builtin_amdgcn_sched_barrier(0)
    Unit cur, nxt; int ui = 0;
    if (!S.next(0, cur)) return;
    f32x4 acc[2][2][4][2];
#pragma unroll
    for (int a = 0; a < 2; ++a)
#pragma unroll
        for (int b = 0; b < 2; ++b)
#pragma unroll
            for (int m = 0; m < 4; ++m)
#pragma unroll
                for (int n = 0; n < 2; ++n) acc[a][b][m][n] = (f32x4){0.f, 0.f, 0.f, 0.f};
    bf16x8 At[4][2], B0[2][2], B1[2][2];
    const char* cA = (const char*)g.A + (size_t)cur.pm * tstepA; const char* cB = (const char*)g.Bt + (size_t)cur.pn * tstepB;
    S.a_ready(cur);
    if constexpr (SP2) {
        PG8_STAGE(PG8_SB(0, 0), cB, voffB); PG8_STAGE(PG8_SB(0, 1), cB + hstepB, voffB); PG8_STAGE(PG8_SA(0, 0), cA, voffA); PG8_STAGE(PG8_SA(0, 1), cA + hstepA, voffA);
        if (wr == 1) PG8_BAR;
        PG8_WAIT_V(2); PG8_BAR;
        PG8_STAGE(PG8_SB(1, 0), cB + kstep, voffB); PG8_STAGE(PG8_SA(1, 0), cA + kstep, voffA); PG8_STAGE(PG8_SB(1, 1), cB + hstepB + kstep, voffB);
        PG8_WAIT_V(6); PG8_BAR;
    } else {
        PG8_STAGE(PG8_SB(0, 0), cB, voffB); PG8_STAGE(PG8_SA(0, 0), cA, voffA); PG8_STAGE(PG8_SB(0, 1), cB + hstepB, voffB); PG8_STAGE(PG8_SA(0, 1), cA + hstepA, voffA);
        if (wr == 1) PG8_BAR;
        PG8_WAIT_V(4); PG8_BAR;
        PG8_STAGE(PG8_SB(1, 0), cB + kstep, voffB); PG8_STAGE(PG8_SA(1, 0), cA + kstep, voffA); PG8_STAGE(PG8_SB(1, 1), cB + hstepB + kstep, voffB);
        PG8_WAIT_V(6); PG8_BAR;
    }
    for (;;) {
        const bool has_next = S.next(ui + 1, nxt);
        const char* nA = has_next ? (const char*)g.A + (size_t)nxt.pm * tstepA : cA; const char* nB = has_next ? (const char*)g.Bt + (size_t)nxt.pn * tstepB : cB;
        for (int t = 0; t < nt; t += 2) {
            const bool last = (t == nt - 2);
            const char* a1 = cA + (size_t)(t + 1) * kstep;
            const char* a2 = last ? nA : cA + (size_t)(t + 2) * kstep; const char* b2 = last ? nB : cB + (size_t)(t + 2) * kstep;
            const char* a3 = a2 + kstep; const char* b3 = b2 + kstep;
            if (last && has_next) S.a_ready(nxt);
            if constexpr (SP2) {
            PG8_LDB(B0, 0, 0); PG8_LDB(B1, 0, 1); PG8_SCHED; PG8_LDA(At, 0, 0); PG8_STAGE(PG8_SA(1, 1), a1 + hstepA, voffA);
            PG8_WAIT_V(8); PG8_WAIT_L(0); PG8_BAR; PG8_MMA(0, 0, At, B0); PG8_MMA(0, 1, At, B1); PG8_BAR; PG8_SCHED;
            PG8_LDA(At, 0, 1); PG8_STAGE(PG8_SB(0, 0), b2, voffB); PG8_STAGE(PG8_SB(0, 1), b2 + hstepB, voffB); PG8_STAGE(PG8_SA(0, 0), a2, voffA);
            PG8_WAIT_V(8); PG8_WAIT_L(0); PG8_BAR; PG8_MMA(1, 0, At, B0); PG8_MMA(1, 1, At, B1); PG8_BAR; PG8_SCHED;
            PG8_LDB(B0, 1, 0); PG8_LDB(B1, 1, 1); PG8_SCHED; PG8_LDA(At, 1, 0); PG8_STAGE(PG8_SA(0, 1), a2 + hstepA, voffA);
            PG8_WAIT_V(8); PG8_WAIT_L(0); PG8_BAR; PG8_MMA(0, 0, At, B0); PG8_MMA(0, 1, At, B1); PG8_BAR; PG8_SCHED;
            PG8_LDA(At, 1, 1); PG8_STAGE(PG8_SB(1, 0), b3, voffB); PG8_STAGE(PG8_SB(1, 1), b3 + hstepB, voffB); PG8_STAGE(PG8_SA(1, 0), a3, voffA);
            PG8_WAIT_V(8); PG8_WAIT_L(0); PG8_BAR; PG8_MMA(1, 0, At, B0); PG8_MMA(1, 1, At, B1); PG8_BAR; PG8_SCHED;
            } else {
            PG8_LDB(B0, 0, 0); PG8_SCHED; PG8_LDA(At, 0, 0); PG8_STAGE(PG8_SA(1, 1), a1 + hstepA, voffA);
            PG8_WAIT_L(8); PG8_BAR; PG8_WAIT_L(0); PG8_MMA(0, 0, At, B0); PG8_BAR; PG8_SCHED;
            PG8_LDB(B1, 0, 1); PG8_STAGE(PG8_SB(0, 0), b2, voffB);
            PG8_BAR; PG8_WAIT_L(0); PG8_MMA(0, 1, At, B1); PG8_BAR;
            PG8_LDA(At, 0, 1); PG8_STAGE(PG8_SA(0, 0), a2, voffA);
            PG8_BAR; PG8_WAIT_L(0); PG8_MMA(1, 0, At, B0); PG8_BAR; PG8_SCHED;
            PG8_STAGE(PG8_SB(0, 1), b2 + hstepB, voffB);
            PG8_WAIT_V(6); PG8_BAR; PG8_MMA(1, 1, At, B1); PG8_BAR;
            PG8_LDB(B0, 1, 0); PG8_SCHED; PG8_LDA(At, 1, 0); PG8_STAGE(PG8_SA(0, 1), a2 + hstepA, voffA);
            PG8_WAIT_L(8); PG8_BAR; PG8_WAIT_L(0); PG8_MMA(0, 0, At, B0); PG8_BAR; PG8_SCHED;
            PG8_LDB(B1, 1, 1); PG8_STAGE(PG8_SB(1, 0), b3, voffB);
            PG8_BAR; PG8_WAIT_L(0); PG8_MMA(0, 1, At, B1); PG8_BAR;
            PG8_LDA(At, 1, 1); PG8_STAGE(PG8_SA(1, 0), a3, voffA);
            PG8_BAR; PG8_WAIT_L(0); PG8_MMA(1, 0, At, B0); PG8_BAR; PG8_SCHED;
            PG8_STAGE(PG8_SB(1, 1), b3 + hstepB, voffB);
            PG8_WAIT_V(6); PG8_BAR; PG8_MMA(1, 1, At, B1); PG8_BAR;
            }
        }
        if constexpr (ALIGN_EPI) { if (wr == 0) PG8_BAR; }
        if constexpr (!Epi::AFTER_DRAIN) { E(acc, cur, wr, wc, fr, fq); S.done(cur); }
        if (!has_next) break;
#pragma unroll
        for (int a = 0; a < 2; ++a)
#pragma unroll
            for (int b = 0; b < 2; ++b)
#pragma unroll
                for (int m = 0; m < 4; ++m)
#pragma unroll
                    for (int n = 0; n < 2; ++n) acc[a][b][m][n] = (f32x4){0.f, 0.f, 0.f, 0.f};
        cur = nxt; cA = nA; cB = nB; ++ui;
        if constexpr (ALIGN_EPI) { if (wr == 1) PG8_BAR; }
    }
    PG8_WAIT_V(0);
    if constexpr (!ALIGN_EPI) { if (wr == 0) PG8_BAR; }
    PG8_BAR;
    if constexpr (Epi::AFTER_DRAIN) { E.fused(acc, cur, wr, wc, fr, fq, lds, wid, lane); S.done(cur); }
#undef PG8_SA
#undef PG8_SB
#undef PG8_STAGE
#undef PG8_LDA
#undef PG8_LDB
#undef PG8_MMA
#undef PG8_WAIT_V
#undef PG8_WAIT_L
#undef PG8_BAR
#undef PG8_SCHED
}
}

constexpr int BATCH = 2, SEQ = 8192, M = BATCH * SEQ, DM = 2048, DFF = 5504, NMEM = 256, DEPTH = 2;
constexpr int DIN = 11076, DIN_PAD = 11264, PLD = 11008;
constexpr int C_QA = 0, C_KA = 1024, C_VA = 1280, C_QI = 1536, C_XL = 1792, C_GL = 2816, C_QM = 3840, C_GT = 4864;
constexpr float EPS = 1e-6f, LOG2E = 1.4426950408889634f;

constexpr size_t MiB = 1u << 20;
constexpr size_t WS_CTL = 0, CTL_ZERO_BYTES = 1 * MiB;
constexpr size_t WS_WGU = 2 * MiB, WS_WDN = 45 * MiB, WS_WIN = 67 * MiB, WS_WMKV = 111 * MiB, WS_WBR = 119 * MiB, WS_WOUT = 131 * MiB;
constexpr size_t WS_WGU2 = 139 * MiB, WS_WDN2 = 182 * MiB, WS_WAT = 204 * MiB, WS_WIT = 204 * MiB + 512 * 1024;
constexpr size_t WS_XN = 206 * MiB, WS_R1 = 270 * MiB, WS_SCR = 614 * MiB, WS_SIDE = 742 * MiB, WS_KIDX = 747 * MiB, WS_WIDX = 749 * MiB;
constexpr size_t WS_MASK = 750 * MiB, WS_VT = 766 * MiB, WS_MK = 774 * MiB, WS_VTM = 775 * MiB, WS_MEMN = 776 * MiB, WS_AGG = 778 * MiB, WS_END = 780 * MiB;
constexpr int CW_BAR = 4096;

constexpr int LDS_BYTES = 163840, MISC_OFF = LDS_BYTES - 256;

#define LAS __attribute__((address_space(3)))
typedef unsigned short bf16;
typedef short bf16x8 __attribute__((ext_vector_type(8)));
typedef float f32x4 __attribute__((ext_vector_type(4)));
typedef float f32x16 __attribute__((ext_vector_type(16)));
typedef unsigned u32x4 __attribute__((ext_vector_type(4)));
typedef unsigned u32x2 __attribute__((ext_vector_type(2)));
#define LDS_WAIT() asm volatile("s_waitcnt lgkmcnt(0)" ::: "memory")
#define VM_WAIT() asm volatile("s_waitcnt vmcnt(0)" ::: "memory")
__device__ __forceinline__ unsigned f2bf(float f) { unsigned u = __builtin_bit_cast(unsigned, f); return (u + 0x7fffu + ((u >> 16) & 1u)) >> 16; }
__device__ __forceinline__ unsigned pk2(float lo, float hi) { return f2bf(lo) | (f2bf(hi) << 16); }
__device__ __forceinline__ unsigned pkbf(float lo, float hi) { unsigned r; asm("v_cvt_pk_bf16_f32 %0, %1, %2" : "=v"(r) : "v"(lo), "v"(hi)); return r; }
__device__ __forceinline__ float bflo(unsigned w) { return __uint_as_float(w << 16); }
__device__ __forceinline__ float bfhi(unsigned w) { return __uint_as_float(w & 0xffff0000u); }

#define XB_TMO      128
#define XB_XCNT(j)  (256  + 64 * (j))
#define XB_XSUB(j)  (1280 + 64 * (j))
#define XB_XGEN(j)  (2304 + 64 * (j))
#define XB_TOP      3328
#define XB_TOPGEN   3392
#define XCD_BAR_WORDS 3456
#define XB_SPIN_CAP (1u << 18)

__device__ __forceinline__ unsigned xb_ld(unsigned* p)              { return __hip_atomic_load(p, __ATOMIC_RELAXED, __HIP_MEMORY_SCOPE_AGENT); }
__device__ __forceinline__ unsigned xb_add(unsigned* p, unsigned v) { return __hip_atomic_fetch_add(p, v, __ATOMIC_RELAXED, __HIP_MEMORY_SCOPE_AGENT); }
__device__ __forceinline__ unsigned xb_xcc_id() { return (unsigned)__builtin_amdgcn_s_getreg((3 << 11) | 20) & 0xFu; }
#define XB_SPIN(cond, bar) do { unsigned _sp = 0; while (cond) { __builtin_amdgcn_s_sleep(1); \
    if ((++_sp & 255u) == 0u) { if (xb_ld(&(bar)[XB_TMO])) break; if (_sp > XB_SPIN_CAP) { atomicAdd(&(bar)[XB_TMO], 1u); break; } } } } while (0)

struct XcdBarrier {
    unsigned* bar; unsigned x;
    volatile LAS unsigned* st;
};
__device__ __forceinline__ XcdBarrier xcd_barrier_post(unsigned* bar, volatile LAS unsigned* st) {
    XcdBarrier b; b.bar = bar; b.x = xb_xcc_id(); b.st = st;
    if (threadIdx.x == 0) (void)xb_add(&bar[XB_XCNT(b.x)], 1u);
    return b;
}
__device__ __forceinline__ void xcd_barrier_complete(unsigned* bar, unsigned x, unsigned& nloc, unsigned& nx) {
    const unsigned G = gridDim.x * gridDim.y * gridDim.z;
    unsigned sum, cnt, mine, sp = 0u;
    for (;;) {
        sum = 0u; cnt = 0u; mine = 0u;
#pragma unroll
        for (unsigned j = 0; j < 16; ++j) { const unsigned c = xb_ld(&bar[XB_XCNT(j)]); sum += c; cnt += (c > 0u) ? 1u : 0u; mine = (j == x) ? c : mine; }
        if (sum == G) break;
        __builtin_amdgcn_s_sleep(1);
        if ((++sp & 255u) == 0u) { if (xb_ld(&bar[XB_TMO])) break; if (sp > XB_SPIN_CAP) { atomicAdd(&bar[XB_TMO], 1u); break; } }
    }
    nloc = mine > 0u ? mine : 1u; nx = cnt > 0u ? cnt : 1u;
}
__device__ __forceinline__ void xcd_barrier(const XcdBarrier& b) {
    asm volatile("s_waitcnt vmcnt(0)" ::: "memory");
    __syncthreads();
    if (threadIdx.x == 0) {
        unsigned* bar = b.bar;
        __builtin_amdgcn_s_waitcnt(0);
        unsigned nloc = b.st[0], nx = b.st[1];
        if (nloc == 0u) { xcd_barrier_complete(bar, b.x, nloc, nx); b.st[0] = nloc; b.st[1] = nx; }
        const unsigned old = xb_add(&bar[XB_XSUB(b.x)], 1u);
        const unsigned gen = old / nloc;
        if (old + 1u == (gen + 1u) * nloc) {
            __builtin_amdgcn_fence(__ATOMIC_RELEASE, "agent");
            asm volatile("s_waitcnt vmcnt(0)" ::: "memory");
            const unsigned og = xb_add(&bar[XB_TOP], 1u);
            const unsigned tg = og / nx;
            if (og + 1u == (tg + 1u) * nx) xb_add(&bar[XB_TOPGEN], 1u);
            else XB_SPIN(xb_ld(&bar[XB_TOPGEN]) == tg, bar);
            __builtin_amdgcn_fence(__ATOMIC_ACQUIRE, "agent");
            xb_add(&bar[XB_XGEN(b.x)], 1u);
            asm volatile("s_waitcnt vmcnt(0)" ::: "memory");
        } else {
            XB_SPIN(xb_ld(&bar[XB_XGEN(b.x)]) == gen, bar);
            __builtin_amdgcn_fence(__ATOMIC_ACQUIRE, "agent");
            asm volatile("s_waitcnt vmcnt(0)" ::: "memory");
        }
    }
    __syncthreads();
}

#define GAS __attribute__((address_space(1)))
struct Params { const GAS float* in[25]; GAS float* out; GAS unsigned char* ws; };
typedef const Params __attribute__((address_space(4)))* KP;
__device__ __forceinline__ KP kargs() { KP k = (KP)__builtin_amdgcn_kernarg_segment_ptr(); asm volatile("" : "+s"(k)); return k; }
__device__ __forceinline__ const float* gin(KP k, int i) { return (const float*)k->in[i]; }
__device__ __forceinline__ float* gout(KP k) { return (float*)k->out; }
__device__ __forceinline__ unsigned char* gws(KP k) { return (unsigned char*)k->ws; }
__device__ __forceinline__ int lane_id_asm() { int l; asm volatile("v_mbcnt_lo_u32_b32 %0, -1, 0\n\tv_mbcnt_hi_u32_b32 %0, -1, %0" : "=v"(l)); return l; }
__device__ __forceinline__ int launder_s(int v) { asm volatile("" : "+s"(v)); return v; }
__device__ __forceinline__ int launder_v(int v) { asm volatile("" : "+v"(v)); return v; }
enum { I_X = 0, I_MEM, I_RELB, I_FNORM, I_NFF1, I_WGU1, I_WDN1, I_NMIX, I_WIN, I_CONVW, I_CONVB, I_WA, I_BA, I_WI, I_BI, I_LAM, I_LNG, I_LNB, I_MEMNORM, I_WMKV, I_WBR, I_WOUT, I_NFF2, I_WGU2, I_WDN2 };

__device__ __forceinline__ float wave_sum(float v) {
#pragma unroll
    for (int o = 1; o < 64; o <<= 1) v += __shfl_xor(v, o);
    return v;
}
__device__ __forceinline__ f32x4 mfma16(bf16x8 a, bf16x8 b, f32x4 c) { return __builtin_amdgcn_mfma_f32_16x16x32_bf16(a, b, c, 0, 0, 0); }
__device__ __forceinline__ f32x16 mfma32(bf16x8 a, bf16x8 b, f32x16 c) { return __builtin_amdgcn_mfma_f32_32x32x16_bf16(a, b, c, 0, 0, 0); }

__device__ __forceinline__ void tr_item(const float* W, int ldw, int scol0, int nvalid, bf16* WT, int ldt, int drow0, int k0, LAS float* scr, int lane) {
    if (nvalid == 32) {
#pragma unroll
        for (int i = 0; i < 8; ++i) { const int kk = 8 * i + (lane >> 3), c4 = (lane & 7) * 4;
            const f32x4 v = *(const f32x4*)(W + (size_t)(k0 + kk) * ldw + scol0 + c4);
            LAS float* d = scr + kk * 33 + c4; d[0] = v.x; d[1] = v.y; d[2] = v.z; d[3] = v.w; }
    } else {
#pragma unroll 8
        for (int i = 0; i < 32; ++i) { const int kk = 2 * i + (lane >> 5), c = lane & 31; scr[kk * 33 + c] = (c < nvalid) ? W[(size_t)(k0 + kk) * ldw + scol0 + c] : 0.f; }
    }
    LDS_WAIT(); asm volatile("" ::: "memory");
    const int c = lane & 7;
#pragma unroll
    for (int j = 0; j < 4; ++j) { const int n = (lane >> 3) + 8 * j; const LAS float* s = scr + (8 * c) * 33 + n;
        u32x4 o; o.x = pkbf(s[0 * 33], s[1 * 33]); o.y = pkbf(s[2 * 33], s[3 * 33]); o.z = pkbf(s[4 * 33], s[5 * 33]); o.w = pkbf(s[6 * 33], s[7 * 33]);
        *(u32x4*)(WT + (size_t)(drow0 + n) * ldt + k0 + 8 * c) = o; }
    LDS_WAIT(); asm volatile("" ::: "memory");
}
__device__ __forceinline__ void tr_plain(const float* W, int K, int N, bf16* WT, int item, LAS float* scr, int lane) {
    const int nblk = N / 32, kb = item / nblk, nb = item % nblk;
    tr_item(W, N, 32 * nb, 32, WT, K, 32 * nb, 64 * kb, scr, lane);
}
__device__ __forceinline__ void tr_gu(const float* W, bf16* WT, int item, LAS float* scr, int lane) {
    const int nblk = 2 * DFF / 32, kb = item / nblk, nb = item % nblk, n0 = 32 * nb, T = n0 >> 8, wi = n0 & 255;
    const int sc = wi < 128 ? 128 * T + wi : DFF + 128 * T + (wi - 128);
    tr_item(W, 2 * DFF, sc, 32, WT, DM, n0, 64 * kb, scr, lane);
}
__device__ __forceinline__ void tr_win(const float* W, bf16* WT, int item, LAS float* scr, int lane) {
    const int nblk = DIN_PAD / 32, kb = item / nblk, nb = item % nblk, n0 = 32 * nb;
    int sc, nv;
    if (n0 < 1792) { sc = n0; nv = 32; }
    else if (n0 < 2048) { const int off = n0 - 1792; sc = 1792 + off; nv = 68 - off; nv = nv < 0 ? 0 : (nv > 32 ? 32 : nv); if (nv == 0) sc = 0; }
    else { sc = n0 - 188; nv = 32; }
    tr_item(W, DIN, sc, nv, WT, DM, n0, 64 * kb, scr, lane);
}

__device__ __forceinline__ void rms_row_bf16(const float* xrow, const float* g, bf16* orow, int lane) {
    const f32x4* xr = (const f32x4*)xrow + lane; const f32x4* gr = (const f32x4*)g + lane;
    f32x4 v[8]; float s = 0.f;
#pragma unroll
    for (int j = 0; j < 8; ++j) { v[j] = xr[64 * j]; s += (v[j].x * v[j].x + v[j].y * v[j].y) + (v[j].z * v[j].z + v[j].w * v[j].w); }
    const float rstd = 1.0f / sqrtf(wave_sum(s) * (1.0f / DM) + EPS);
    u32x2* o8 = (u32x2*)orow + lane;
#pragma unroll
    for (int j = 0; j < 8; ++j) { const f32x4 gg = gr[64 * j]; u32x2 w; w.x = pk2(v[j].x * rstd * gg.x, v[j].y * rstd * gg.y); w.y = pk2(v[j].z * rstd * gg.z, v[j].w * rstd * gg.w); o8[64 * j] = w; }
}
__device__ __forceinline__ void rms_rows_bf16(const float* x, const float* g, bf16* out, int gw, int NGW, int lane) {
    const f32x4* gr = (const f32x4*)g + lane;
    f32x4 gg[8];
#pragma unroll
    for (int j = 0; j < 8; ++j) gg[j] = gr[64 * j];
    for (int m = gw; m < M; m += 4 * NGW) {
        f32x4 v[4][8]; float ss[4];
#pragma unroll
        for (int r = 0; r < 4; ++r) { const int mr = (m + r * NGW < M) ? m + r * NGW : m; const f32x4* xr = (const f32x4*)(x + (size_t)mr * DM) + lane;
#pragma unroll
            for (int j = 0; j < 8; ++j) v[r][j] = xr[64 * j]; }
#pragma unroll
        for (int r = 0; r < 4; ++r) { float s = 0.f;
#pragma unroll
            for (int j = 0; j < 8; ++j) s += (v[r][j].x * v[r][j].x + v[r][j].y * v[r][j].y) + (v[r][j].z * v[r][j].z + v[r][j].w * v[r][j].w);
            ss[r] = 1.0f / sqrtf(wave_sum(s) * (1.0f / DM) + EPS); }
#pragma unroll
        for (int r = 0; r < 4; ++r) if (m + r * NGW < M) { u32x2* o = (u32x2*)(out + (size_t)(m + r * NGW) * DM) + lane;
#pragma unroll
            for (int j = 0; j < 8; ++j) { u32x2 w; w.x = pkbf(v[r][j].x * ss[r] * gg[j].x, v[r][j].y * ss[r] * gg[j].y); w.y = pkbf(v[r][j].z * ss[r] * gg[j].z, v[r][j].w * ss[r] * gg[j].w); o[64 * j] = w; } }
    }
}
__device__ __forceinline__ void rms_row_f32(const float* xrow, const float* g, float* orow, int lane) {
    const f32x4* xr = (const f32x4*)xrow + lane; const f32x4* gr = (const f32x4*)g + lane;
    f32x4 v[8]; float s = 0.f;
#pragma unroll
    for (int j = 0; j < 8; ++j) { v[j] = xr[64 * j]; s += (v[j].x * v[j].x + v[j].y * v[j].y) + (v[j].z * v[j].z + v[j].w * v[j].w); }
    const float rstd = 1.0f / sqrtf(wave_sum(s) * (1.0f / DM) + EPS);
    f32x4* o = (f32x4*)orow + lane;
#pragma unroll
    for (int j = 0; j < 8; ++j) { const f32x4 gg = gr[64 * j]; o[64 * j] = v[j] * rstd * gg; }
}

template <class SC> __device__ __forceinline__ void tr_wg_item(const float* W, int ldw, SC scol, bf16* WT, int ldt, int drow0, int k0, LAS unsigned char* ldsb, int tid, int lane, int wave) {
    LAS float* tile = (LAS float*)ldsb;
    const int run = lane >> 3, c4 = (lane & 7) * 4;
    int sc, nv; scol(run, sc, nv);
    f32x4 v[16];
#pragma unroll
    for (int i = 0; i < 16; ++i) { const int kk = wave * 16 + i;
        v[i] = (f32x4){0.f, 0.f, 0.f, 0.f};
        if (nv == 32) v[i] = *(const f32x4*)(W + (size_t)(k0 + kk) * ldw + sc + c4);
        else { const float* src = W + (size_t)(k0 + kk) * ldw + sc; if (c4 + 0 < nv) v[i].x = src[c4]; if (c4 + 1 < nv) v[i].y = src[c4 + 1]; if (c4 + 2 < nv) v[i].z = src[c4 + 2]; if (c4 + 3 < nv) v[i].w = src[c4 + 3]; } }
#pragma unroll
    for (int i = 0; i < 16; ++i) { LAS float* o = tile + (wave * 16 + i) * 257 + run * 32 + c4; o[0] = v[i].x; o[1] = v[i].y; o[2] = v[i].z; o[3] = v[i].w; }
    __syncthreads();
    const int c = lane & 15;
#pragma unroll
    for (int j = 0; j < 8; ++j) { const int n = wave * 32 + (lane >> 4) + 4 * j; const LAS float* s = tile + (8 * c) * 257 + n;
        u32x4 o; o.x = pkbf(s[0 * 257], s[1 * 257]); o.y = pkbf(s[2 * 257], s[3 * 257]); o.z = pkbf(s[4 * 257], s[5 * 257]); o.w = pkbf(s[6 * 257], s[7 * 257]);
        *(u32x4*)(WT + (size_t)(drow0 + n) * ldt + k0 + 8 * c) = o; }
    __syncthreads();
}
struct ScPlain { int n0; __device__ __forceinline__ void operator()(int run, int& sc, int& nv) const { sc = n0 + 32 * run; nv = 32; } };
struct ScGu { int T; __device__ __forceinline__ void operator()(int run, int& sc, int& nv) const { sc = run < 4 ? 128 * T + 32 * run : DFF + 128 * T + 32 * (run - 4); nv = 32; } };
struct ScWin { int n0; __device__ __forceinline__ void operator()(int run, int& sc, int& nv) const { const int r0 = n0 + 32 * run;
    if (r0 < 1792) { sc = r0; nv = 32; } else if (r0 < 2048) { const int off = r0 - 1792; sc = 1792 + off; nv = 68 - off; nv = nv < 0 ? 0 : (nv > 32 ? 32 : nv); if (nv == 0) sc = 0; } else { sc = r0 - 188; nv = 32; } } };
__device__ __forceinline__ void phase_cvt(KP p, int l, LAS unsigned char* lds, int vcu_, int G, int gw, int NGW, int wave, int lane_) {
    const int vcu = launder_s(vcu_), lane = launder_v(lane_), tid = wave * 64 + lane;
    unsigned char* ws = gws(p);
    constexpr int J_GU = (DM / 128) * (2 * DFF / 256), J_DN = (DFF / 128) * (DM / 256), J_IN = (DM / 128) * (DIN_PAD / 256), J_SQ = (DM / 128) * (DM / 256), J_BR = (1024 / 128) * (DM / 256);
    constexpr int NJ = 2 * J_GU + 2 * J_DN + J_IN + 2 * J_SQ + 3 * J_BR;
    for (int it = vcu; it < NJ; it += G) {
        int r = it;
        if (r < 2 * J_GU) { const bool sec = r >= J_GU; r -= sec ? J_GU : 0; const int nb = r % (2 * DFF / 256), kb = r / (2 * DFF / 256);
            tr_wg_item(gin(p, sec ? I_WGU2 : I_WGU1) + (size_t)l * DM * 2 * DFF, 2 * DFF, ScGu{nb}, (bf16*)(ws + (sec ? WS_WGU2 : WS_WGU)), DM, 256 * nb, 128 * kb, lds, tid, lane, wave); continue; }
        r -= 2 * J_GU;
        if (r < 2 * J_DN) { const bool sec = r >= J_DN; r -= sec ? J_DN : 0; const int nb = r % (DM / 256), kb = r / (DM / 256);
            tr_wg_item(gin(p, sec ? I_WDN2 : I_WDN1) + (size_t)l * DFF * DM, DM, ScPlain{256 * nb}, (bf16*)(ws + (sec ? WS_WDN2 : WS_WDN)), DFF, 256 * nb, 128 * kb, lds, tid, lane, wave); continue; }
        r -= 2 * J_DN;
        if (r < J_IN) { const int nb = r % (DIN_PAD / 256), kb = r / (DIN_PAD / 256);
            tr_wg_item(gin(p, I_WIN) + (size_t)l * DM * DIN, DIN, ScWin{256 * nb}, (bf16*)(ws + WS_WIN), DM, 256 * nb, 128 * kb, lds, tid, lane, wave); continue; }
        r -= J_IN;
        if (r < 2 * J_SQ) { const bool sec = r >= J_SQ; r -= sec ? J_SQ : 0; const int nb = r % (DM / 256), kb = r / (DM / 256);
            tr_wg_item(gin(p, sec ? I_WOUT : I_WMKV) + (size_t)l * DM * DM, DM, ScPlain{256 * nb}, (bf16*)(ws + (sec ? WS_WOUT : WS_WMKV)), DM, 256 * nb, 128 * kb, lds, tid, lane, wave); continue; }
        r -= 2 * J_SQ;
        { const int j = r / J_BR, rr = r % J_BR, nb = rr % (DM / 256), kb = rr / (DM / 256);
          tr_wg_item(gin(p, I_WBR) + ((size_t)l * 3 + j) * 1024 * DM, DM, ScPlain{256 * nb}, (bf16*)(ws + WS_WBR) + (size_t)j * DM * 1024, 1024, 256 * nb, 128 * kb, lds, tid, lane, wave); }
    }
    { __syncthreads(); LAS float* scr = (LAS float*)(lds + wave * 8704);
      for (int it = gw; it < 16 * 8; it += NGW) { const int mtx = it >> 3, n = mtx & 7; const bool isI = mtx >= 8;
          tr_plain(gin(p, isI ? I_WI : I_WA) + ((size_t)l * 8 + n) * 128 * 128, 128, 128, (bf16*)(ws + (isI ? WS_WIT : WS_WAT)) + (size_t)n * 128 * 128, it & 7, scr, lane); } }
    for (int m = gw; m < BATCH * NMEM; m += NGW) rms_row_bf16(gin(p, I_MEM) + (size_t)m * DM, gin(p, I_MEMNORM) + (size_t)l * DM, (bf16*)(ws + WS_MEMN) + (size_t)m * DM, lane);
}

__device__ __forceinline__ float row_bcast15(float v) { return __builtin_bit_cast(float, __builtin_amdgcn_update_dpp(0, __builtin_bit_cast(int, v), 0x15F, 0xF, 0xF, false)); }
__device__ __forceinline__ float xmax32(float v) { auto rr = __builtin_amdgcn_permlane32_swap(__float_as_uint(v), __float_as_uint(v), false, false); return fmaxf(__uint_as_float(rr[0]), __uint_as_float(rr[1])); }
__device__ __forceinline__ float xadd32(float v) { auto rr = __builtin_amdgcn_permlane32_swap(__float_as_uint(v), __float_as_uint(v), false, false); return __uint_as_float(rr[0]) + __uint_as_float(rr[1]); }
__device__ __forceinline__ unsigned xor32_or(unsigned v) { auto rr = __builtin_amdgcn_permlane32_swap(v, v, false, false); return rr[0] | rr[1]; }
__device__ __forceinline__ unsigned xor16_or(unsigned v) { auto rr = __builtin_amdgcn_permlane16_swap(v, v, false, false); return rr[0] | rr[1]; }
template <int N> __device__ __forceinline__ float dpp_shr(float v, float ident) {
    return __builtin_bit_cast(float, __builtin_amdgcn_update_dpp(__builtin_bit_cast(int, ident), __builtin_bit_cast(int, v), 0x110 + N, 0xF, 0xF, false));
}
__device__ __forceinline__ float fsig(float x) { return __builtin_amdgcn_rcpf(1.0f + __builtin_amdgcn_exp2f(-LOG2E * x)); }
__device__ __forceinline__ float gelu_tanh(float x) {
    const float z = 0.7978845608028654f * (x + 0.044715f * x * x * x);
    const float e = __builtin_amdgcn_exp2f(2.0f * LOG2E * z);
    const float t = 1.0f - 2.0f * __builtin_amdgcn_rcpf(e + 1.0f);
    return 0.5f * x * (1.0f + t);
}

__device__ __forceinline__ void kidx_ln_quarter(KP p, int l, int gt) {
    const int row = gt >> 2, q = gt & 3;
    const float* s = (const float*)(gws(p) + WS_SIDE) + (size_t)row * 72 + 16 * q;
    const float* g = gin(p, I_LNG) + l * 64 + 16 * q; const float* be = gin(p, I_LNB) + l * 64 + 16 * q;
    f32x4 v[4]; float mu = 0.f;
#pragma unroll
    for (int i = 0; i < 4; ++i) { v[i] = *(const f32x4*)(s + 4 * i); mu += (v[i].x + v[i].y) + (v[i].z + v[i].w); }
    mu += __shfl_xor(mu, 1); mu += __shfl_xor(mu, 2); mu *= (1.0f / 64.0f);
    float var = 0.f;
#pragma unroll
    for (int i = 0; i < 4; ++i) { v[i] = v[i] - mu; var += (v[i].x * v[i].x + v[i].y * v[i].y) + (v[i].z * v[i].z + v[i].w * v[i].w); }
    var += __shfl_xor(var, 1); var += __shfl_xor(var, 2);
    const float rstd = 1.0f / sqrtf(var * (1.0f / 64.0f) + EPS);
    bf16* o = (bf16*)(gws(p) + WS_KIDX) + (size_t)row * 64 + 16 * q;
    unsigned w[8];
#pragma unroll
    for (int i = 0; i < 4; ++i) { const f32x4 gg = *(const f32x4*)(g + 4 * i), bb = *(const f32x4*)(be + 4 * i);
        w[2 * i] = pk2(v[i].x * rstd * gg.x + bb.x, v[i].y * rstd * gg.y + bb.y); w[2 * i + 1] = pk2(v[i].z * rstd * gg.z + bb.z, v[i].w * rstd * gg.w + bb.w); }
    *(u32x4*)o = (u32x4){w[0], w[1], w[2], w[3]}; *(u32x4*)(o + 8) = (u32x4){w[4], w[5], w[6], w[7]};
    if (q == 0) { const f32x4 wv = *(const f32x4*)(s + 64); *(f32x4*)((float*)(gws(p) + WS_WIDX) + (size_t)row * 4) = wv * 0.0625f; }
}

__device__ __forceinline__ void vt_item(KP p, int item, LAS unsigned char* scrb, int lane) {
    const int db = item & 1, tb = (item >> 1) & 127, kvh = (item >> 8) & 1, b = item >> 9;
    const bf16* P = (const bf16*)(gws(p) + WS_R1);
    LAS unsigned short* scr = (LAS unsigned short*)scrb;
#pragma unroll
    for (int i = 0; i < 8; ++i) {
        const int t = 8 * i + (lane >> 3), ch = lane & 7;
        const u32x4 v = *(const u32x4*)(P + (size_t)(b * SEQ + tb * 64 + t) * PLD + C_VA + kvh * 128 + db * 64 + 8 * ch);
        const unsigned w[4] = {v.x, v.y, v.z, v.w};
#pragma unroll
        for (int j = 0; j < 4; ++j) { scr[(8 * ch + 2 * j) * 66 + t] = (unsigned short)(w[j] & 0xffff); scr[(8 * ch + 2 * j + 1) * 66 + t] = (unsigned short)(w[j] >> 16); }
    }
    LDS_WAIT(); asm volatile("" ::: "memory");
    bf16* VT = (bf16*)(gws(p) + WS_VT);
#pragma unroll
    for (int i = 0; i < 8; ++i) {
        const int d = 8 * i + (lane >> 3), ch = lane & 7;
        const LAS unsigned* s = (const LAS unsigned*)(scr + d * 66 + 8 * ch);
        u32x4 o; o.x = s[0]; o.y = s[1]; o.z = s[2]; o.w = s[3];
        *(u32x4*)(VT + (((size_t)((b * 2 + kvh) * 128 + tb)) * 128 + db * 64 + d) * 64 + 8 * ch) = o;
    }
    LDS_WAIT(); asm volatile("" ::: "memory");
}

__device__ __forceinline__ void scan16x4(float& a0, float& a1, float& a2, float& a3, float& u0, float& u1, float& u2, float& u3) {
#define LRU_ST(N) \
    "v_fmac_f32_dpp %4, %4, %0 row_shr:" #N " row_mask:0xf bank_mask:0xf\n\t" "v_fmac_f32_dpp %5, %5, %1 row_shr:" #N " row_mask:0xf bank_mask:0xf\n\t" \
    "v_fmac_f32_dpp %6, %6, %2 row_shr:" #N " row_mask:0xf bank_mask:0xf\n\t" "v_fmac_f32_dpp %7, %7, %3 row_shr:" #N " row_mask:0xf bank_mask:0xf\n\t" \
    "v_mul_f32_dpp %0, %0, %0 row_shr:" #N " row_mask:0xf bank_mask:0xf\n\t" "v_mul_f32_dpp %1, %1, %1 row_shr:" #N " row_mask:0xf bank_mask:0xf\n\t" \
    "v_mul_f32_dpp %2, %2, %2 row_shr:" #N " row_mask:0xf bank_mask:0xf\n\t" "v_mul_f32_dpp %3, %3, %3 row_shr:" #N " row_mask:0xf bank_mask:0xf\n\t"
    asm volatile("s_nop 1\n\t" LRU_ST(1) LRU_ST(2) LRU_ST(4) LRU_ST(8) : "+v"(a0), "+v"(a1), "+v"(a2), "+v"(a3), "+v"(u0), "+v"(u1), "+v"(u2), "+v"(u3));
#undef LRU_ST
}
constexpr int LR_WA = 0, LR_WI = 34816, LR_PAR = 69632, LR_COMP = LR_PAR + 9 * 512;
__device__ __forceinline__ void lru_job(KP p, int l, int jb, LAS unsigned char* lds, int tid, int lane, int wave) {
    const int n = jb & 7, jj = jb >> 3, b = jj >> 4, tile0 = 4 * (jj & 15), tok = lane & 15, h = lane >> 4;
    const bf16* P = (const bf16*)(gws(p) + WS_R1);
    float* aggA = (float*)(gws(p) + WS_AGG); float* aggH = aggA + (size_t)BATCH * 64 * 1024;
    unsigned* LRS = (unsigned*)(gws(p) + WS_SCR);
    LAS float* par = (LAS float*)(lds + LR_PAR);
    LAS float* compA = (LAS float*)(lds + LR_COMP); LAS float* compH = compA + 1024;
    __syncthreads();
    {
        const bf16* waT = (const bf16*)(gws(p) + WS_WAT) + (size_t)n * 128 * 128; const bf16* wiT = (const bf16*)(gws(p) + WS_WIT) + (size_t)n * 128 * 128;
#pragma unroll
        for (int i = 0; i < 4; ++i) { const int ci = tid + 512 * i, r = ci >> 4, ch = ci & 15;
            *(LAS u32x4*)(lds + LR_WA + r * 272 + ch * 16) = *(const u32x4*)(waT + r * 128 + ch * 8);
            *(LAS u32x4*)(lds + LR_WI + r * 272 + ch * 16) = *(const u32x4*)(wiT + r * 128 + ch * 8); }
        if (tid < 128) { const int c = n * 128 + tid;
            par[tid] = -8.0f * LOG2E * log1pf(expf(-gin(p, I_LAM)[(size_t)l * 1024 + c]));
            par[128 + tid] = gin(p, I_BA)[(size_t)l * 1024 + c]; par[256 + tid] = gin(p, I_BI)[(size_t)l * 1024 + c]; par[384 + tid] = gin(p, I_CONVB)[(size_t)l * 1024 + c];
#pragma unroll
            for (int j = 0; j < 4; ++j) par[512 + 128 * j + tid] = gin(p, I_CONVW)[((size_t)l * 4 + j) * 1024 + c]; }
        __syncthreads();
    }
#pragma unroll 1
    for (int tt = 0; tt < 4; ++tt) {
        const int tile = tile0 + tt, t = tile * 128 + wave * 16 + tok; const size_t row = (size_t)b * SEQ + t;
        const int hofs = launder_v(4 * h);
        float xc[4][2][4]; bf16x8 xb[4];
#pragma unroll
        for (int ks = 0; ks < 4; ++ks) {
#pragma unroll
            for (int hf = 0; hf < 2; ++hf) {
                const int cl = 32 * ks + 16 * hf + hofs;
                f32x4 a = *(const LAS f32x4*)(par + 384 + cl);
#pragma unroll
                for (int j = 0; j < 4; ++j) {
                    if (t - 3 + j >= 0) {
                        const u32x2 xv = *(const u32x2*)(P + (row - 3 + j) * PLD + C_XL + n * 128 + cl);
                        const f32x4 cw = *(const LAS f32x4*)(par + 512 + 128 * j + cl);
                        a.x += cw.x * bflo(xv.x); a.y += cw.y * bfhi(xv.x); a.z += cw.z * bflo(xv.y); a.w += cw.w * bfhi(xv.y);
                    }
                }
                xc[ks][hf][0] = a.x; xc[ks][hf][1] = a.y; xc[ks][hf][2] = a.z; xc[ks][hf][3] = a.w;
            }
            u32x4 w; w.x = pk2(xc[ks][0][0], xc[ks][0][1]); w.y = pk2(xc[ks][0][2], xc[ks][0][3]); w.z = pk2(xc[ks][1][0], xc[ks][1][1]); w.w = pk2(xc[ks][1][2], xc[ks][1][3]);
            xb[ks] = __builtin_bit_cast(bf16x8, w);
        }
        float acum[8][4], hloc[8][4];
#pragma unroll
        for (int dt = 0; dt < 8; ++dt) {
            f32x4 acca = {0.f, 0.f, 0.f, 0.f}, acci = {0.f, 0.f, 0.f, 0.f};
            const LAS unsigned char* wa = lds + LR_WA + (16 * dt + tok) * 272 + 2 * hofs; const LAS unsigned char* wi = lds + LR_WI + (16 * dt + tok) * 272 + 2 * hofs;
#pragma unroll
            for (int ks = 0; ks < 4; ++ks) {
                const u32x2 a0 = *(const LAS u32x2*)(wa + 64 * ks), a1 = *(const LAS u32x2*)(wa + 64 * ks + 32);
                const u32x2 i0 = *(const LAS u32x2*)(wi + 64 * ks), i1 = *(const LAS u32x2*)(wi + 64 * ks + 32);
                const u32x4 fa = {a0.x, a0.y, a1.x, a1.y}, fi = {i0.x, i0.y, i1.x, i1.y};
                acca = mfma16(__builtin_bit_cast(bf16x8, fa), xb[ks], acca);
                acci = mfma16(__builtin_bit_cast(bf16x8, fi), xb[ks], acci);
            }
            const int cl0 = 16 * dt + hofs;
            const f32x4 vsp = *(const LAS f32x4*)(par + cl0), vba = *(const LAS f32x4*)(par + 128 + cl0), vbi = *(const LAS f32x4*)(par + 256 + cl0);
            float av[4], uv[4];
#pragma unroll
            for (int r = 0; r < 4; ++r) {
                const float rg = fsig(acca[r] + vba[r]), ig = fsig(acci[r] + vbi[r]);
                const float l2a = rg * vsp[r];
                const float a = __builtin_amdgcn_exp2f(l2a);
                const float x2 = 2.0f * 0.6931471805599453f * l2a;
                float om_s = -x2 * (1.0f + x2 * (0.5f + x2 * (0.16666667f + x2 * 0.041666668f))), om_l = 1.0f - a * a;
                asm volatile("" : "+v"(om_s), "+v"(om_l));
                const float om = (x2 > -0.06f) ? om_s : om_l;
                av[r] = a; uv[r] = __builtin_amdgcn_sqrtf(fmaxf(om, 0.f)) * (ig * xc[dt >> 1][dt & 1][r]);
            }
            scan16x4(av[0], av[1], av[2], av[3], uv[0], uv[1], uv[2], uv[3]);
#pragma unroll
            for (int r = 0; r < 4; ++r) { acum[dt][r] = av[r]; hloc[dt][r] = uv[r]; }
            if (tok == 15) { *(LAS f32x4*)(compA + wave * 128 + cl0) = (f32x4){av[0], av[1], av[2], av[3]}; *(LAS f32x4*)(compH + wave * 128 + cl0) = (f32x4){uv[0], uv[1], uv[2], uv[3]}; }
        }
        __syncthreads();
#pragma unroll
        for (int dt = 0; dt < 8; ++dt) {
            const int cl0 = 16 * dt + hofs;
            f32x4 cin = {0.f, 0.f, 0.f, 0.f}, pa = {1.f, 1.f, 1.f, 1.f};
            for (int w2 = 0; w2 < wave; ++w2) { const f32x4 ca = *(const LAS f32x4*)(compA + w2 * 128 + cl0), chh = *(const LAS f32x4*)(compH + w2 * 128 + cl0); cin = ca * cin + chh; pa = pa * ca; }
            f32x4 A, H;
#pragma unroll
            for (int r = 0; r < 4; ++r) { A[r] = acum[dt][r] * pa[r]; H[r] = acum[dt][r] * cin[r] + hloc[dt][r]; }
            *(u32x4*)(LRS + row * 1024 + n * 128 + cl0) = (u32x4){pkbf(A[0], H[0]), pkbf(A[1], H[1]), pkbf(A[2], H[2]), pkbf(A[3], H[3])};
            if (wave == 7 && tok == 15) { const size_t o = ((size_t)b * 64 + tile) * 1024 + n * 128 + cl0; *(f32x4*)(aggA + o) = A; *(f32x4*)(aggH + o) = H; }
        }
        __syncthreads();
    }
}
__device__ __forceinline__ void lru_apply_job(KP p, int jb, LAS unsigned char* lds, int tid, int lane_, int wave, bf16* OB, int old) {
    const int lane = launder_v(lane_);
    const int half = jb & 1, tile = (jb >> 1) & 63, b = jb >> 7;
    const float* aggA = (const float*)(gws(p) + WS_AGG); const float* aggH = aggA + (size_t)BATCH * 64 * 1024;
    const unsigned* LRS = (const unsigned*)(gws(p) + WS_SCR);
    const bf16* P = (const bf16*)(gws(p) + WS_R1);
    LAS float* carry = (LAS float*)lds;
    __syncthreads();
    {
        const float* pa = aggA + (size_t)b * 64 * 1024 + half * 512 + tid; const float* ph = aggH + (size_t)b * 64 * 1024 + half * 512 + tid;
        float C = 0.f;
        for (int i0 = 0; i0 < tile; i0 += 16) {
            float a[16], hh[16];
#pragma unroll
            for (int j = 0; j < 16; ++j) { const bool ok = i0 + j < tile; const int ic = ok ? i0 + j : 0; a[j] = pa[(size_t)ic * 1024]; hh[j] = ph[(size_t)ic * 1024]; if (!ok) { a[j] = 1.f; hh[j] = 0.f; } }
#pragma unroll
            for (int j = 0; j < 16; ++j) C = a[j] * C + hh[j];
        }
        carry[tid] = C;
    }
    __syncthreads();
    const f32x4 c0 = *(const LAS f32x4*)(carry + 8 * lane), c1 = *(const LAS f32x4*)(carry + 8 * lane + 4);
    const size_t row0 = (size_t)b * SEQ + tile * 128 + wave * 16; const int c = half * 512 + 8 * lane;
#pragma unroll 1
    for (int r0 = 0; r0 < 16; r0 += 4) {
        u32x4 s0[4], s1[4], gv[4];
#pragma unroll
        for (int i = 0; i < 4; ++i) { const size_t row = row0 + r0 + i; const u32x4* sp = (const u32x4*)(LRS + row * 1024 + c); s0[i] = sp[0]; s1[i] = sp[1]; gv[i] = *(const u32x4*)(P + row * PLD + C_GL + c); }
#pragma unroll
        for (int i = 0; i < 4; ++i) { const size_t row = row0 + r0 + i;
            float y[8];
#pragma unroll
            for (int k = 0; k < 4; ++k) { y[k] = bflo(s0[i][k]) * c0[k] + bfhi(s0[i][k]); y[4 + k] = bflo(s1[i][k]) * c1[k] + bfhi(s1[i][k]); }
            u32x4 w;
#pragma unroll
            for (int k = 0; k < 4; ++k) w[k] = pkbf(y[2 * k] * gelu_tanh(bflo(gv[i][k])), y[2 * k + 1] * gelu_tanh(bfhi(gv[i][k])));
            *(u32x4*)(OB + row * old + c) = w; }
    }
}

__device__ __forceinline__ void memattn_job(KP p, int jb, LAS unsigned char* lds, int tid, int lane_, int wave, bf16* OB, int old) {
    const int lane = launder_v(lane_);
    const int hd = jb & 3, b = (jb >> 2) & 1, j = jb >> 3, tok = lane & 15, h = lane >> 4;
    const bf16* P = (const bf16*)(gws(p) + WS_R1);
    const bf16* MK = (const bf16*)(gws(p) + WS_MK); const bf16* VTM = (const bf16*)(gws(p) + WS_VTM);
    __syncthreads();
#pragma unroll
    for (int i = 0; i < 16; ++i) { const int ci = tid + 512 * i, m = ci >> 5, c = ci & 31;
        *(LAS u32x4*)(lds + m * 512 + ((c ^ (m & 15)) << 4)) = *(const u32x4*)(MK + (size_t)(b * 256 + m) * 1024 + hd * 256 + c * 8); }
    const size_t row = (size_t)b * SEQ + j * 128 + wave * 16 + tok;
    bf16x8 qf[8];
#pragma unroll
    for (int ks = 0; ks < 8; ++ks) qf[ks] = *(const bf16x8*)(P + row * PLD + C_QM + hd * 256 + 32 * ks + 8 * h);
    unsigned ka[8];
#pragma unroll
    for (int ks = 0; ks < 8; ++ks) ka[ks] = (unsigned)launder_v(tok * 512 + (((4 * ks + h) ^ tok) << 4));
    __syncthreads();
    bf16x8 pf[8]; float inv;
    {
        f32x4 S[16];
#pragma unroll
        for (int mt = 0; mt < 16; ++mt) {
            f32x4 acc = {0.f, 0.f, 0.f, 0.f};
#pragma unroll
            for (int ks = 0; ks < 8; ++ks) acc = mfma16(*(const LAS bf16x8*)(lds + ka[ks] + mt * 8192), qf[ks], acc);
            S[mt] = acc;
        }
        float mx = -3.0e38f;
#pragma unroll
        for (int mt = 0; mt < 16; ++mt)
#pragma unroll
            for (int r = 0; r < 4; ++r) mx = fmaxf(mx, S[mt][r]);
        mx = fmaxf(mx, __shfl_xor(mx, 16)); mx = fmaxf(mx, __shfl_xor(mx, 32));
        const float sc = 0.0625f * LOG2E;
        float sum = 0.f;
#pragma unroll
        for (int mt = 0; mt < 16; ++mt)
#pragma unroll
            for (int r = 0; r < 4; ++r) { const float e = __builtin_amdgcn_exp2f((S[mt][r] - mx) * sc); S[mt][r] = e; sum += e; }
        sum += __shfl_xor(sum, 16); sum += __shfl_xor(sum, 32);
        inv = 1.0f / sum;
#pragma unroll
        for (int T = 0; T < 8; ++T) { u32x4 w; w.x = pk2(S[2 * T][0], S[2 * T][1]); w.y = pk2(S[2 * T][2], S[2 * T][3]); w.z = pk2(S[2 * T + 1][0], S[2 * T + 1][1]); w.w = pk2(S[2 * T + 1][2], S[2 * T + 1][3]);
            pf[T] = __builtin_bit_cast(bf16x8, w); }
    }
    __syncthreads();
#pragma unroll
    for (int i = 0; i < 16; ++i) { const int ci = tid + 512 * i, d = ci >> 5, c = ci & 31;
        *(LAS u32x4*)(lds + d * 512 + ((c ^ (d & 15)) << 4)) = *(const u32x4*)(VTM + (size_t)(hd * 256 + d) * 512 + b * 256 + c * 8); }
    unsigned va[8][2];
#pragma unroll
    for (int T = 0; T < 8; ++T) { va[T][0] = (unsigned)launder_v(tok * 512 + 8 * (h & 1) + (((4 * T + (h >> 1)) ^ tok) << 4)); va[T][1] = (unsigned)launder_v(tok * 512 + 8 * (h & 1) + (((4 * T + 2 + (h >> 1)) ^ tok) << 4)); }
    __syncthreads();
#pragma unroll
    for (int dt = 0; dt < 16; ++dt) {
        f32x4 acc = {0.f, 0.f, 0.f, 0.f};
#pragma unroll
        for (int T = 0; T < 8; ++T) { const u32x2 v0 = *(const LAS u32x2*)(lds + va[T][0] + dt * 8192), v1 = *(const LAS u32x2*)(lds + va[T][1] + dt * 8192); const u32x4 f = {v0.x, v0.y, v1.x, v1.y};
            acc = mfma16(__builtin_bit_cast(bf16x8, f), pf[T], acc); }
        u32x2 w; w.x = pk2(acc[0] * inv, acc[1] * inv); w.y = pk2(acc[2] * inv, acc[3] * inv);
        *(u32x2*)(OB + row * old + hd * 256 + 16 * dt + 4 * h) = w;
    }
}

struct KFr { bf16x8 a0, a1, b0, b1; };
__device__ __forceinline__ KFr idx_load(const bf16* kidx, size_t krow, int lane) {
    const bf16* kp = kidx + (krow + (lane & 15)) * 64 + (lane >> 4) * 8;
    KFr f; f.a0 = *(const bf16x8*)kp; f.a1 = *(const bf16x8*)(kp + 32); f.b0 = *(const bf16x8*)(kp + 16 * 64); f.b1 = *(const bf16x8*)(kp + 16 * 64 + 32); return f;
}
__device__ __forceinline__ f32x4 idx_score4(const bf16x8 k0, const bf16x8 k1, const bf16x8 (&qf)[4][2], const f32x4 w) {
    f32x4 s = {0.f, 0.f, 0.f, 0.f};
#pragma unroll
    for (int hd = 0; hd < 4; ++hd) {
        f32x4 d = {0.f, 0.f, 0.f, 0.f};
        d = mfma16(k0, qf[hd][0], d); d = mfma16(k1, qf[hd][1], d);
#pragma unroll
        for (int r = 0; r < 4; ++r) { const int di = __float_as_int(d[r]); s[r] = __builtin_fmaf(w[hd], __int_as_float(di > 0 ? di : 0), s[r]); }
    }
    return s;
}
__device__ __forceinline__ unsigned orderable(float s) { const unsigned u = __float_as_uint(s); return u ^ ((u >> 31) ? 0xFFFFFFFFu : 0x80000000u); }

template <int NE> __device__ __forceinline__ unsigned long long rank_select(const unsigned long long (&v)[NE], unsigned long long top12, int need) {
    unsigned long long prefix = top12 << 33;
    for (int bit = 32; bit >= 0; --bit) {
        const unsigned long long cand = prefix | (1ull << bit);
        int cnt = 0;
#pragma unroll
        for (int e = 0; e < NE; ++e) cnt += __popcll(__ballot(v[e] >= cand));
        if (cnt >= need) prefix = cand;
    }
    return prefix;
}

template <int sprobe> __device__ __forceinline__ void select_item(KP p, int b, int u, LAS unsigned char* lds, int tid, int lane, int wave) {
    LAS unsigned* hist = (LAS unsigned*)lds;
    LAS unsigned long long* lists = (LAS unsigned long long*)lds;
    LAS unsigned* mstage = (LAS unsigned*)(lds + 131072);
    LAS int* qinfo = (LAS int*)(lds + 147456);
    const bf16* P = (const bf16*)(gws(p) + WS_R1); const bf16* kidx = (const bf16*)(gws(p) + WS_KIDX);
    const int q0 = u * 16, nkeys = q0 + 16, ngrp = (nkeys + 31) >> 5, nw2 = (nkeys + 63) >> 6;
    for (int i = tid; i < 32768; i += 512) hist[i] = 0u;
    for (int i = tid; i < 4096; i += 512) mstage[i] = 0u;
    if (tid < 48) qinfo[tid] = 0;
    const int ql = lane & 15, h4 = lane >> 4, tq = q0 + ql;
    const size_t qrow = (size_t)b * SEQ + tq;
    bf16x8 qf[4][2];
#pragma unroll
    for (int hd = 0; hd < 4; ++hd)
#pragma unroll
        for (int ks = 0; ks < 2; ++ks) qf[hd][ks] = *(const bf16x8*)(P + qrow * PLD + C_QI + hd * 64 + ks * 32 + h4 * 8);
    const f32x4 w = *(const f32x4*)((const float*)(gws(p) + WS_WIDX) + qrow * 4);
    __syncthreads();
    {
        const size_t kr0 = (size_t)b * SEQ;
#define SEL_HADD(x) do { const unsigned u_ = __float_as_uint(x);   \
            (void)__hip_atomic_fetch_add((LAS unsigned*)((LAS unsigned char*)hist + hqb + (((u_ >> 19) + hrot) & 0x1FFCu)), 1u + ((u_ >> 20) & 1u) * 0xFFFFu, __ATOMIC_RELAXED, __HIP_MEMORY_SCOPE_WORKGROUP); } while (0)
#define SEL_BODY1(KF, gg) do { if ((gg) < ngrp) { if ((gg) * 32 + 31 <= q0) { \
            { const f32x4 sc = idx_score4(KF.a0, KF.a1, qf, w); _Pragma("unroll") for (int r = 0; r < 4; ++r) SEL_HADD(sc[r]); } \
            { const f32x4 sc = idx_score4(KF.b0, KF.b1, qf, w); _Pragma("unroll") for (int r = 0; r < 4; ++r) SEL_HADD(sc[r]); } } \
          else { _Pragma("unroll") for (int hf = 0; hf < 2; ++hf) { const int kb = (gg) * 32 + hf * 16; \
            if (kb < nkeys) { const f32x4 sc = hf ? idx_score4(KF.b0, KF.b1, qf, w) : idx_score4(KF.a0, KF.a1, qf, w); \
                _Pragma("unroll") for (int r = 0; r < 4; ++r) { const int key = kb + 4 * h4 + r; if (key <= tq) SEL_HADD(sc[r]); } } } } } } while (0)
#define SEL_LOAD(gg) idx_load(kidx, kr0 + 32 * ((gg) < ngrp ? (gg) : wave), lane)
        const unsigned hqb = (unsigned)ql * 8192u;
        const unsigned hrot = (unsigned)ql * 16u;
        KFr kA = SEL_LOAD(wave), kB = SEL_LOAD(wave + 8), kC;
        for (int g = wave; g < ngrp; g += 24) {
            kC = SEL_LOAD(g + 16); SEL_BODY1(kA, g);
            kA = SEL_LOAD(g + 24); SEL_BODY1(kB, g + 8);
            kB = SEL_LOAD(g + 32); SEL_BODY1(kC, g + 16);
        }
#undef SEL_BODY1
#undef SEL_HADD
    }
    __syncthreads();
    for (int qq = 0; qq < 2; ++qq) {
        const int q = 2 * wave + qq, total = q0 + q + 1;
        if (total <= 256) { if (lane == 0) { qinfo[q] = -1; qinfo[16 + q] = 0; } continue; }
        LAS unsigned* hq = hist + q * 2048;
        const int wb = lane < 32 ? 992 - 32 * lane : 32 * lane;
        int s = 0;
#pragma unroll 8
        for (int i = 0; i < 32; ++i) { const unsigned wv = hq[(wb + ((i + lane) & 31) + 4 * q) & 2047]; s += (int)(wv & 0xffffu) + (int)(wv >> 16); }
        int pre = s;
#pragma unroll
        for (int off = 1; off < 64; off <<= 1) { const int t = __shfl_up(pre, off); if (lane >= off) pre += t; }
        const unsigned long long ball = __ballot(pre >= 256);
        const int L = __ffsll((long long)ball) - 1;
        const int above = (L > 0) ? __shfl(pre, L - 1) : 0;
        const int wbL = L < 32 ? 992 - 32 * L : 32 * L;
        const int wj = L < 32 ? wbL + 31 - (lane >> 1) : wbL + (lane >> 1), hj = L < 32 ? 1 - (lane & 1) : (lane & 1);
        const unsigned wv = hq[(wj + 4 * q) & 2047];
        const int c = hj ? (int)(wv >> 16) : (int)(wv & 0xffffu);
        int pre2 = c;
#pragma unroll
        for (int off = 1; off < 64; off <<= 1) { const int t = __shfl_up(pre2, off); if (lane >= off) pre2 += t; }
        pre2 += above;
        const unsigned long long ball2 = __ballot(pre2 >= 256);
        const int is = __ffsll((long long)ball2) - 1;
        const int nab = __shfl(pre2, is) - __shfl(c, is);
        const int b1raw = __shfl(2 * wj + hj, is);
        if (lane == 0) { qinfo[q] = b1raw; qinfo[16 + q] = nab; }
    }
    __syncthreads();
    const int b1q = qinfo[ql];
    {
        const size_t kr0 = (size_t)b * SEQ;
        struct Pend { int pos; unsigned flags; int gg; unsigned ub[8]; };
#define SEL_FLUSH(PD) do { if ((PD).flags) { _Pragma("unroll") for (int k = 0; k < 8; ++k) if (((PD).flags >> k) & 1u) { \
            const int idx = (PD).pos + __popc((PD).flags & ((1u << k) - 1u)), key = (PD).gg * 32 + (k >> 2) * 16 + 4 * h4 + (k & 3); \
            if (idx < 1024) lists[ql * 1024 + idx] = ((unsigned long long)orderable(__uint_as_float((PD).ub[k])) << 13) | (unsigned long long)(8191 - key); } } } while (0)
#define SEL_EL2(x, K, OK) do { const float x_ = (x); (PN_).ub[K] = __float_as_uint(x_); const bool gt = x_ > hiF, ge = x_ >= loF; \
            bits |= ((OK) && gt) ? (1u << (((K) >> 2) * 16 + 4 * h4 + ((K) & 3))) : 0u; (PN_).flags |= ((OK) && ge && !gt) ? (1u << (K)) : 0u; } while (0)
#define SEL_BODY2(KF, gg_, PN, PO) do { (PN).flags = 0u; (PN).gg = (gg_); (PN).pos = 0; if ((gg_) < ngrp) { unsigned bits = 0u; auto& PN_ = (PN); \
            if ((gg_) * 32 + 31 <= q0) { \
                { const f32x4 sc = idx_score4(KF.a0, KF.a1, qf, w); _Pragma("unroll") for (int r = 0; r < 4; ++r) SEL_EL2(sc[r], r, true); } \
                { const f32x4 sc = idx_score4(KF.b0, KF.b1, qf, w); _Pragma("unroll") for (int r = 0; r < 4; ++r) SEL_EL2(sc[r], 4 + r, true); } } \
            else { _Pragma("unroll") for (int hf = 0; hf < 2; ++hf) { const int kb = (gg_) * 32 + hf * 16; \
                if (kb < nkeys) { const f32x4 sc = hf ? idx_score4(KF.b0, KF.b1, qf, w) : idx_score4(KF.a0, KF.a1, qf, w); \
                    _Pragma("unroll") for (int r = 0; r < 4; ++r) { const int key = kb + 4 * h4 + r; SEL_EL2(sc[r], hf * 4 + r, key <= tq); } } } } \
            if ((PN).flags) (PN).pos = __hip_atomic_fetch_add(&qinfo[32 + ql], __popc((PN).flags), __ATOMIC_RELAXED, __HIP_MEMORY_SCOPE_WORKGROUP); \
            bits = xor16_or(bits); bits = xor32_or(bits); if (h4 == 0) mstage[ql * 256 + (gg_)] = bits; } \
            SEL_FLUSH(PO); } while (0)
        const unsigned e0 = (unsigned)b1q << 20, e1 = e0 | 0xFFFFFu;
        const float hiF = b1q < 0 ? -__builtin_inff() : (b1q < 2048 ? __uint_as_float(e1) : __uint_as_float(e0 | (b1q == 2048 ? 1u : 0u)));
        const float loF = b1q < 0 ? -__builtin_inff() : (b1q < 2048 ? __uint_as_float(e0) : __uint_as_float(e1));
        Pend pA, pB, pC; pC.flags = 0u; pC.pos = 0; pC.gg = 0;
#pragma unroll
        for (int k = 0; k < 8; ++k) pC.ub[k] = 0u;
        KFr kA = SEL_LOAD(wave), kB = SEL_LOAD(wave + 8), kC;
        for (int g = wave; g < ngrp; g += 24) {
            kC = SEL_LOAD(g + 16); SEL_BODY2(kA, g, pA, pC);
            kA = SEL_LOAD(g + 24); SEL_BODY2(kB, g + 8, pB, pA);
            kB = SEL_LOAD(g + 32); SEL_BODY2(kC, g + 16, pC, pB);
        }
        SEL_FLUSH(pC);
#undef SEL_FLUSH
#undef SEL_BODY2
#undef SEL_EL2
#undef SEL_LOAD
    }
    __syncthreads();
    for (int qq = 0; qq < 2; ++qq) {
        const int q = 2 * wave + qq, b1 = qinfo[q];
        if (b1 < 0) continue;
        int n = qinfo[32 + q]; n = n > 1024 ? 1024 : n;
        const int need = 256 - qinfo[16 + q];
        const unsigned long long top12 = (unsigned long long)(b1 < 2048 ? (b1 | 2048) : (b1 ^ 4095));
        const LAS unsigned long long* Lq = lists + q * 1024;
        unsigned long long thr;
        if (n <= 64) { unsigned long long v[1]; v[0] = lane < n ? Lq[lane] : 0ull; thr = rank_select<1>(v, top12, need); }
        else if (n <= 256) { unsigned long long v[4];
#pragma unroll
            for (int e = 0; e < 4; ++e) v[e] = (lane + 64 * e) < n ? Lq[lane + 64 * e] : 0ull;
            thr = rank_select<4>(v, top12, need); }
        else { unsigned long long v[16];
#pragma unroll
            for (int e = 0; e < 16; ++e) v[e] = (lane + 64 * e) < n ? Lq[lane + 64 * e] : 0ull;
            thr = rank_select<16>(v, top12, need); }
        for (int e = lane; e < n; e += 64) { const unsigned long long v = Lq[e]; if (v >= thr) { const int key = 8191 - (int)(v & 8191ull); (void)__hip_atomic_fetch_or(&mstage[q * 256 + (key >> 5)], 1u << (key & 31), __ATOMIC_RELAXED, __HIP_MEMORY_SCOPE_WORKGROUP); } }
    }
    __syncthreads();
    unsigned* mask = (unsigned*)(gws(p) + WS_MASK);
    for (int i = tid; i < 16 * nw2; i += 512) { const int q = i / nw2, wp = i - q * nw2; *(u32x2*)(mask + ((size_t)b * SEQ + q0 + q) * 256 + 2 * wp) = *(const LAS u32x2*)(mstage + q * 256 + 2 * wp); }
    __syncthreads();
}

__device__ __forceinline__ float bfi_sel(int sel, float x) { float r; asm("v_bfi_b32 %0, %1, %2, %3" : "=v"(r) : "v"(sel), "v"(x), "v"(0xff800000u)); return r; }
constexpr int AT_K = 0, AT_VT = 16384, AT_BUF = 32768, AT_BIAS = 3 * AT_BUF;
__device__ __forceinline__ void attn_bias_table(KP p, LAS unsigned char* lds, int tid) {
    LAS float* bt = (LAS float*)(lds + AT_BIAS);
    for (int i = tid; i < 1024; i += 512) {
        const int hd = i >> 7, dd = i & 127;
        int bk = dd;
        if (dd >= 16) { bk = 16 + (dd >= 19) + (dd >= 21) + (dd >= 24) + (dd >= 27) + (dd >= 31) + (dd >= 35) + (dd >= 40) + (dd >= 46) + (dd >= 52) + (dd >= 59) + (dd >= 67) + (dd >= 77) + (dd >= 87) + (dd >= 99) + (dd >= 113); }
        bt[i] = gin(p, I_RELB)[bk * 8 + hd] * LOG2E;
    }
}
template <int probe> __device__ __forceinline__ void attn_item(KP p, int b, int kvh, int qt, LAS unsigned char* lds, int lane_, int wave, bf16* OB, int old) {
    const int lane = launder_v(lane_);
    const bf16* P = (const bf16*)(gws(p) + WS_R1); const bf16* VT = (const bf16*)(gws(p) + WS_VT); const unsigned* mask = (const unsigned*)(gws(p) + WS_MASK);
    const int head = kvh * 4 + (wave & 3), q0 = qt * 64 + 32 * (wave >> 2), nkt = (probe == 1) ? 1 : qt + 1, ql = lane & 31, hi = lane >> 5, tq = q0 + ql;
    const size_t row = (size_t)b * SEQ + tq;
    bf16x8 qf[8];
#pragma unroll
    for (int ks = 0; ks < 8; ++ks) qf[ks] = *(const bf16x8*)(P + row * PLD + C_QA + head * 128 + 16 * ks + 8 * hi);
    f32x16 O[4];
#pragma unroll
    for (int dt = 0; dt < 4; ++dt)
#pragma unroll
        for (int r = 0; r < 16; ++r) O[dt][r] = 0.f;
    float mrun = -1.0e4f, lrun = 0.f;
    const float c1 = 0.08838834764831845f * LOG2E;
    const LAS float* btab = (const LAS float*)(lds + AT_BIAS) + head * 128;
    const float bfar = btab[127];
    const bf16* kbase = P + (size_t)b * SEQ * PLD + C_KA + kvh * 128; const bf16* vbase = VT + (size_t)(b * 2 + kvh) * 128 * SEQ; const unsigned* mrow = mask + row * 256;
    unsigned koff[2], voff[2];
#pragma unroll
    for (int i = 0; i < 2; ++i) {
        const int pos = 1024 * (wave + 8 * i) + 16 * lane;
        const int key = pos >> 8, kc = ((pos >> 4) & 15) ^ (key & 15);
        koff[i] = (unsigned)(key * PLD + kc * 8);
        const int d = pos >> 7, vc = ((pos >> 4) & 7) ^ ((d >> 1) & 7);
        voff[i] = (unsigned)(d * 64 + vc * 8);
    }
#define AT_DMA(kt, st) do { _Pragma("unroll") for (int i = 0; i < 2; ++i) { \
        __builtin_amdgcn_global_load_lds((const unsigned*)(kbase + (size_t)(kt) * 64 * PLD + koff[i]), (LAS unsigned*)(lds + (st) * AT_BUF + AT_K + 1024 * (wave + 8 * i)), 16, 0, 0); \
        __builtin_amdgcn_global_load_lds((const unsigned*)(vbase + (size_t)(kt) * 8192 + voff[i]), (LAS unsigned*)(lds + (st) * AT_BUF + AT_VT + 1024 * (wave + 8 * i)), 16, 0, 0); } } while (0)
    const int piq = (ql & 16) | ((ql & 4) << 1) | ((ql & 8) >> 1) | (ql & 3);
    unsigned ksw[8], vsw[4];
#pragma unroll
    for (int ks = 0; ks < 8; ++ks) ksw[ks] = (probe == 5) ? (unsigned)launder_v(lane * 16 + ks * 1024) : (unsigned)launder_v(piq * 256 + (((2 * ks + hi) ^ (piq & 15)) << 4));
#pragma unroll
    for (int s = 0; s < 4; ++s) vsw[s] = (probe == 5) ? (unsigned)launder_v(lane * 16 + s * 1024) : (unsigned)launder_v(ql * 128 + (((2 * s + hi) ^ ((ql >> 1) & 7)) << 4));
    const bool grpB = wave >= 4;
    AT_DMA(0, 0);
    u32x2 mw = *(const u32x2*)(mrow);
    bf16x8 pf[4];
#pragma unroll
    for (int s = 0; s < 4; ++s) pf[s] = (bf16x8){0, 0, 0, 0, 0, 0, 0, 0};
#define AT_PV(vb_) do { bf16x8 vf[2][4], vg[2][4]; \
        _Pragma("unroll") for (int dt = 0; dt < 2; ++dt) _Pragma("unroll") for (int s = 0; s < 4; ++s) vf[dt][s] = (probe == 7) ? qf[s + 4 * dt] : *(const LAS bf16x8*)((vb_) + vsw[s] + dt * 4096); \
        __builtin_amdgcn_sched_barrier(0); \
        _Pragma("unroll") for (int dt = 0; dt < 2; ++dt) _Pragma("unroll") for (int s = 0; s < 4; ++s) vg[dt][s] = (probe == 7) ? qf[s + 4 * dt] : *(const LAS bf16x8*)((vb_) + vsw[s] + (dt + 2) * 4096); \
        _Pragma("unroll") for (int dt = 0; dt < 2; ++dt) _Pragma("unroll") for (int s = 0; s < 4; ++s) { if (probe != 4 && probe < 6) O[dt] = mfma32(vf[dt][s], pf[s], O[dt]); else if (probe >= 6) O[dt][s] += __builtin_bit_cast(float, vf[dt][s][0] | (vf[dt][s][1] << 16)); } \
        __builtin_amdgcn_sched_barrier(0); \
        _Pragma("unroll") for (int dt = 0; dt < 2; ++dt) _Pragma("unroll") for (int s = 0; s < 4; ++s) { if (probe != 4 && probe < 6) O[dt + 2] = mfma32(vg[dt][s], pf[s], O[dt + 2]); else if (probe >= 6) O[dt + 2][s] += __builtin_bit_cast(float, vg[dt][s][0] | (vg[dt][s][1] << 16)); } } while (0)
    int st = 0, stp = 2;
    for (int kt = 0; kt < nkt; ++kt) {
        asm volatile("s_waitcnt vmcnt(0)" ::: "memory");
        __builtin_amdgcn_s_barrier();
        asm volatile("" ::: "memory");
        const u32x2 mcur = mw;
        const int stn = st == 2 ? 0 : st + 1;
        if (kt + 1 < nkt && probe != 2) { AT_DMA(kt + 1, stn); mw = *(const u32x2*)(mrow + 2 * (kt + 1)); }
        if (grpB && kt > 0) AT_PV(lds + stp * AT_BUF + AT_VT);
        const LAS unsigned char* kb = lds + st * AT_BUF + AT_K;
        f32x16 S[2];
        {
            bf16x8 kf[2][8];
#pragma unroll
            for (int hh = 0; hh < 2; ++hh)
#pragma unroll
                for (int ks = 0; ks < 8; ++ks) kf[hh][ks] = (probe == 7) ? qf[ks] : *(const LAS bf16x8*)(kb + ksw[ks] + hh * 8192);
            __builtin_amdgcn_sched_barrier(0);
#pragma unroll
            for (int hh = 0; hh < 2; ++hh) {
#pragma unroll
                for (int r = 0; r < 16; ++r) S[hh][r] = 0.f;
#pragma unroll
                for (int ks = 0; ks < 8; ++ks) { if (probe != 4 && probe < 6) S[hh] = mfma32(kf[hh][ks], qf[ks], S[hh]); else if (probe >= 6) S[hh][ks] += __builtin_bit_cast(float, kf[hh][ks][0] | (kf[hh][ks][1] << 16)); }
            }
        }
        const bool farr = (q0 - (64 * kt + 63)) >= 113;
        float mt = -INFINITY;
        if (farr) {
            const float boff = bfar - mrun;
#pragma unroll
            for (int hh = 0; hh < 2; ++hh) {
                const unsigned wbits = (hh ? mcur.y : mcur.x) >> (8 * hi);
#pragma unroll
                for (int r = 0; r < 16; ++r) {
                    const int kk = 16 * (r >> 3) + 4 * ((r >> 2) & 1) + (r & 3);
                    const float x = __builtin_fmaf(S[hh][r], c1, boff);
                    const int sel = __builtin_amdgcn_sbfe((int)wbits, kk, 1);
                    const float xm = bfi_sel(sel, x);
                    S[hh][r] = xm; mt = fmaxf(mt, xm);
                }
            }
        } else {
#pragma unroll
            for (int hh = 0; hh < 2; ++hh) {
                const unsigned wbits = (hh ? mcur.y : mcur.x) >> (8 * hi);
                const int dbase = tq - (64 * kt + 32 * hh + 8 * hi);
#pragma unroll
                for (int r = 0; r < 16; ++r) {
                    const int kk = 16 * (r >> 3) + 4 * ((r >> 2) & 1) + (r & 3);
                    int dist = dbase - kk; dist = dist < 0 ? 0 : (dist > 127 ? 127 : dist);
                    const float x = __builtin_fmaf(S[hh][r], c1, btab[dist] - mrun);
                    const int sel = __builtin_amdgcn_sbfe((int)wbits, kk, 1);
                    const float xm = bfi_sel(sel, x);
                    S[hh][r] = xm; mt = fmaxf(mt, xm);
                }
            }
        }
        mt = xmax32(mt);
        float alpha = 1.0f;
        if (!__all(mt <= 8.0f)) {
            const float dm = fmaxf(mt, 0.f); alpha = __builtin_amdgcn_exp2f(-dm); mrun += dm;
#pragma unroll
            for (int dt = 0; dt < 4; ++dt)
#pragma unroll
                for (int r = 0; r < 16; ++r) O[dt][r] *= alpha;
#pragma unroll
            for (int hh = 0; hh < 2; ++hh)
#pragma unroll
                for (int r = 0; r < 16; ++r) S[hh][r] -= dm;
        }
        float ps = 0.f;
#pragma unroll
        for (int hh = 0; hh < 2; ++hh)
#pragma unroll
            for (int r = 0; r < 16; ++r) { const float e = __builtin_amdgcn_exp2f(S[hh][r]); S[hh][r] = e; ps += e; }
        lrun = lrun * alpha + ps;
#pragma unroll
        for (int s = 0; s < 4; ++s) { const int hh = s >> 1, r0 = 8 * (s & 1);
            u32x4 wv; wv.x = pkbf(S[hh][r0 + 0], S[hh][r0 + 1]); wv.y = pkbf(S[hh][r0 + 2], S[hh][r0 + 3]); wv.z = pkbf(S[hh][r0 + 4], S[hh][r0 + 5]); wv.w = pkbf(S[hh][r0 + 6], S[hh][r0 + 7]);
            pf[s] = __builtin_bit_cast(bf16x8, wv); }
        if (!grpB) AT_PV(lds + st * AT_BUF + AT_VT);
        stp = st; st = stn;
    }
    if (grpB) AT_PV(lds + stp * AT_BUF + AT_VT);
#undef AT_PV
#undef AT_DMA
    const float ltot = xadd32(lrun);
    const float inv = 1.0f / ltot;
#pragma unroll
    for (int dt = 0; dt < 4; ++dt)
#pragma unroll
        for (int g = 0; g < 4; ++g) {
            u32x2 wv; wv.x = pkbf(O[dt][4 * g + 0] * inv, O[dt][4 * g + 1] * inv); wv.y = pkbf(O[dt][4 * g + 2] * inv, O[dt][4 * g + 3] * inv);
            *(u32x2*)(OB + row * old + head * 128 + 32 * dt + 8 * g + 4 * hi) = wv;
        }
    asm volatile("s_waitcnt vmcnt(0)" ::: "memory");
    __builtin_amdgcn_s_barrier();
    asm volatile("" ::: "memory");
}

#ifndef SKIP_MIXER
#define SKIP_MIXER 0
#endif
#ifndef PROBE_MIX
#define PROBE_MIX 0
#endif
#ifndef PROBE_CVT
#define PROBE_CVT 0
#endif
#ifndef ZERO_BRANCH
#define ZERO_BRANCH 0
#endif
__device__ __forceinline__ void zero_cols(bf16* P, int col0, int gw, int NGW, int lane) {
    for (int m = gw; m < M; m += NGW) { u32x4* o = (u32x4*)(P + (size_t)m * PLD + col0) + lane; o[0] = (u32x4){0u, 0u, 0u, 0u}; o[64] = (u32x4){0u, 0u, 0u, 0u}; }
}
__global__ void __launch_bounds__(512, 2) fwd(Params pdummy) {
    extern __shared__ __attribute__((aligned(16))) unsigned char lds_raw[];
    LAS unsigned char* lds = (LAS unsigned char*)lds_raw;
    const int wave0 = __builtin_amdgcn_readfirstlane(threadIdx.x >> 6);
    const int G = gridDim.x, bx = blockIdx.x;
    const int vcu = (G % 8 == 0) ? (bx % 8) * (G / 8) + bx / 8 : bx;
    const int NGW = G * 8;
    if (threadIdx.x < 64) ((LAS unsigned*)(lds + MISC_OFF))[threadIdx.x] = 0u;
    __syncthreads();
    XcdBarrier bar = xcd_barrier_post((unsigned*)(gws(kargs()) + WS_CTL) + CW_BAR, (volatile LAS unsigned*)(lds + MISC_OFF + 32));
#define GRID_BAR() xcd_barrier(bar)
#define PH_BEGIN const int lane = lane_id_asm(), wave = wave0, tid = wave * 64 + lane, gw = vcu * 8 + wave, bxl = launder_s(bx); KP p = kargs(); (void)bxl; unsigned char* ws = gws(p); (void)lane; (void)gw; (void)ws;

    for (int l = 0; l < DEPTH; ++l) {
        for (int rep = (PROBE_CVT & 1) ? 0 : 1; rep < 2; ++rep) { PH_BEGIN phase_cvt(p, l, lds, vcu, G, gw, NGW, wave, lane); }
        for (int f = 0; f < 2; ++f) {
            if (f == 1 && !SKIP_MIXER) {
                for (int rep = (PROBE_CVT & 1) ? 0 : 1; rep < 2; ++rep) { PH_BEGIN float* X = gout(p); bf16* XN = (bf16*)(ws + WS_XN);
                  rms_rows_bf16(X, gin(p, I_NMIX) + (size_t)l * DM, XN, gw, NGW, lane); }
                GRID_BAR();
                for (int rep = (PROBE_CVT & 4) ? 0 : 1; rep < 2; ++rep)
                { PH_BEGIN
                    pg8::Gemm g{(const bf16*)(ws + WS_XN), (const bf16*)(ws + WS_WIN), M, DIN_PAD, DM, DM, DM}; pg8::StaticOrder S; S.init(M, DIN_PAD, G, bxl);
                    pg8::EpiProj E{(bf16*)(ws + WS_R1), PLD, (float*)(ws + WS_SIDE)};
                    pg8::gemm_phase<pg8::EpiProj, pg8::StaticOrder, true, true>(lds, g, S, E, tid);
                }
                GRID_BAR();
                for (int rep = (PROBE_MIX & 16) ? 0 : 1; rep < 2; ++rep) {
                { PH_BEGIN
                    for (int gt = vcu * 512 + tid; gt < 4 * M; gt += G * 512) kidx_ln_quarter(p, l, gt);
                    for (int it = gw; it < 1024; it += NGW) vt_item(p, it, lds + 8192 + wave * 16384, lane);
                } }
                for (int rep = (PROBE_MIX & 32) ? 0 : 1; rep < 2; ++rep)
                { PH_BEGIN for (int it = vcu; it < 256; it += G) lru_job(p, l, it, lds, tid, lane, wave); }
                for (int rep = (PROBE_MIX & 64) ? 0 : 1; rep < 2; ++rep)
                { PH_BEGIN bf16* OB = rep ? (bf16*)(ws + WS_R1) + C_QM : (bf16*)(ws + WS_SCR); const int old = rep ? PLD : 1024;
                    if (!(ZERO_BRANCH & 4)) { for (int it = vcu; it < 512; it += G) memattn_job(p, it, lds, tid, lane, wave, OB, old); __syncthreads(); } else zero_cols((bf16*)(ws + WS_R1), C_QM, gw, NGW, lane);
                }
                GRID_BAR();
                for (int rep = (PROBE_MIX & 6) ? 0 : 1; rep < 2; ++rep) {
                { PH_BEGIN
                    if (!(ZERO_BRANCH & 1) && (rep || (PROBE_MIX & 2))) for (int pi = vcu; pi < 512; pi += G) { const int b = pi >> 8, j = pi & 255;
#pragma unroll 1
                        for (int k = 0; k < 2; ++k) { if ((PROBE_MIX >> 12) && rep == 0) select_item<(PROBE_MIX >> 12)>(p, b, k ? 511 - j : j, lds, tid, lane, wave); else select_item<0>(p, b, k ? 511 - j : j, lds, tid, lane, wave); } }
                    __syncthreads();
                }
                { PH_BEGIN bf16* OB = rep ? (bf16*)(ws + WS_R1) + C_GL : (bf16*)(ws + WS_SCR); const int old = rep ? PLD : 1024;
                    if (!(ZERO_BRANCH & 2) && (rep || (PROBE_MIX & 4))) { for (int it = vcu; it < 256; it += G) lru_apply_job(p, it, lds, tid, lane, wave, OB, old); } else if (ZERO_BRANCH & 2) zero_cols((bf16*)(ws + WS_R1), C_GL, gw, NGW, lane);
                }
                }
                GRID_BAR();
                for (int rep = (PROBE_MIX & 8) ? 0 : 1; rep < 2; ++rep) {
                { PH_BEGIN bf16* OB = rep ? (bf16*)(ws + WS_R1) + C_QA : (bf16*)(ws + WS_SCR); const int old = rep ? PLD : 1024;
                    if (!(ZERO_BRANCH & 1)) {
                        attn_bias_table(p, lds, tid);
                        __syncthreads();
                        for (int pi = vcu; pi < 256; pi += G) { const int bk = pi >> 6, j = pi & 63;
#pragma unroll 1
                            for (int k = 0; k < 2; ++k) { if ((PROBE_MIX >> 8) && rep == 0) attn_item<(PROBE_MIX >> 8)>(p, bk >> 1, bk & 1, k ? 127 - j : j, lds, lane, wave, OB, old); else attn_item<0>(p, bk >> 1, bk & 1, k ? 127 - j : j, lds, lane, wave, OB, old); } }
                    } else zero_cols((bf16*)(ws + WS_R1), C_QA, gw, NGW, lane);
                }
                }
                GRID_BAR();
                for (int rep = (PROBE_CVT & 16) ? 0 : 1; rep < 2; ++rep) {
                { PH_BEGIN bf16* R1 = (bf16*)(ws + WS_R1); const bf16* WBR = (const bf16*)(ws + WS_WBR); pg8::StaticOrder S; S.init(M, DM, G, bxl);
                  pg8::Gemm g{R1 + C_QA, WBR, M, DM, 1024, PLD, 1024}; pg8::EpiBf16 E{(bf16*)(ws + WS_SCR), DM}; pg8::gemm_phase<pg8::EpiBf16, pg8::StaticOrder, true, true>(lds, g, S, E, tid); }
                { PH_BEGIN bf16* R1 = (bf16*)(ws + WS_R1); const bf16* WBR = (const bf16*)(ws + WS_WBR); pg8::StaticOrder S; S.init(M, DM, G, bxl);
                  pg8::Gemm g{R1 + C_GL, WBR + (size_t)DM * 1024, M, DM, 1024, PLD, 1024}; pg8::EpiBf16 E{(bf16*)(ws + WS_SCR) + (size_t)M * DM, DM}; pg8::gemm_phase<pg8::EpiBf16, pg8::StaticOrder, true, true>(lds, g, S, E, tid); }
                { PH_BEGIN bf16* R1 = (bf16*)(ws + WS_R1); const bf16* WBR = (const bf16*)(ws + WS_WBR); pg8::StaticOrder S; S.init(M, DM, G, bxl);
                  pg8::Gemm g{R1 + C_QM, WBR + (size_t)2 * DM * 1024, M, DM, 1024, PLD, 1024}; pg8::EpiMerge E{R1 + C_GT, PLD, (const bf16*)(ws + WS_SCR), (const bf16*)(ws + WS_SCR) + (size_t)M * DM, (bf16*)(ws + WS_XN), DM}; pg8::gemm_phase<pg8::EpiMerge, pg8::StaticOrder, true, true>(lds, g, S, E, tid); }
                }
                GRID_BAR();
                { PH_BEGIN
                    pg8::Gemm g{(const bf16*)(ws + WS_XN), (const bf16*)(ws + WS_WOUT), M, DM, DM, DM, DM}; pg8::StaticOrder S; S.init(M, DM, G, bxl);
                    pg8::EpiResid E{gout(p), gout(p), DM, 1.0f};
                    pg8::gemm_phase<pg8::EpiResid, pg8::StaticOrder, true, true>(lds, g, S, E, tid);
                }
                GRID_BAR();
            }
            for (int rep = (PROBE_CVT & 1) ? 0 : 1; rep < 2; ++rep) { PH_BEGIN const float* xsrc = (l == 0 && f == 0) ? gin(p, I_X) : gout(p); bf16* XN = (bf16*)(ws + WS_XN);
              rms_rows_bf16(xsrc, gin(p, f ? I_NFF2 : I_NFF1) + (size_t)l * DM, XN, gw, NGW, lane); }
            GRID_BAR();
            if (f == 0) {
                { PH_BEGIN const bf16* WM = (const bf16*)(ws + WS_WMKV); const bf16* MN = (const bf16*)(ws + WS_MEMN);
                  pg8::Gemm g{MN, WM, BATCH * NMEM, 1024, DM, DM, DM}; pg8::SimpleOrder S; S.init(BATCH * NMEM, 1024, G, bxl - 192); pg8::EpiBf16 E{(bf16*)(ws + WS_MK), 1024}; pg8::gemm_phase<pg8::EpiBf16, pg8::SimpleOrder, true, true>(lds, g, S, E, tid); }
                { PH_BEGIN const bf16* WM = (const bf16*)(ws + WS_WMKV); const bf16* MN = (const bf16*)(ws + WS_MEMN);
                  pg8::Gemm g{WM + (size_t)1024 * DM, MN, 1024, BATCH * NMEM, DM, DM, DM}; pg8::SimpleOrder S; S.init(1024, BATCH * NMEM, G, bxl - 200); pg8::EpiBf16 E{(bf16*)(ws + WS_VTM), BATCH * NMEM}; pg8::gemm_phase<pg8::EpiBf16, pg8::SimpleOrder, true, true>(lds, g, S, E, tid); }
            }
            for (int rep = (PROBE_CVT & 2) ? 0 : 1; rep < 2; ++rep)
            { PH_BEGIN
                pg8::Gemm g{(const bf16*)(ws + WS_XN), (const bf16*)(ws + (f ? WS_WGU2 : WS_WGU)), M, 2 * DFF, DM, DM, DM}; pg8::StaticOrder S; S.init(M, 2 * DFF, G, bxl);
                pg8::EpiSwiglu E{(bf16*)(ws + WS_R1), DFF};
                pg8::gemm_phase<pg8::EpiSwiglu, pg8::StaticOrder, true, true>(lds, g, S, E, tid);
            }
            GRID_BAR();
            for (int rep = (PROBE_CVT & 8) ? 0 : 1; rep < 2; ++rep)
            { PH_BEGIN
                const float* xsrc = (l == 0 && f == 0) ? gin(p, I_X) : gout(p);
                pg8::Gemm g{(const bf16*)(ws + WS_R1), (const bf16*)(ws + (f ? WS_WDN2 : WS_WDN)), M, DM, DFF, DFF, DFF}; pg8::StaticOrder S; S.init(M, DM, G, bxl);
                pg8::EpiResid E{xsrc, rep ? gout(p) : (float*)(ws + WS_SCR), DM, 0.5f};
                pg8::gemm_phase<pg8::EpiResid, pg8::StaticOrder, true, true>(lds, g, S, E, tid);
            }
            GRID_BAR();
        }
    }
    { PH_BEGIN float* X = gout(p); const f32x4* gr = (const f32x4*)gin(p, I_FNORM) + lane;
      f32x4 gg[8];
#pragma unroll
      for (int j = 0; j < 8; ++j) gg[j] = gr[64 * j];
      for (int m = gw; m < M; m += 4 * NGW) {
          f32x4 v[4][8]; float ss[4];
#pragma unroll
          for (int r = 0; r < 4; ++r) { const int mr = (m + r * NGW < M) ? m + r * NGW : m; const f32x4* xr = (const f32x4*)(X + (size_t)mr * DM) + lane;
#pragma unroll
              for (int j = 0; j < 8; ++j) v[r][j] = xr[64 * j]; }
#pragma unroll
          for (int r = 0; r < 4; ++r) { float sq = 0.f;
#pragma unroll
              for (int j = 0; j < 8; ++j) sq += (v[r][j].x * v[r][j].x + v[r][j].y * v[r][j].y) + (v[r][j].z * v[r][j].z + v[r][j].w * v[r][j].w);
              ss[r] = 1.0f / sqrtf(wave_sum(sq) * (1.0f / DM) + EPS); }
#pragma unroll
          for (int r = 0; r < 4; ++r) if (m + r * NGW < M) { f32x4* o = (f32x4*)(X + (size_t)(m + r * NGW) * DM) + lane;
#pragma unroll
              for (int j = 0; j < 8; ++j) o[64 * j] = v[r][j] * ss[r] * gg[j]; }
      } }
}

extern "C" void kernel_launch(void* const* d_in, const int* in_sizes, int n_in, void* d_out, int out_size, void* d_ws, size_t ws_size, hipStream_t stream) {
    static int grid = 0;
    if (grid == 0) {
        if (n_in != 25 || in_sizes[0] != M * DM || out_size != M * DM || ws_size < WS_END) { fprintf(stderr, "kernel_launch: unexpected shapes / workspace (n_in %d, ws %zu, need %zu); nothing launched\n", n_in, ws_size, (size_t)WS_END); grid = -1; return; }
        int dev = 0, cus = 0, per_cu = 0;
        if (hipGetDevice(&dev) != hipSuccess || hipDeviceGetAttribute(&cus, hipDeviceAttributeMultiprocessorCount, dev) != hipSuccess) { grid = -1; return; }
        if (hipFuncSetAttribute((const void*)fwd, hipFuncAttributeMaxDynamicSharedMemorySize, LDS_BYTES) != hipSuccess) { fprintf(stderr, "kernel_launch: hipFuncSetAttribute failed\n"); grid = -1; return; }
        if (hipOccupancyMaxActiveBlocksPerMultiprocessor(&per_cu, (const void*)fwd, 512, LDS_BYTES) != hipSuccess || per_cu < 1) { fprintf(stderr, "kernel_launch: occupancy query reports %d workgroups per CU; nothing launched\n", per_cu); (void)hipGetLastError(); grid = -1; return; }
        grid = cus;
    }
    if (grid < 0) return;
    if (hipMemsetAsync((char*)d_ws + WS_CTL, 0, CTL_ZERO_BYTES, stream) != hipSuccess) return;
    Params a{};
    for (int i = 0; i < 25; ++i) a.in[i] = (const GAS float*)d_in[i];
    a.out = (GAS float*)d_out; a.ws = (GAS unsigned char*)d_ws;
    hipLaunchKernelGGL(fwd, dim3(grid), dim3(512), LDS_BYTES, stream, a);
}
```

```cpp
#include <hip/hip_runtime.h>
#include <cstdio>
#include <cstdint>

namespace pg8 {
#define PG8_LAS __attribute__((address_space(3)))
typedef unsigned short bf16_t;
typedef short bf16x8 __attribute__((ext_vector_type(8)));
typedef float f32x4 __attribute__((ext_vector_type(4)));
typedef unsigned u32x4 __attribute__((ext_vector_type(4)));
typedef unsigned u32x2 __attribute__((ext_vector_type(2)));
constexpr int BM = 256, BK = 64, HALF = 128, HTB = HALF * BK * 2  , STAGE_BYTES = 8 * HTB, NXCD = 8, WGM = 8;

__host__ __device__ __forceinline__ int lds_byte(int r, int c) { const int st = (r >> 4) * 2 + (c >> 5), rr = r & 15, cc = c & 31, ob = rr * 64 + cc * 2; return st * 1024 + (ob ^ (((ob >> 9) & 1) << 5)); }
__host__ __device__ __forceinline__ void stage_rc(int b, int& R, int& C) { const int st = b / 1024, sb = b % 1024, swz = sb ^ (((sb >> 9) & 1) << 5); R = (st >> 1) * 16 + swz / 64; C = (st & 1) * 32 + (swz % 64) / 2; }
__host__ __device__ __forceinline__ int perm32(int rho) { const int n = rho >> 4, i = rho & 15; return 8 * (i >> 2) + 4 * n + (i & 3); }

struct Unit { int pm, pn; };
struct Gemm { const bf16_t* A; const bf16_t* Bt; int M, N, K, lda, ldb; };

struct StaticOrder {
    int nM, nN, nwg, G, c;
    __host__ __device__ void init(int M, int N, int G_, int c_) { nM = M / BM; nN = N / BM; nwg = nM * nN; G = G_; c = c_; }
    __host__ __device__ bool next(int i, Unit& u) const {
        const long L = (long)i * G + c; if (L >= nwg) return false;
        int wgid = (int)L; { const int q = nwg / NXCD, r = nwg % NXCD, xcd = wgid % NXCD, off = wgid / NXCD; wgid = (xcd < r ? xcd * (q + 1) : r * (q + 1) + (xcd - r) * q) + off; }
        const int nig = WGM * nN, gid = wgid / nig, fm = gid * WGM, gsz = (nM - fm) < WGM ? (nM - fm) : WGM;
        u.pm = fm + ((wgid % nig) % gsz); u.pn = (wgid % nig) / gsz; return true;
    }
    __device__ __forceinline__ void a_ready(const Unit&) const {}
    __device__ __forceinline__ void done(const Unit&) const {}
};
struct SimpleOrder {
    int nM, nN, nwg, G, c;
    __host__ __device__ void init(int M, int N, int G_, int c_) { nM = M / BM; nN = N / BM; nwg = nM * nN; G = G_; c = c_; }
    __host__ __device__ bool next(int i, Unit& u) const {
        const long L = (long)i * G + c; if (L < 0 || L >= nwg) return false;
        u.pm = (int)(L % nM); u.pn = (int)(L / nM); return true;
    }
    __device__ __forceinline__ void a_ready(const Unit&) const {}
    __device__ __forceinline__ void done(const Unit&) const {}
};

typedef __bf16 pkb2_t __attribute__((ext_vector_type(2))); typedef float pkf2_t __attribute__((ext_vector_type(2)));
__device__ __forceinline__ unsigned cvt_pk_bf16(float lo, float hi) { return __builtin_bit_cast(unsigned, __builtin_convertvector((pkf2_t){lo, hi}, pkb2_t)); }

__device__ __forceinline__ float fsigmoid(float x) { return __builtin_amdgcn_rcpf(1.0f + __builtin_amdgcn_exp2f(-1.4426950408889634f * x)); }
__device__ __forceinline__ float bf_lo(unsigned w) { return __uint_as_float(w << 16); }
__device__ __forceinline__ float bf_hi(unsigned w) { return __uint_as_float(w & 0xffff0000u); }

struct EpiSwiglu {
    static constexpr bool PERM = true, AFTER_DRAIN = false, HOOK = false;
    bf16_t* H; int ldh; long rstd_off;
    __device__ __forceinline__ void operator()(const f32x4 (&acc)[2][2][4][2], const Unit& u, int wr, int wc, int fr, int fq) const {
        const int row0 = u.pm * BM + wr * 64 + fr, col0 = u.pn * HALF + wc * 32 + 8 * fq;
#pragma unroll
        for (int ai = 0; ai < 2; ++ai)
#pragma unroll
            for (int m = 0; m < 4; ++m) {
                bf16_t* rowp = H + (size_t)(row0 + ai * HALF + m * 16) * ldh + col0;
                const float rs = ((const float*)((const char*)H + rstd_off))[row0 + ai * HALF + m * 16];
                const f32x4 g0 = acc[ai][0][m][0] * rs, g1 = acc[ai][0][m][1] * rs, u0 = acc[ai][1][m][0] * rs, u1 = acc[ai][1][m][1] * rs;
                float o[8];
#pragma unroll
                for (int j = 0; j < 4; ++j) { o[j] = g0[j] * fsigmoid(g0[j]) * u0[j]; o[4 + j] = g1[j] * fsigmoid(g1[j]) * u1[j]; }
                u32x4 w; w.x = cvt_pk_bf16(o[0], o[1]); w.y = cvt_pk_bf16(o[2], o[3]); w.z = cvt_pk_bf16(o[4], o[5]); w.w = cvt_pk_bf16(o[6], o[7]);
                *(u32x4*)rowp = w;
            }
    }
};
struct EpiResid {
    static constexpr bool PERM = false, AFTER_DRAIN = false, HOOK = false, TOUCH = false;
    const float* src; float* out; int ldc; float alpha;
    static __device__ __forceinline__ float ror8(float v) { return __builtin_bit_cast(float, __builtin_amdgcn_update_dpp(0, __builtin_bit_cast(int, v), 0x128, 0xF, 0xF, false)); }
    __device__ __forceinline__ void operator()(const f32x4 (&acc)[2][2][4][2], const Unit& u, int wr, int wc, int fr, int fq) const {
        const bool lo = fr < 8;
        const int row0 = u.pm * BM + wr * 64 + (fr & 7), col0 = u.pn * BM + wc * 32 + 16 * (fr >> 3) + 4 * fq;
#pragma unroll
        for (int ai = 0; ai < 2; ++ai)
#pragma unroll
            for (int m = 0; m < 4; ++m) {
                const size_t off = (size_t)(row0 + ai * HALF + m * 16) * ldc + col0;
                f32x4 s[2][2];
#pragma unroll
                for (int bj = 0; bj < 2; ++bj)
#pragma unroll
                    for (int hh = 0; hh < 2; ++hh) s[bj][hh] = *(const f32x4*)(src + off + bj * HALF + (size_t)hh * 8 * ldc);
#pragma unroll
                for (int bj = 0; bj < 2; ++bj) {
                    const f32x4 r0 = acc[ai][bj][m][0] * alpha, r1 = acc[ai][bj][m][1] * alpha;
                    f32x4 d1, d2;
#pragma unroll
                    for (int e = 0; e < 4; ++e) { const float y = ror8(lo ? r1[e] : r0[e]); d1[e] = lo ? r0[e] : y; d2[e] = lo ? y : r1[e]; }
                    *(f32x4*)(out + off + bj * HALF) = s[bj][0] + d1;
                    *(f32x4*)(out + off + bj * HALF + (size_t)8 * ldc) = s[bj][1] + d2;
                }
                if (m & 1) asm volatile("" ::: "memory");
            }
    }
};
template <bool F32SRC> struct EpiResidB {
    static constexpr bool PERM = true, AFTER_DRAIN = false, HOOK = false, TOUCH = false;
    const float* srcf; const bf16_t* srcb; bf16_t* out; int ldc; float alpha; long part_off;
    __device__ __forceinline__ void operator()(const f32x4 (&acc)[2][2][4][2], const Unit& u, int wr, int wc, int fr, int fq) const {
        const int row0 = u.pm * BM + wr * 64 + fr, col0 = u.pn * BM + wc * 32 + 8 * fq;
        u32x4 svall[8][2];
        if constexpr (!F32SRC) {
#pragma unroll
            for (int g = 0; g < 8; ++g)
#pragma unroll
                for (int bj = 0; bj < 2; ++bj) svall[g][bj] = *(const u32x4*)(srcb + (size_t)(row0 + (g >> 2) * HALF + (g & 3) * 16) * ldc + col0 + bj * HALF);
        }
#pragma unroll
        for (int ai = 0; ai < 2; ++ai)
#pragma unroll
            for (int m = 0; m < 4; ++m) {
                const size_t off = (size_t)(row0 + ai * HALF + m * 16) * ldc + col0;
                f32x4 s[2][2]; float ssq = 0.f;
                if constexpr (F32SRC) {
#pragma unroll
                    for (int bj = 0; bj < 2; ++bj) { s[bj][0] = *(const f32x4*)(srcf + off + bj * HALF); s[bj][1] = *(const f32x4*)(srcf + off + bj * HALF + 4); }
                } else {
#pragma unroll
                    for (int bj = 0; bj < 2; ++bj) { const u32x4 sv = svall[ai * 4 + m][bj]; s[bj][0] = (f32x4){bf_lo(sv.x), bf_hi(sv.x), bf_lo(sv.y), bf_hi(sv.y)}; s[bj][1] = (f32x4){bf_lo(sv.z), bf_hi(sv.z), bf_lo(sv.w), bf_hi(sv.w)}; }
                }
#pragma unroll
                for (int bj = 0; bj < 2; ++bj) {
                    const f32x4 v0 = s[bj][0] + acc[ai][bj][m][0] * alpha, v1 = s[bj][1] + acc[ai][bj][m][1] * alpha;
                    ssq += (v0[0] * v0[0] + v0[1] * v0[1]) + (v0[2] * v0[2] + v0[3] * v0[3]) + (v1[0] * v1[0] + v1[1] * v1[1]) + (v1[2] * v1[2] + v1[3] * v1[3]);
                    u32x4 w; w.x = cvt_pk_bf16(v0[0], v0[1]); w.y = cvt_pk_bf16(v0[2], v0[3]); w.z = cvt_pk_bf16(v1[0], v1[1]); w.w = cvt_pk_bf16(v1[2], v1[3]);
                    *(u32x4*)(out + off + bj * HALF) = w;
                }
                ssq += __shfl_xor(ssq, 16); ssq += __shfl_xor(ssq, 32);
                if (fq == 0) ((float*)((char*)out + part_off))[(size_t)(row0 + ai * HALF + m * 16) * 32 + u.pn * 4 + wc] = ssq;
                if (F32SRC && (m & 1)) asm volatile("" ::: "memory");
            }
    }
};
struct EpiProj {
    static constexpr bool PERM = true, AFTER_DRAIN = false, HOOK = false;
    bf16_t* P; int ldp; float* side; bf16_t* gfrag; long rstd_off;
    __device__ __forceinline__ void operator()(const f32x4 (&acc)[2][2][4][2], const Unit& u, int wr, int wc, int fr, int fq) const {
        const int row0 = u.pm * BM + wr * 64 + fr, cw = wc * 32 + 8 * fq;
        if (u.pn == 7) {
            if (cw < 72) {
#pragma unroll
                for (int ai = 0; ai < 2; ++ai)
#pragma unroll
                    for (int m = 0; m < 4; ++m) { const float rs = ((const float*)((const char*)P + rstd_off))[row0 + ai * HALF + m * 16]; float* rp = side + (size_t)(row0 + ai * HALF + m * 16) * 72 + cw; *(f32x4*)rp = acc[ai][0][m][0] * rs; *(f32x4*)(rp + 4) = acc[ai][0][m][1] * rs; }
            }
            return;
        }
        const int colbase = 256 * (u.pn > 7 ? u.pn - 1 : u.pn) + cw; const bool sig = u.pn >= 20;
#pragma unroll
        for (int ai = 0; ai < 2; ++ai)
#pragma unroll
            for (int m = 0; m < 4; ++m) {
                bf16_t* rowp = P + (size_t)(row0 + ai * HALF + m * 16) * ldp + colbase;
                const float rs = ((const float*)((const char*)P + rstd_off))[row0 + ai * HALF + m * 16];
#pragma unroll
                for (int bj = 0; bj < 2; ++bj) {
                    f32x4 v0 = acc[ai][bj][m][0] * rs, v1 = acc[ai][bj][m][1] * rs;
                    if (sig) {
#pragma unroll
                        for (int j = 0; j < 4; ++j) { v0[j] = fsigmoid(v0[j]); v1[j] = fsigmoid(v1[j]); }
                    }
                    u32x4 w; w.x = cvt_pk_bf16(v0[0], v0[1]); w.y = cvt_pk_bf16(v0[2], v0[3]); w.z = cvt_pk_bf16(v1[0], v1[1]); w.w = cvt_pk_bf16(v1[2], v1[3]);
                    if (sig) *(u32x4*)(gfrag + gfrag_off(u.pn - 20, u.pm, wr * 4 + wc, (ai * 4 + m) * 2 + bj, fq * 16 + fr)) = w;
                    else *(u32x4*)(rowp + bj * HALF) = w;
                }
            }
    }
    static __device__ __forceinline__ size_t gfrag_off(int gt, int pm, int wave, int slot, int lane) { return ((((size_t)((gt >> 3) * 64 + pm) * 8 + (gt & 7)) * 8 + wave) * 16 + slot) * 512 + lane * 8; }
};
template <int J> struct EpiBranch {
    static constexpr bool PERM = true, AFTER_DRAIN = false, HOOK = false;
    const bf16_t* gate; int ldg; float* tmp; bf16_t* outb; int ldc;
    __device__ __forceinline__ void operator()(const f32x4 (&acc)[2][2][4][2], const Unit& u, int wr, int wc, int fr, int fq) const {
        const int row0 = u.pm * BM + wr * 64 + fr, col0 = u.pn * BM + wc * 32 + 8 * fq;
#pragma unroll
        for (int ai = 0; ai < 2; ++ai)
#pragma unroll
            for (int m = 0; m < 4; ++m) {
                const int row = row0 + ai * HALF + m * 16;
#pragma unroll
                for (int bj = 0; bj < 2; ++bj) {
                    const int c = col0 + bj * HALF;
                    const u32x4 gv = *(const u32x4*)(gate + (size_t)row * ldg + c);
                    f32x4 t0, t1;
                    t0[0] = bf_lo(gv.x) * acc[ai][bj][m][0][0]; t0[1] = bf_hi(gv.x) * acc[ai][bj][m][0][1]; t0[2] = bf_lo(gv.y) * acc[ai][bj][m][0][2]; t0[3] = bf_hi(gv.y) * acc[ai][bj][m][0][3];
                    t1[0] = bf_lo(gv.z) * acc[ai][bj][m][1][0]; t1[1] = bf_hi(gv.z) * acc[ai][bj][m][1][1]; t1[2] = bf_lo(gv.w) * acc[ai][bj][m][1][2]; t1[3] = bf_hi(gv.w) * acc[ai][bj][m][1][3];
                    float* tp = tmp + (size_t)row * ldc + c;
                    if (J > 0) { t0 += *(const f32x4*)tp; t1 += *(const f32x4*)(tp + 4); }
                    if (J < 2) { *(f32x4*)tp = t0; *(f32x4*)(tp + 4) = t1; }
                    else { u32x4 w; w.x = cvt_pk_bf16(t0[0], t0[1]); w.y = cvt_pk_bf16(t0[2], t0[3]); w.z = cvt_pk_bf16(t1[0], t1[1]); w.w = cvt_pk_bf16(t1[2], t1[3]);
                        *(u32x4*)(outb + (size_t)row * ldc + c) = w; }
                }
                asm volatile("" ::: "memory");
            }
    }
};
struct EpiMerge {
    static constexpr bool PERM = true, AFTER_DRAIN = false, HOOK = false;
    const bf16_t* gate; int ldg; const bf16_t* z0; const bf16_t* z1; bf16_t* outb; int ldc;
    __device__ __forceinline__ void operator()(const f32x4 (&acc)[2][2][4][2], const Unit& u, int wr, int wc, int fr, int fq) const {
        const int row0 = u.pm * BM + wr * 64 + fr, col0 = u.pn * BM + wc * 32 + 8 * fq;
#pragma unroll
        for (int ai = 0; ai < 2; ++ai)
#pragma unroll
            for (int m = 0; m < 4; ++m) {
                const int row = row0 + ai * HALF + m * 16;
                u32x4 g0[2], g1[2], g2[2], a0[2], a1[2];
#pragma unroll
                for (int bj = 0; bj < 2; ++bj) { const int c = col0 + bj * HALF; const bf16_t* gp = gate + (size_t)row * ldg + c;
                    g0[bj] = *(const u32x4*)gp; g1[bj] = *(const u32x4*)(gp + 2048); g2[bj] = *(const u32x4*)(gp + 4096);
                    a0[bj] = *(const u32x4*)(z0 + (size_t)row * ldc + c); a1[bj] = *(const u32x4*)(z1 + (size_t)row * ldc + c); }
#pragma unroll
                for (int bj = 0; bj < 2; ++bj) {
                    const unsigned G0[4] = {g0[bj].x, g0[bj].y, g0[bj].z, g0[bj].w}, G1[4] = {g1[bj].x, g1[bj].y, g1[bj].z, g1[bj].w}, G2[4] = {g2[bj].x, g2[bj].y, g2[bj].z, g2[bj].w};
                    const unsigned A0[4] = {a0[bj].x, a0[bj].y, a0[bj].z, a0[bj].w}, A1[4] = {a1[bj].x, a1[bj].y, a1[bj].z, a1[bj].w};
                    unsigned w[4];
#pragma unroll
                    for (int k = 0; k < 4; ++k) {
                        const float lo = bf_lo(G0[k]) * bf_lo(A0[k]) + bf_lo(G1[k]) * bf_lo(A1[k]) + bf_lo(G2[k]) * acc[ai][bj][m][k >> 1][2 * (k & 1)];
                        const float hi = bf_hi(G0[k]) * bf_hi(A0[k]) + bf_hi(G1[k]) * bf_hi(A1[k]) + bf_hi(G2[k]) * acc[ai][bj][m][k >> 1][2 * (k & 1) + 1];
                        w[k] = cvt_pk_bf16(lo, hi); }
                    *(u32x4*)(outb + (size_t)row * ldc + col0 + bj * HALF) = (u32x4){w[0], w[1], w[2], w[3]};
                }
                asm volatile("" ::: "memory");
            }
    }
};
struct EpiGate {
    static constexpr bool PERM = true, AFTER_DRAIN = false, HOOK = true;
    const bf16_t* gate; int ldg; bf16_t* outb; int ldc;
    static __device__ __forceinline__ float cl(float g) { return __builtin_fmaxf(g, 8.673617379884035e-19f); }
    __device__ __forceinline__ void mid(f32x4 (&acc)[2][2][4][2], const Unit& u, int j, int wr, int wc, int fr, int fq) const {
        int lane_ = fq * 16 + fr, wave_ = wr * 4 + wc;
        asm volatile("" : "+v"(lane_), "+s"(wave_));
#define EG_LD(C, GA, GB) do { _Pragma("unroll") for (int mm = 0; mm < 2; ++mm) _Pragma("unroll") for (int bj = 0; bj < 2; ++bj) { const int slot = ((C) * 2 + mm) * 2 + bj; \
            GA[mm][bj] = *(const u32x4*)(gate + EpiProj::gfrag_off(8 * j + u.pn, u.pm, wave_, slot, lane_)); GB[mm][bj] = *(const u32x4*)(gate + EpiProj::gfrag_off(8 * (j + 1) + u.pn, u.pm, wave_, slot, lane_)); } } while (0)
#define EG_CP(C, GA, GB) do { _Pragma("unroll") for (int mm = 0; mm < 2; ++mm) _Pragma("unroll") for (int bj = 0; bj < 2; ++bj) { const int ai = (C) >> 1, m = 2 * ((C) & 1) + mm; \
            const unsigned A_[4] = {GA[mm][bj].x, GA[mm][bj].y, GA[mm][bj].z, GA[mm][bj].w}, B_[4] = {GB[mm][bj].x, GB[mm][bj].y, GB[mm][bj].z, GB[mm][bj].w}; \
            _Pragma("unroll") for (int k = 0; k < 4; ++k) {                \
                const float nlo = j ? cl(bf_lo(A_[k])) : bf_lo(A_[k]), nhi = j ? cl(bf_hi(A_[k])) : bf_hi(A_[k]); \
                acc[ai][bj][m][k >> 1][2 * (k & 1)] *= nlo * __builtin_amdgcn_rcpf(cl(bf_lo(B_[k]))); \
                acc[ai][bj][m][k >> 1][2 * (k & 1) + 1] *= nhi * __builtin_amdgcn_rcpf(cl(bf_hi(B_[k]))); } } } while (0)
        u32x4 a0[2][2], b0[2][2], a1[2][2], b1[2][2];
        EG_LD(0, a0, b0); EG_LD(1, a1, b1);
        asm volatile("" ::: "memory");
        EG_CP(0, a0, b0); EG_LD(2, a0, b0);
        asm volatile("" ::: "memory");
        EG_CP(1, a1, b1); EG_LD(3, a1, b1);
        asm volatile("" ::: "memory");
        EG_CP(2, a0, b0);
        EG_CP(3, a1, b1);
        asm volatile("" ::: "memory");
#undef EG_LD
#undef EG_CP
    }
    __device__ __forceinline__ void operator()(const f32x4 (&acc)[2][2][4][2], const Unit& u, int wr, int wc, int fr, int fq) const {
        int row0 = u.pm * BM + wr * 64 + fr, col0 = u.pn * BM + wc * 32 + 8 * fq, lane_ = fq * 16 + fr, wave_ = wr * 4 + wc;
        asm volatile("" : "+v"(row0), "+v"(col0), "+v"(lane_), "+s"(wave_));
#pragma unroll
        for (int ai = 0; ai < 2; ++ai)
#pragma unroll
            for (int mp = 0; mp < 2; ++mp) {
                u32x4 g2[2][2];
#pragma unroll
                for (int mm = 0; mm < 2; ++mm)
#pragma unroll
                    for (int bj = 0; bj < 2; ++bj) g2[mm][bj] = *(const u32x4*)(gate + EpiProj::gfrag_off(16 + u.pn, u.pm, wave_, (ai * 4 + 2 * mp + mm) * 2 + bj, lane_));
#pragma unroll
                for (int mm = 0; mm < 2; ++mm)
#pragma unroll
                    for (int bj = 0; bj < 2; ++bj) { const int m = 2 * mp + mm;
                        const unsigned G2[4] = {g2[mm][bj].x, g2[mm][bj].y, g2[mm][bj].z, g2[mm][bj].w};
                        unsigned w[4];
#pragma unroll
                        for (int k = 0; k < 4; ++k) w[k] = cvt_pk_bf16(cl(bf_lo(G2[k])) * acc[ai][bj][m][k >> 1][2 * (k & 1)], cl(bf_hi(G2[k])) * acc[ai][bj][m][k >> 1][2 * (k & 1) + 1]);
                        *(u32x4*)(outb + (size_t)(row0 + ai * HALF + m * 16) * ldc + col0 + bj * HALF) = (u32x4){w[0], w[1], w[2], w[3]}; }
                asm volatile("" ::: "memory");
            }
    }
};
struct EpiBf16 {
    static constexpr bool PERM = true, AFTER_DRAIN = false, HOOK = false;
    bf16_t* C; int ldc;
    __device__ __forceinline__ void operator()(const f32x4 (&acc)[2][2][4][2], const Unit& u, int wr, int wc, int fr, int fq) const {
        const int row0 = u.pm * BM + wr * 64 + fr, col0 = u.pn * BM + wc * 32 + 8 * fq;
#pragma unroll
        for (int ai = 0; ai < 2; ++ai)
#pragma unroll
            for (int m = 0; m < 4; ++m) {
                bf16_t* rowp = C + (size_t)(row0 + ai * HALF + m * 16) * ldc + col0;
#pragma unroll
                for (int bj = 0; bj < 2; ++bj) {
                    const f32x4 v0 = acc[ai][bj][m][0] + 0.0f, v1 = acc[ai][bj][m][1] + 0.0f;
                    u32x4 w; w.x = cvt_pk_bf16(v0[0], v0[1]); w.y = cvt_pk_bf16(v0[2], v0[3]); w.z = cvt_pk_bf16(v1[0], v1[1]); w.w = cvt_pk_bf16(v1[2], v1[3]);
                    *(u32x4*)(rowp + bj * HALF) = w;
                }
            }
    }
};

template <class Epi, class Sched, bool ALIGN_EPI = false, bool SP2 = false>
__device__ __forceinline__ void gemm_phase(PG8_LAS unsigned char* lds, const Gemm g, const Sched& S, const Epi& E, const int tid) {
    const int wid = __builtin_amdgcn_readfirstlane(tid >> 6), lane = tid & 63, wr = wid >> 2, wc = wid & 3, fr = lane & 15, fq = lane >> 4;
    const int K = g.K, nt = K / BK;
    unsigned voffA[2], voffB[2];
#pragma unroll
    for (int i = 0; i < 2; ++i) { int R, C; stage_rc(tid * 16 + i * 8192, R, C); const int Rb = Epi::PERM ? ((R & ~31) + perm32(R & 31)) : R;
        voffA[i] = (unsigned)(R * g.lda + C) * 2u; voffB[i] = (unsigned)(Rb * g.ldb + C) * 2u; }
    const size_t kstep = (size_t)(BK * 2);
    const size_t hstepA = (size_t)HALF * g.lda * 2, hstepB = (size_t)HALF * g.ldb * 2;
    const size_t tstepA = 2 * hstepA, tstepB = 2 * hstepB;
    const unsigned ldsw = (unsigned)wid * 1024u;
    const int aoff = lds_byte(wr * 64 + fr, fq * 8), boff = lds_byte(wc * 32 + fr, fq * 8);
#define PG8_SA(b, h) (((b) * 2 + (h)) * HTB)
#define PG8_SB(b, h) ((4 + (b) * 2 + (h)) * HTB)
#define PG8_STAGE(bufoff, gbase, voff) do { _Pragma("unroll") for (int _i = 0; _i < 2; ++_i) \
        __builtin_amdgcn_global_load_lds((const unsigned*)((const char*)(gbase) + (voff)[_i]), (PG8_LAS unsigned*)(lds + (bufoff) + ldsw + _i * 8192), 16, 0, 0); } while (0)
#define PG8_LDA(dst, b, h) do { _Pragma("unroll") for (int m = 0; m < 4; ++m) _Pragma("unroll") for (int k = 0; k < 2; ++k) dst[m][k] = *(const PG8_LAS bf16x8*)(lds + PG8_SA(b, h) + aoff + m * 2048 + k * 1024); } while (0)
#define PG8_LDB(dst, b, h) do { _Pragma("unroll") for (int n = 0; n < 2; ++n) _Pragma("unroll") for (int k = 0; k < 2; ++k) dst[n][k] = *(const PG8_LAS bf16x8*)(lds + PG8_SB(b, h) + boff + n * 2048 + k * 1024); } while (0)
#define PG8_MMA(ai, bj, At, Bt) do { __builtin_amdgcn_s_setprio(1); _Pragma("unroll") for (int m = 0; m < 4; ++m) _Pragma("unroll") for (int n = 0; n < 2; ++n) _Pragma("unroll") for (int k = 0; k < 2; ++k) \
        acc[ai][bj][m][n] = __builtin_amdgcn_mfma_f32_16x16x32_bf16(Bt[n][k], At[m][k], acc[ai][bj][m][n], 0, 0, 0); __builtin_amdgcn_s_setprio(0); } while (0)
#define PG8_WAIT_V(n) asm volatile("s_waitcnt vmcnt(" #n ")" ::: "memory")
#define PG8_WAIT_L(n) asm volatile("s_waitcnt lgkmcnt(" #n ")" ::: "memory")
#define PG8_BAR __builtin_amdgcn_s_barrier()
#define PG8_SCHED __builtin_amdgcn_sched_barrier(0)
    Unit cur, nxt; int ui = 0;
    if (!S.next(0, cur)) return;
    f32x4 acc[2][2][4][2];
#pragma unroll
    for (int a = 0; a < 2; ++a)
#pragma unroll
        for (int b = 0; b < 2; ++b)
#pragma unroll
            for (int m = 0; m < 4; ++m)
#pragma unroll
                for (int n = 0; n < 2; ++n) acc[a][b][m][n] = (f32x4){0.f, 0.f, 0.f, 0.f};
    bf16x8 At[4][2], B0[2][2], B1[2][2];
    const char* cA = (const char*)g.A + (size_t)cur.pm * tstepA; const char* cB = (const char*)g.Bt + (size_t)cur.pn * tstepB;
    S.a_ready(cur);
    if constexpr (SP2) {
        PG8_STAGE(PG8_SB(0, 0), cB, voffB); PG8_STAGE(PG8_SB(0, 1), cB + hstepB, voffB); PG8_STAGE(PG8_SA(0, 0), cA, voffA); PG8_STAGE(PG8_SA(0, 1), cA + hstepA, voffA);
        if (wr == 1) PG8_BAR;
        PG8_WAIT_V(2); PG8_BAR;
        PG8_STAGE(PG8_SB(1, 0), cB + kstep, voffB); PG8_STAGE(PG8_SA(1, 0), cA + kstep, voffA); PG8_STAGE(PG8_SB(1, 1), cB + hstepB + kstep, voffB);
        PG8_WAIT_V(6); PG8_BAR;
    } else {
        PG8_STAGE(PG8_SB(0, 0), cB, voffB); PG8_STAGE(PG8_SA(0, 0), cA, voffA); PG8_STAGE(PG8_SB(0, 1), cB + hstepB, voffB); PG8_STAGE(PG8_SA(0, 1), cA + hstepA, voffA);
        if (wr == 1) PG8_BAR;
        PG8_WAIT_V(4); PG8_BAR;
        PG8_STAGE(PG8_SB(1, 0), cB + kstep, voffB); PG8_STAGE(PG8_SA(1, 0), cA + kstep, voffA); PG8_STAGE(PG8_SB(1, 1), cB + hstepB + kstep, voffB);
        PG8_WAIT_V(6); PG8_BAR;
    }
    for (;;) {
        const bool has_next = S.next(ui + 1, nxt);
        const char* nA = has_next ? (const char*)g.A + (size_t)nxt.pm * tstepA : cA; const char* nB = has_next ? (const char*)g.Bt + (size_t)nxt.pn * tstepB : cB;
        for (int t = 0; t < nt; t += 2) {
            const bool last = (t == nt - 2);
            const char* a1 = cA + (size_t)(t + 1) * kstep;
            const char* a2 = last ? nA : cA + (size_t)(t + 2) * kstep; const char* b2 = last ? nB : cB + (size_t)(t + 2) * kstep;
            const char* a3 = a2 + kstep; const char* b3 = b2 + kstep;
            if (last && has_next) S.a_ready(nxt);
            if constexpr (SP2) {
            PG8_LDB(B0, 0, 0); PG8_LDB(B1, 0, 1); PG8_SCHED; PG8_LDA(At, 0, 0); PG8_STAGE(PG8_SA(1, 1), a1 + hstepA, voffA);
            PG8_WAIT_V(8); PG8_WAIT_L(0); PG8_BAR; PG8_MMA(0, 0, At, B0); PG8_MMA(0, 1, At, B1); PG8_BAR; PG8_SCHED;
            PG8_LDA(At, 0, 1); PG8_STAGE(PG8_SB(0, 0), b2, voffB); PG8_STAGE(PG8_SB(0, 1), b2 + hstepB, voffB); PG8_STAGE(PG8_SA(0, 0), a2, voffA);
            PG8_WAIT_V(8); PG8_WAIT_L(0); PG8_BAR; PG8_MMA(1, 0, At, B0); PG8_MMA(1, 1, At, B1); PG8_BAR; PG8_SCHED;
            PG8_LDB(B0, 1, 0); PG8_LDB(B1, 1, 1); PG8_SCHED; PG8_LDA(At, 1, 0); PG8_STAGE(PG8_SA(0, 1), a2 + hstepA, voffA);
            PG8_WAIT_V(8); PG8_WAIT_L(0); PG8_BAR; PG8_MMA(0, 0, At, B0); PG8_MMA(0, 1, At, B1); PG8_BAR; PG8_SCHED;
            PG8_LDA(At, 1, 1); PG8_STAGE(PG8_SB(1, 0), b3, voffB); PG8_STAGE(PG8_SB(1, 1), b3 + hstepB, voffB); PG8_STAGE(PG8_SA(1, 0), a3, voffA);
            PG8_WAIT_V(8); PG8_WAIT_L(0); PG8_BAR; PG8_MMA(1, 0, At, B0); PG8_MMA(1, 1, At, B1); PG8_BAR; PG8_SCHED;
            } else {
            PG8_LDB(B0, 0, 0); PG8_SCHED; PG8_LDA(At, 0, 0); PG8_STAGE(PG8_SA(1, 1), a1 + hstepA, voffA);
            PG8_WAIT_L(8); PG8_BAR; PG8_WAIT_L(0); PG8_MMA(0, 0, At, B0); PG8_BAR; PG8_SCHED;
            PG8_LDB(B1, 0, 1); PG8_STAGE(PG8_SB(0, 0), b2, voffB);
            PG8_BAR; PG8_WAIT_L(0); PG8_MMA(0, 1, At, B1); PG8_BAR;
            PG8_LDA(At, 0, 1); PG8_STAGE(PG8_SA(0, 0), a2, voffA);
            PG8_BAR; PG8_WAIT_L(0); PG8_MMA(1, 0, At, B0); PG8_BAR; PG8_SCHED;
            PG8_STAGE(PG8_SB(0, 1), b2 + hstepB, voffB);
            PG8_WAIT_V(6); PG8_BAR; PG8_MMA(1, 1, At, B1); PG8_BAR;
            PG8_LDB(B0, 1, 0); PG8_SCHED; PG8_LDA(At, 1, 0); PG8_STAGE(PG8_SA(0, 1), a2 + hstepA, voffA);
            PG8_WAIT_L(8); PG8_BAR; PG8_WAIT_L(0); PG8_MMA(0, 0, At, B0); PG8_BAR; PG8_SCHED;
            PG8_LDB(B1, 1, 1); PG8_STAGE(PG8_SB(1, 0), b3, voffB);
            PG8_BAR; PG8_WAIT_L(0); PG8_MMA(0, 1, At, B1); PG8_BAR;
            PG8_LDA(At, 1, 1); PG8_STAGE(PG8_SA(1, 0), a3, voffA);
            PG8_BAR; PG8_WAIT_L(0); PG8_MMA(1, 0, At, B0); PG8_BAR; PG8_SCHED;
            PG8_STAGE(PG8_SB(1, 1), b3 + hstepB, voffB);
            PG8_WAIT_V(6); PG8_BAR; PG8_MMA(1, 1, At, B1); PG8_BAR;
            }
            if constexpr (Epi::HOOK) { if (t + 2 == 16 || t + 2 == 32) E.mid(acc, cur, (t + 2) / 16 - 1, wr, wc, fr, fq); }
        }
        if constexpr (ALIGN_EPI) { if (wr == 0) PG8_BAR; }
        if constexpr (!Epi::AFTER_DRAIN) { E(acc, cur, wr, wc, fr, fq); S.done(cur); }
        if (!has_next) break;
#pragma unroll
        for (int a = 0; a < 2; ++a)
#pragma unroll
            for (int b = 0; b < 2; ++b)
#pragma unroll
                for (int m = 0; m < 4; ++m)
#pragma unroll
                    for (int n = 0; n < 2; ++n) acc[a][b][m][n] = (f32x4){0.f, 0.f, 0.f, 0.f};
        cur = nxt; cA = nA; cB = nB; ++ui;
        if constexpr (ALIGN_EPI) { if (wr == 1) PG8_BAR; }
    }
    PG8_WAIT_V(0);
    if constexpr (!ALIGN_EPI) { if (wr == 0) PG8_BAR; }
    PG8_BAR;
    if constexpr (Epi::AFTER_DRAIN) { E.fused(acc, cur, wr, wc, fr, fq, lds, wid, lane); S.done(cur); }
#undef PG8_SA
#undef PG8_SB
#undef PG8_STAGE
#undef PG8_LDA
#undef PG8_LDB
#undef PG8_MMA
#undef PG8_WAIT_V
#undef PG8_WAIT_L
#undef PG8_BAR
#undef PG8_SCHED
}
}

constexpr int BATCH = 2, SEQ = 8192, M = BATCH * SEQ, DM = 2048, DFF = 5504, NMEM = 256, DEPTH = 2;
constexpr int DIN = 11076, DIN_PAD = 11264, PLD = 5504;
constexpr int C_QA = 0, C_KA = 1024, C_VA = 1280, C_QI = 1536, C_XL = 1792, C_GL = 2816, C_QM = 3840, C_GT = 4864;
constexpr float EPS = 1e-6f, LOG2E = 1.4426950408889634f;

constexpr size_t MiB = 1u << 20;
constexpr size_t WS_CTL = 0, CTL_ZERO_BYTES = 1 * MiB;
constexpr size_t WS_WGU = 2 * MiB, WS_WDN = 45 * MiB, WS_WIN = 67 * MiB, WS_WMKV = 111 * MiB, WS_WBR = 119 * MiB, WS_WOUT = 131 * MiB;
constexpr size_t WS_WGU2 = 139 * MiB, WS_WDN2 = 182 * MiB, WS_WAT = 204 * MiB, WS_WIT = 204 * MiB + 512 * 1024;
constexpr size_t WS_XN = 206 * MiB, WS_R1 = 270 * MiB, WS_SCR = 614 * MiB, WS_SIDE = 742 * MiB, WS_KIDX = 747 * MiB, WS_WIDX = 749 * MiB;
constexpr size_t WS_MASK = 750 * MiB, WS_VT = 766 * MiB, WS_MK = 774 * MiB, WS_VTM = 775 * MiB, WS_MEMN = 776 * MiB, WS_AGG = 778 * MiB, WS_END = 780 * MiB;
constexpr size_t WS_PART = 634 * MiB, WS_RSTD = 779 * MiB;
constexpr size_t WS_GFR = 442 * MiB, WS_LRS = WS_XN, WS_XB = 678 * MiB;
constexpr int CW_BAR = 4096;

constexpr int LDS_BYTES = 163840, MISC_OFF = LDS_BYTES - 256;

#define LAS __attribute__((address_space(3)))
typedef unsigned short bf16;
typedef short bf16x8 __attribute__((ext_vector_type(8)));
typedef float f32x4 __attribute__((ext_vector_type(4)));
typedef float f32x16 __attribute__((ext_vector_type(16)));
typedef unsigned u32x4 __attribute__((ext_vector_type(4)));
typedef unsigned u32x2 __attribute__((ext_vector_type(2)));
#define LDS_WAIT() asm volatile("s_waitcnt lgkmcnt(0)" ::: "memory")
#define VM_WAIT() asm volatile("s_waitcnt vmcnt(0)" ::: "memory")
__device__ __forceinline__ unsigned f2bf(float f) { unsigned u = __builtin_bit_cast(unsigned, f); return (u + 0x7fffu + ((u >> 16) & 1u)) >> 16; }
__device__ __forceinline__ unsigned pk2(float lo, float hi) { return f2bf(lo) | (f2bf(hi) << 16); }
typedef __bf16 bf16v2_t __attribute__((ext_vector_type(2))); typedef float f32v2_t __attribute__((ext_vector_type(2)));
__device__ __forceinline__ unsigned pkbf(float lo, float hi) { return __builtin_bit_cast(unsigned, __builtin_convertvector((f32v2_t){lo, hi}, bf16v2_t)); }
__device__ __forceinline__ float bflo(unsigned w) { return __uint_as_float(w << 16); }
__device__ __forceinline__ float bfhi(unsigned w) { return __uint_as_float(w & 0xffff0000u); }

#define XB_TMO      128
#define XB_XCNT(j)  (256  + 64 * (j))
#define XB_XSUB(j)  (1280 + 64 * (j))
#define XB_XGEN(j)  (2304 + 64 * (j))
#define XB_TOP      3328
#define XB_TOPGEN   3392
#define XCD_BAR_WORDS 3456
#define XB_SPIN_CAP (1u << 18)

__device__ __forceinline__ unsigned xb_ld(unsigned* p)              { return __hip_atomic_load(p, __ATOMIC_RELAXED, __HIP_MEMORY_SCOPE_AGENT); }
__device__ __forceinline__ unsigned xb_add(unsigned* p, unsigned v) { return __hip_atomic_fetch_add(p, v, __ATOMIC_RELAXED, __HIP_MEMORY_SCOPE_AGENT); }
__device__ __forceinline__ unsigned xb_xcc_id() { return (unsigned)__builtin_amdgcn_s_getreg((3 << 11) | 20) & 0xFu; }
#define XB_SPIN(cond, bar) do { unsigned _sp = 0; while (cond) { __builtin_amdgcn_s_sleep(1); \
    if ((++_sp & 255u) == 0u) { if (xb_ld(&(bar)[XB_TMO])) break; if (_sp > XB_SPIN_CAP) { atomicAdd(&(bar)[XB_TMO], 1u); break; } } } } while (0)

struct XcdBarrier {
    unsigned* bar; unsigned x;
    volatile LAS unsigned* st;
};
__device__ __forceinline__ XcdBarrier xcd_barrier_post(unsigned* bar, volatile LAS unsigned* st) {
    XcdBarrier b; b.bar = bar; b.x = xb_xcc_id(); b.st = st;
    if (threadIdx.x == 0) (void)xb_add(&bar[XB_XCNT(b.x)], 1u);
    return b;
}
__device__ __forceinline__ void xcd_barrier_complete(unsigned* bar, unsigned x, unsigned& nloc, unsigned& nx) {
    const unsigned G = gridDim.x * gridDim.y * gridDim.z;
    unsigned sum, cnt, mine, sp = 0u;
    for (;;) {
        sum = 0u; cnt = 0u; mine = 0u;
#pragma unroll
        for (unsigned j = 0; j < 16; ++j) { const unsigned c = xb_ld(&bar[XB_XCNT(j)]); sum += c; cnt += (c > 0u) ? 1u : 0u; mine = (j == x) ? c : mine; }
        if (sum == G) break;
        __builtin_amdgcn_s_sleep(1);
        if ((++sp & 255u) == 0u) { if (xb_ld(&bar[XB_TMO])) break; if (sp > XB_SPIN_CAP) { atomicAdd(&bar[XB_TMO], 1u); break; } }
    }
    nloc = mine > 0u ? mine : 1u; nx = cnt > 0u ? cnt : 1u;
}
__device__ __forceinline__ void xcd_barrier(const XcdBarrier& b) {
    asm volatile("s_waitcnt vmcnt(0)" ::: "memory");
    __syncthreads();
    if (threadIdx.x == 0) {
        unsigned* bar = b.bar;
        __builtin_amdgcn_s_waitcnt(0);
        unsigned nloc = b.st[0], nx = b.st[1];
        if (nloc == 0u) { xcd_barrier_complete(bar, b.x, nloc, nx); b.st[0] = nloc; b.st[1] = nx; }
        const unsigned old = xb_add(&bar[XB_XSUB(b.x)], 1u);
        const unsigned gen = old / nloc;
        if (old + 1u == (gen + 1u) * nloc) {
            __builtin_amdgcn_fence(__ATOMIC_RELEASE, "agent");
            asm volatile("s_waitcnt vmcnt(0)" ::: "memory");
            const unsigned og = xb_add(&bar[XB_TOP], 1u);
            const unsigned tg = og / nx;
            if (og + 1u == (tg + 1u) * nx) xb_add(&bar[XB_TOPGEN], 1u);
            else XB_SPIN(xb_ld(&bar[XB_TOPGEN]) == tg, bar);
            __builtin_amdgcn_fence(__ATOMIC_ACQUIRE, "agent");
            xb_add(&bar[XB_XGEN(b.x)], 1u);
            asm volatile("s_waitcnt vmcnt(0)" ::: "memory");
        } else {
            XB_SPIN(xb_ld(&bar[XB_XGEN(b.x)]) == gen, bar);
            __builtin_amdgcn_fence(__ATOMIC_ACQUIRE, "agent");
            asm volatile("s_waitcnt vmcnt(0)" ::: "memory");
        }
    }
    __syncthreads();
}

#define GAS __attribute__((address_space(1)))
struct Params { const GAS float* in[25]; GAS float* out; GAS unsigned char* ws; };
typedef const Params __attribute__((address_space(4)))* KP;
__device__ __forceinline__ KP kargs() { KP k = (KP)__builtin_amdgcn_kernarg_segment_ptr(); asm volatile("" : "+s"(k)); return k; }
__device__ __forceinline__ const float* gin(KP k, int i) { return (const float*)k->in[i]; }
__device__ __forceinline__ float* gout(KP k) { return (float*)k->out; }
__device__ __forceinline__ unsigned char* gws(KP k) { return (unsigned char*)k->ws; }
__device__ __forceinline__ int lane_id_asm() { int l; asm volatile("v_mbcnt_lo_u32_b32 %0, -1, 0\n\tv_mbcnt_hi_u32_b32 %0, -1, %0" : "=v"(l)); return l; }
__device__ __forceinline__ int launder_s(int v) { asm volatile("" : "+s"(v)); return v; }
__device__ __forceinline__ int launder_v(int v) { asm volatile("" : "+v"(v)); return v; }
enum { I_X = 0, I_MEM, I_RELB, I_FNORM, I_NFF1, I_WGU1, I_WDN1, I_NMIX, I_WIN, I_CONVW, I_CONVB, I_WA, I_BA, I_WI, I_BI, I_LAM, I_LNG, I_LNB, I_MEMNORM, I_WMKV, I_WBR, I_WOUT, I_NFF2, I_WGU2, I_WDN2 };

__device__ __forceinline__ float wave_sum(float v) {
#pragma unroll
    for (int o = 1; o < 64; o <<= 1) v += __shfl_xor(v, o);
    return v;
}
__device__ __forceinline__ f32x4 mfma16(bf16x8 a, bf16x8 b, f32x4 c) { return __builtin_amdgcn_mfma_f32_16x16x32_bf16(a, b, c, 0, 0, 0); }
__device__ __forceinline__ f32x16 mfma32(bf16x8 a, bf16x8 b, f32x16 c) { return __builtin_amdgcn_mfma_f32_32x32x16_bf16(a, b, c, 0, 0, 0); }

__device__ __forceinline__ void tr_item(const float* W, int ldw, int scol0, int nvalid, bf16* WT, int ldt, int drow0, int k0, LAS float* scr, int lane) {
    if (nvalid == 32) {
#pragma unroll
        for (int i = 0; i < 8; ++i) { const int kk = 8 * i + (lane >> 3), c4 = (lane & 7) * 4;
            const f32x4 v = *(const f32x4*)(W + (size_t)(k0 + kk) * ldw + scol0 + c4);
            LAS float* d = scr + kk * 33 + c4; d[0] = v.x; d[1] = v.y; d[2] = v.z; d[3] = v.w; }
    } else {
#pragma unroll 8
        for (int i = 0; i < 32; ++i) { const int kk = 2 * i + (lane >> 5), c = lane & 31; scr[kk * 33 + c] = (c < nvalid) ? W[(size_t)(k0 + kk) * ldw + scol0 + c] : 0.f; }
    }
    LDS_WAIT(); asm volatile("" ::: "memory");
    const int c = lane & 7;
#pragma unroll
    for (int j = 0; j < 4; ++j) { const int n = (lane >> 3) + 8 * j; const LAS float* s = scr + (8 * c) * 33 + n;
        u32x4 o; o.x = pkbf(s[0 * 33], s[1 * 33]); o.y = pkbf(s[2 * 33], s[3 * 33]); o.z = pkbf(s[4 * 33], s[5 * 33]); o.w = pkbf(s[6 * 33], s[7 * 33]);
        *(u32x4*)(WT + (size_t)(drow0 + n) * ldt + k0 + 8 * c) = o; }
    LDS_WAIT(); asm volatile("" ::: "memory");
}
__device__ __forceinline__ void tr_plain(const float* W, int K, int N, bf16* WT, int item, LAS float* scr, int lane) {
    const int nblk = N / 32, kb = item / nblk, nb = item % nblk;
    tr_item(W, N, 32 * nb, 32, WT, K, 32 * nb, 64 * kb, scr, lane);
}
__device__ __forceinline__ void tr_gu(const float* W, bf16* WT, int item, LAS float* scr, int lane) {
    const int nblk = 2 * DFF / 32, kb = item / nblk, nb = item % nblk, n0 = 32 * nb, T = n0 >> 8, wi = n0 & 255;
    const int sc = wi < 128 ? 128 * T + wi : DFF + 128 * T + (wi - 128);
    tr_item(W, 2 * DFF, sc, 32, WT, DM, n0, 64 * kb, scr, lane);
}
__device__ __forceinline__ void tr_win(const float* W, bf16* WT, int item, LAS float* scr, int lane) {
    const int nblk = DIN_PAD / 32, kb = item / nblk, nb = item % nblk, n0 = 32 * nb;
    int sc, nv;
    if (n0 < 1792) { sc = n0; nv = 32; }
    else if (n0 < 2048) { const int off = n0 - 1792; sc = 1792 + off; nv = 68 - off; nv = nv < 0 ? 0 : (nv > 32 ? 32 : nv); if (nv == 0) sc = 0; }
    else { sc = n0 - 188; nv = 32; }
    tr_item(W, DIN, sc, nv, WT, DM, n0, 64 * kb, scr, lane);
}

__device__ __forceinline__ void rms_row_bf16(const float* xrow, const float* g, bf16* orow, int lane) {
    const f32x4* xr = (const f32x4*)xrow + lane; const f32x4* gr = (const f32x4*)g + lane;
    f32x4 v[8]; float s = 0.f;
#pragma unroll
    for (int j = 0; j < 8; ++j) { v[j] = xr[64 * j]; s += (v[j].x * v[j].x + v[j].y * v[j].y) + (v[j].z * v[j].z + v[j].w * v[j].w); }
    const float rstd = 1.0f / sqrtf(wave_sum(s) * (1.0f / DM) + EPS);
    u32x2* o8 = (u32x2*)orow + lane;
#pragma unroll
    for (int j = 0; j < 8; ++j) { const f32x4 gg = gr[64 * j]; u32x2 w; w.x = pkbf(v[j].x * rstd * gg.x, v[j].y * rstd * gg.y); w.y = pkbf(v[j].z * rstd * gg.z, v[j].w * rstd * gg.w); o8[64 * j] = w; }
}
__device__ __forceinline__ void rstd_from_parts(KP p, int gt0, int gstride) {
    const float* part = (const float*)(gws(p) + WS_PART); float* rstd = (float*)(gws(p) + WS_RSTD);
    for (int row = gt0; row < M; row += gstride) {
        const f32x4* pp = (const f32x4*)(part + (size_t)row * 32);
        f32x4 a = pp[0], b = pp[1], c = pp[2], d = pp[3], e = pp[4], f = pp[5], g = pp[6], h = pp[7];
        const f32x4 t = ((a + b) + (c + d)) + ((e + f) + (g + h));
        rstd[row] = 1.0f / sqrtf(((t.x + t.y) + (t.z + t.w)) * (1.0f / DM) + EPS);
    }
}
__device__ __forceinline__ void rstd_first(KP p, int gw, int NGW, int lane) {
    const float* x = gin(p, I_X); bf16* xb = (bf16*)(gws(p) + WS_XB); float* rstd = (float*)(gws(p) + WS_RSTD);
    for (int m = gw; m < M; m += 4 * NGW) {
        f32x4 v[4][8];
#pragma unroll
        for (int r = 0; r < 4; ++r) { const int mr = (m + r * NGW < M) ? m + r * NGW : m; const f32x4* xr = (const f32x4*)(x + (size_t)mr * DM) + lane;
#pragma unroll
            for (int j = 0; j < 8; ++j) v[r][j] = xr[64 * j]; }
#pragma unroll
        for (int r = 0; r < 4; ++r) { float sq = 0.f;
#pragma unroll
            for (int j = 0; j < 8; ++j) sq += (v[r][j].x * v[r][j].x + v[r][j].y * v[r][j].y) + (v[r][j].z * v[r][j].z + v[r][j].w * v[r][j].w);
            const float rs = 1.0f / sqrtf(wave_sum(sq) * (1.0f / DM) + EPS);
            if (m + r * NGW < M) { if (lane == 0) rstd[m + r * NGW] = rs; u32x2* o = (u32x2*)(xb + (size_t)(m + r * NGW) * DM) + lane;
#pragma unroll
                for (int j = 0; j < 8; ++j) { u32x2 w; w.x = pkbf(v[r][j].x, v[r][j].y); w.y = pkbf(v[r][j].z, v[r][j].w); o[64 * j] = w; } } }
    }
}
__device__ __forceinline__ void rms_rows_b2b(const bf16* x, const float* g, bf16* out, int gw, int NGW, int lane) {
    f32x4 gg[4][2];
#pragma unroll
    for (int j = 0; j < 4; ++j) { gg[j][0] = *(const f32x4*)(g + 512 * j + 8 * lane); gg[j][1] = *(const f32x4*)(g + 512 * j + 8 * lane + 4); }
    for (int m = gw; m < M; m += 4 * NGW) {
        u32x4 v[4][4]; float ss[4];
#pragma unroll
        for (int r = 0; r < 4; ++r) { const int mr = (m + r * NGW < M) ? m + r * NGW : m; const u32x4* xr = (const u32x4*)(x + (size_t)mr * DM) + lane;
#pragma unroll
            for (int j = 0; j < 4; ++j) v[r][j] = xr[64 * j]; }
#pragma unroll
        for (int r = 0; r < 4; ++r) { float sq = 0.f;
#pragma unroll
            for (int j = 0; j < 4; ++j)
#pragma unroll
                for (int e = 0; e < 4; ++e) { const float a = bflo(v[r][j][e]), b2 = bfhi(v[r][j][e]); sq += a * a + b2 * b2; }
            ss[r] = 1.0f / sqrtf(wave_sum(sq) * (1.0f / DM) + EPS); }
#pragma unroll
        for (int r = 0; r < 4; ++r) if (m + r * NGW < M) { u32x4* o = (u32x4*)(out + (size_t)(m + r * NGW) * DM) + lane;
#pragma unroll
            for (int j = 0; j < 4; ++j) { u32x4 w;
                w.x = pkbf(bflo(v[r][j].x) * ss[r] * gg[j][0].x, bfhi(v[r][j].x) * ss[r] * gg[j][0].y); w.y = pkbf(bflo(v[r][j].y) * ss[r] * gg[j][0].z, bfhi(v[r][j].y) * ss[r] * gg[j][0].w);
                w.z = pkbf(bflo(v[r][j].z) * ss[r] * gg[j][1].x, bfhi(v[r][j].z) * ss[r] * gg[j][1].y); w.w = pkbf(bflo(v[r][j].w) * ss[r] * gg[j][1].z, bfhi(v[r][j].w) * ss[r] * gg[j][1].w);
                o[64 * j] = w; } }
    }
}
__device__ __forceinline__ void rms_rows_bf16(const float* x, const float* g, bf16* out, int gw, int NGW, int lane) {
    const f32x4* gr = (const f32x4*)g + lane;
    f32x4 gg[8];
#pragma unroll
    for (int j = 0; j < 8; ++j) gg[j] = gr[64 * j];
    for (int m = gw; m < M; m += 4 * NGW) {
        f32x4 v[4][8]; float ss[4];
#pragma unroll
        for (int r = 0; r < 4; ++r) { const int mr = (m + r * NGW < M) ? m + r * NGW : m; const f32x4* xr = (const f32x4*)(x + (size_t)mr * DM) + lane;
#pragma unroll
            for (int j = 0; j < 8; ++j) v[r][j] = xr[64 * j]; }
#pragma unroll
        for (int r = 0; r < 4; ++r) { float s = 0.f;
#pragma unroll
            for (int j = 0; j < 8; ++j) s += (v[r][j].x * v[r][j].x + v[r][j].y * v[r][j].y) + (v[r][j].z * v[r][j].z + v[r][j].w * v[r][j].w);
            ss[r] = 1.0f / sqrtf(wave_sum(s) * (1.0f / DM) + EPS); }
#pragma unroll
        for (int r = 0; r < 4; ++r) if (m + r * NGW < M) { u32x2* o = (u32x2*)(out + (size_t)(m + r * NGW) * DM) + lane;
#pragma unroll
            for (int j = 0; j < 8; ++j) { u32x2 w; w.x = pkbf(v[r][j].x * ss[r] * gg[j].x, v[r][j].y * ss[r] * gg[j].y); w.y = pkbf(v[r][j].z * ss[r] * gg[j].z, v[r][j].w * ss[r] * gg[j].w); o[64 * j] = w; } }
    }
}
__device__ __forceinline__ void rms_row_f32(const float* xrow, const float* g, float* orow, int lane) {
    const f32x4* xr = (const f32x4*)xrow + lane; const f32x4* gr = (const f32x4*)g + lane;
    f32x4 v[8]; float s = 0.f;
#pragma unroll
    for (int j = 0; j < 8; ++j) { v[j] = xr[64 * j]; s += (v[j].x * v[j].x + v[j].y * v[j].y) + (v[j].z * v[j].z + v[j].w * v[j].w); }
    const float rstd = 1.0f / sqrtf(wave_sum(s) * (1.0f / DM) + EPS);
    f32x4* o = (f32x4*)orow + lane;
#pragma unroll
    for (int j = 0; j < 8; ++j) { const f32x4 gg = gr[64 * j]; o[64 * j] = v[j] * rstd * gg; }
}

template <class SC> __device__ __forceinline__ void tr_wg_item(const float* W, int ldw, SC scol, bf16* WT, int ldt, int drow0, int k0, LAS unsigned char* ldsb, int tid, int lane, int wave, const float* ksc = nullptr) {
    LAS float* tile = (LAS float*)ldsb;
    const int run = lane >> 3, c4 = (lane & 7) * 4;
    int sc, nv; scol(run, sc, nv);
    f32x4 v[16];
#pragma unroll
    for (int i = 0; i < 16; ++i) { const int kk = wave * 16 + i;
        v[i] = (f32x4){0.f, 0.f, 0.f, 0.f};
        if (nv == 32) v[i] = *(const f32x4*)(W + (size_t)(k0 + kk) * ldw + sc + c4);
        else { const float* src = W + (size_t)(k0 + kk) * ldw + sc; if (c4 + 0 < nv) v[i].x = src[c4]; if (c4 + 1 < nv) v[i].y = src[c4 + 1]; if (c4 + 2 < nv) v[i].z = src[c4 + 2]; if (c4 + 3 < nv) v[i].w = src[c4 + 3]; } }
    if (ksc) {
#pragma unroll
        for (int i = 0; i < 16; ++i) v[i] = v[i] * ksc[k0 + wave * 16 + i]; }
#pragma unroll
    for (int i = 0; i < 16; ++i) { LAS float* o = tile + (wave * 16 + i) * 257 + run * 32 + c4; o[0] = v[i].x; o[1] = v[i].y; o[2] = v[i].z; o[3] = v[i].w; }
    __syncthreads();
    const int c = lane & 15;
#pragma unroll
    for (int j = 0; j < 8; ++j) { const int n = wave * 32 + (lane >> 4) + 4 * j; const LAS float* s = tile + (8 * c) * 257 + n;
        u32x4 o; o.x = pkbf(s[0 * 257], s[1 * 257]); o.y = pkbf(s[2 * 257], s[3 * 257]); o.z = pkbf(s[4 * 257], s[5 * 257]); o.w = pkbf(s[6 * 257], s[7 * 257]);
        *(u32x4*)(WT + (size_t)(drow0 + n) * ldt + k0 + 8 * c) = o; }
    __syncthreads();
}
struct ScPlain { int n0; __device__ __forceinline__ void operator()(int run, int& sc, int& nv) const { sc = n0 + 32 * run; nv = 32; } };
struct ScGu { int T; __device__ __forceinline__ void operator()(int run, int& sc, int& nv) const { sc = run < 4 ? 128 * T + 32 * run : DFF + 128 * T + 32 * (run - 4); nv = 32; } };
struct ScWin { int n0; __device__ __forceinline__ void operator()(int run, int& sc, int& nv) const { const int r0 = n0 + 32 * run;
    if (r0 < 1792) { sc = r0; nv = 32; } else if (r0 < 2048) { const int off = r0 - 1792; sc = 1792 + off; nv = 68 - off; nv = nv < 0 ? 0 : (nv > 32 ? 32 : nv); if (nv == 0) sc = 0; } else { sc = r0 - 188; nv = 32; } } };
struct CvD { const float* src; bf16* dst; const float* ksc; int ldw, nv, ldt; };
template <class SC> __device__ __forceinline__ CvD cvd_make(const float* W, int ldw, SC scol, bf16* WT, int ldt, int drow0, int k0, int lane, int wave, const float* ksc = nullptr) {
    int sc, nv; scol(lane >> 3, sc, nv);
    return CvD{W + (size_t)(k0 + wave * 16) * ldw + sc + (lane & 7) * 4, WT + (size_t)drow0 * ldt + k0, ksc ? ksc + k0 + wave * 16 : nullptr, ldw, nv, ldt};
}
__device__ __forceinline__ CvD cv_decode(KP p, int l, int it, int lane, int wave) {
    unsigned char* ws = gws(p);
    constexpr int J_GU = (DM / 128) * (2 * DFF / 256), J_DN = (DFF / 128) * (DM / 256), J_IN = (DM / 128) * (DIN_PAD / 256), J_SQ = (DM / 128) * (DM / 256), J_BR = (1024 / 128) * (DM / 256);
    int r = it;
    if (r < 2 * J_GU) { const bool sec = r >= J_GU; r -= sec ? J_GU : 0; const int nb = r % (2 * DFF / 256), kb = r / (2 * DFF / 256);
        return cvd_make(gin(p, sec ? I_WGU2 : I_WGU1) + (size_t)l * DM * 2 * DFF, 2 * DFF, ScGu{nb}, (bf16*)(ws + (sec ? WS_WGU2 : WS_WGU)), DM, 256 * nb, 128 * kb, lane, wave, gin(p, sec ? I_NFF2 : I_NFF1) + (size_t)l * DM); }
    r -= 2 * J_GU;
    if (r < 2 * J_DN) { const bool sec = r >= J_DN; r -= sec ? J_DN : 0; const int nb = r % (DM / 256), kb = r / (DM / 256);
        return cvd_make(gin(p, sec ? I_WDN2 : I_WDN1) + (size_t)l * DFF * DM, DM, ScPlain{256 * nb}, (bf16*)(ws + (sec ? WS_WDN2 : WS_WDN)), DFF, 256 * nb, 128 * kb, lane, wave); }
    r -= 2 * J_DN;
    if (r < J_IN) { const int nb = r % (DIN_PAD / 256), kb = r / (DIN_PAD / 256);
        return cvd_make(gin(p, I_WIN) + (size_t)l * DM * DIN, DIN, ScWin{256 * nb}, (bf16*)(ws + WS_WIN), DM, 256 * nb, 128 * kb, lane, wave, gin(p, I_NMIX) + (size_t)l * DM); }
    r -= J_IN;
    if (r < 2 * J_SQ) { const bool sec = r >= J_SQ; r -= sec ? J_SQ : 0; const int nb = r % (DM / 256), kb = r / (DM / 256);
        return cvd_make(gin(p, sec ? I_WOUT : I_WMKV) + (size_t)l * DM * DM, DM, ScPlain{256 * nb}, (bf16*)(ws + (sec ? WS_WOUT : WS_WMKV)), DM, 256 * nb, 128 * kb, lane, wave); }
    r -= 2 * J_SQ;
    { const int j = r / J_BR, rr = r % J_BR, nb = rr % (DM / 256), kb = rr / (DM / 256);
      return cvd_make(gin(p, I_WBR) + ((size_t)l * 3 + j) * 1024 * DM, DM, ScPlain{256 * nb}, (bf16*)(ws + WS_WBR) + (size_t)j * 1024, 3072  , 256 * nb, 128 * kb, lane, wave); }
}
__device__ __forceinline__ void cv_load(const CvD& d, f32x4 (&v)[16], int lane) {
    const int c4 = (lane & 7) * 4;
#pragma unroll
    for (int i = 0; i < 16; ++i) { const float* src = d.src + (size_t)i * d.ldw;
        if (d.nv == 32) v[i] = *(const f32x4*)src;
        else { v[i] = (f32x4){0.f, 0.f, 0.f, 0.f}; if (c4 + 0 < d.nv) v[i].x = src[0]; if (c4 + 1 < d.nv) v[i].y = src[1]; if (c4 + 2 < d.nv) v[i].z = src[2]; if (c4 + 3 < d.nv) v[i].w = src[3]; } }
}
__device__ __forceinline__ void cv_store(const CvD& d, const f32x4 (&v)[16], LAS unsigned char* ldsb, int lane, int wave) {
    LAS float* tile = (LAS float*)ldsb;
    const int run = lane >> 3, c4 = (lane & 7) * 4;
#pragma unroll
    for (int i = 0; i < 16; ++i) { const float sc_ = d.ksc ? d.ksc[i] : 1.0f; LAS float* o = tile + (wave * 16 + i) * 257 + run * 32 + c4; o[0] = v[i].x * sc_; o[1] = v[i].y * sc_; o[2] = v[i].z * sc_; o[3] = v[i].w * sc_; }
    __syncthreads();
    const int c = lane & 15;
#pragma unroll
    for (int j = 0; j < 8; ++j) { const int n = wave * 32 + (lane >> 4) + 4 * j; const LAS float* s = tile + (8 * c) * 257 + n;
        u32x4 o; o.x = pkbf(s[0 * 257], s[1 * 257]); o.y = pkbf(s[2 * 257], s[3 * 257]); o.z = pkbf(s[4 * 257], s[5 * 257]); o.w = pkbf(s[6 * 257], s[7 * 257]);
        *(u32x4*)(d.dst + (size_t)n * d.ldt + 8 * c) = o; }
    __syncthreads();
}
__device__ __forceinline__ void phase_cvt(KP p, int l, LAS unsigned char* lds, int vcu_, int G, int gw, int NGW, int wave, int lane_) {
    const int vcu = launder_s(vcu_), lane = launder_v(lane_), tid = wave * 64 + lane; (void)tid;
    unsigned char* ws = gws(p);
    constexpr int J_GU = (DM / 128) * (2 * DFF / 256), J_DN = (DFF / 128) * (DM / 256), J_IN = (DM / 128) * (DIN_PAD / 256), J_SQ = (DM / 128) * (DM / 256), J_BR = (1024 / 128) * (DM / 256);
    constexpr int NJ = 2 * J_GU + 2 * J_DN + J_IN + 2 * J_SQ + 3 * J_BR;
    if (vcu < NJ) {
        CvD dA = cv_decode(p, l, vcu, lane, wave), dB = dA; f32x4 vA[16], vB[16];
        cv_load(dA, vA, lane);
        for (int it = vcu; it < NJ; it += 2 * G) {
            const bool hasB = it + G < NJ;
            if (hasB) { dB = cv_decode(p, l, it + G, lane, wave); cv_load(dB, vB, lane); }
            cv_store(dA, vA, lds, lane, wave);
            const bool hasA = it + 2 * G < NJ;
            if (hasA) { dA = cv_decode(p, l, it + 2 * G, lane, wave); cv_load(dA, vA, lane); }
            if (hasB) cv_store(dB, vB, lds, lane, wave);
        }
    }
    { __syncthreads(); LAS float* scr = (LAS float*)(lds + wave * 8704);
      for (int it = gw; it < 16 * 8; it += NGW) { const int mtx = it >> 3, n = mtx & 7; const bool isI = mtx >= 8;
          tr_plain(gin(p, isI ? I_WI : I_WA) + ((size_t)l * 8 + n) * 128 * 128, 128, 128, (bf16*)(ws + (isI ? WS_WIT : WS_WAT)) + (size_t)n * 128 * 128, it & 7, scr, lane); } }
    for (int m = gw; m < BATCH * NMEM; m += NGW) rms_row_bf16(gin(p, I_MEM) + (size_t)m * DM, gin(p, I_MEMNORM) + (size_t)l * DM, (bf16*)(ws + WS_MEMN) + (size_t)m * DM, lane);
}

__device__ __forceinline__ float row_bcast15(float v) { return __builtin_bit_cast(float, __builtin_amdgcn_update_dpp(0, __builtin_bit_cast(int, v), 0x15F, 0xF, 0xF, false)); }
__device__ __forceinline__ float xmax32(float v) { auto rr = __builtin_amdgcn_permlane32_swap(__float_as_uint(v), __float_as_uint(v), false, false); return fmaxf(__uint_as_float(rr[0]), __uint_as_float(rr[1])); }
__device__ __forceinline__ float xadd32(float v) { auto rr = __builtin_amdgcn_permlane32_swap(__float_as_uint(v), __float_as_uint(v), false, false); return __uint_as_float(rr[0]) + __uint_as_float(rr[1]); }
__device__ __forceinline__ unsigned xor32_or(unsigned v) { auto rr = __builtin_amdgcn_permlane32_swap(v, v, false, false); return rr[0] | rr[1]; }
__device__ __forceinline__ unsigned xor16_or(unsigned v) { auto rr = __builtin_amdgcn_permlane16_swap(v, v, false, false); return rr[0] | rr[1]; }
template <int N> __device__ __forceinline__ float dpp_shr(float v, float ident) {
    return __builtin_bit_cast(float, __builtin_amdgcn_update_dpp(__builtin_bit_cast(int, ident), __builtin_bit_cast(int, v), 0x110 + N, 0xF, 0xF, false));
}
__device__ __forceinline__ float fsig(float x) { return __builtin_amdgcn_rcpf(1.0f + __builtin_amdgcn_exp2f(-LOG2E * x)); }
__device__ __forceinline__ float gelu_tanh(float x) {
    const float z = 0.7978845608028654f * (x + 0.044715f * x * x * x);
    const float e = __builtin_amdgcn_exp2f(2.0f * LOG2E * z);
    const float t = 1.0f - 2.0f * __builtin_amdgcn_rcpf(e + 1.0f);
    return 0.5f * x * (1.0f + t);
}

__device__ __forceinline__ void kidx_ln_quarter(KP p, int l, int gt) {
    const int row = gt >> 2, q = gt & 3;
    const float* s = (const float*)(gws(p) + WS_SIDE) + (size_t)row * 72 + 16 * q;
    const float* g = gin(p, I_LNG) + l * 64 + 16 * q; const float* be = gin(p, I_LNB) + l * 64 + 16 * q;
    f32x4 v[4]; float mu = 0.f;
#pragma unroll
    for (int i = 0; i < 4; ++i) { v[i] = *(const f32x4*)(s + 4 * i); mu += (v[i].x + v[i].y) + (v[i].z + v[i].w); }
    mu += __shfl_xor(mu, 1); mu += __shfl_xor(mu, 2); mu *= (1.0f / 64.0f);
    float var = 0.f;
#pragma unroll
    for (int i = 0; i < 4; ++i) { v[i] = v[i] - mu; var += (v[i].x * v[i].x + v[i].y * v[i].y) + (v[i].z * v[i].z + v[i].w * v[i].w); }
    var += __shfl_xor(var, 1); var += __shfl_xor(var, 2);
    const float rstd = 1.0f / sqrtf(var * (1.0f / 64.0f) + EPS);
    bf16* o = (bf16*)(gws(p) + WS_KIDX) + (size_t)(row >> 4) * 1024 + (q >> 1) * 512 + ((2 * (q & 1)) * 16 + (row & 15)) * 8;
    unsigned w[8];
#pragma unroll
    for (int i = 0; i < 4; ++i) { const f32x4 gg = *(const f32x4*)(g + 4 * i), bb = *(const f32x4*)(be + 4 * i);
        w[2 * i] = pkbf(v[i].x * rstd * gg.x + bb.x, v[i].y * rstd * gg.y + bb.y); w[2 * i + 1] = pkbf(v[i].z * rstd * gg.z + bb.z, v[i].w * rstd * gg.w + bb.w); }
    *(u32x4*)o = (u32x4){w[0], w[1], w[2], w[3]}; *(u32x4*)(o + 128) = (u32x4){w[4], w[5], w[6], w[7]};
    if (q == 0) { const f32x4 wv = *(const f32x4*)(s + 64); *(f32x4*)((float*)(gws(p) + WS_WIDX) + (size_t)row * 4) = wv * 0.0625f; }
}

__device__ __forceinline__ void vt_item(KP p, int item, LAS unsigned char* scrb, int lane) {
    const int db = item & 1, tb = (item >> 1) & 127, kvh = (item >> 8) & 1, b = item >> 9;
    const bf16* P = (const bf16*)(gws(p) + WS_R1);
    LAS unsigned short* scr = (LAS unsigned short*)scrb;
#pragma unroll
    for (int i = 0; i < 8; ++i) {
        const int t = 8 * i + (lane >> 3), ch = lane & 7;
        const u32x4 v = *(const u32x4*)(P + (size_t)(b * SEQ + tb * 64 + t) * PLD + C_VA + kvh * 128 + db * 64 + 8 * ch);
        const unsigned w[4] = {v.x, v.y, v.z, v.w};
#pragma unroll
        for (int j = 0; j < 4; ++j) { scr[(8 * ch + 2 * j) * 66 + t] = (unsigned short)(w[j] & 0xffff); scr[(8 * ch + 2 * j + 1) * 66 + t] = (unsigned short)(w[j] >> 16); }
    }
    LDS_WAIT(); asm volatile("" ::: "memory");
    bf16* VT = (bf16*)(gws(p) + WS_VT);
#pragma unroll
    for (int i = 0; i < 8; ++i) {
        const int d = 8 * i + (lane >> 3), ch = lane & 7;
        const LAS unsigned* s = (const LAS unsigned*)(scr + d * 66 + 8 * ch);
        u32x4 o; o.x = s[0]; o.y = s[1]; o.z = s[2]; o.w = s[3];
        *(u32x4*)(VT + (((size_t)((b * 2 + kvh) * 128 + tb)) * 128 + db * 64 + d) * 64 + 8 * ch) = o;
    }
    LDS_WAIT(); asm volatile("" ::: "memory");
}

__device__ __forceinline__ void scan16x4(float& a0, float& a1, float& a2, float& a3, float& u0, float& u1, float& u2, float& u3) {
#define LRU_ST(N) \
    "v_fmac_f32_dpp %4, %4, %0 row_shr:" #N " row_mask:0xf bank_mask:0xf\n\t" "v_fmac_f32_dpp %5, %5, %1 row_shr:" #N " row_mask:0xf bank_mask:0xf\n\t" \
    "v_fmac_f32_dpp %6, %6, %2 row_shr:" #N " row_mask:0xf bank_mask:0xf\n\t" "v_fmac_f32_dpp %7, %7, %3 row_shr:" #N " row_mask:0xf bank_mask:0xf\n\t" \
    "v_mul_f32_dpp %0, %0, %0 row_shr:" #N " row_mask:0xf bank_mask:0xf\n\t" "v_mul_f32_dpp %1, %1, %1 row_shr:" #N " row_mask:0xf bank_mask:0xf\n\t" \
    "v_mul_f32_dpp %2, %2, %2 row_shr:" #N " row_mask:0xf bank_mask:0xf\n\t" "v_mul_f32_dpp %3, %3, %3 row_shr:" #N " row_mask:0xf bank_mask:0xf\n\t"
    asm volatile("s_nop 1\n\t" LRU_ST(1) LRU_ST(2) LRU_ST(4) LRU_ST(8) : "+v"(a0), "+v"(a1), "+v"(a2), "+v"(a3), "+v"(u0), "+v"(u1), "+v"(u2), "+v"(u3));
#undef LRU_ST
}
constexpr int LR_WA = 0, LR_WI = 34816, LR_PAR = 69632, LR_COMP = LR_PAR + 9 * 512, LR_XT = 83968, LR_XTB = 33536;
__device__ __forceinline__ void lru_job(KP p, int l, int jb, LAS unsigned char* lds, int tid, int lane, int wave) {
    const int n = jb & 7, jj = jb >> 3, b = jj >> 4, tile0 = 4 * (jj & 15), tok = lane & 15, h = lane >> 4;
    const bf16* P = (const bf16*)(gws(p) + WS_R1);
    float* aggA = (float*)(gws(p) + WS_AGG); float* aggH = aggA + (size_t)BATCH * 64 * 1024;
    unsigned* LRS = (unsigned*)(gws(p) + WS_LRS);
    LAS float* par = (LAS float*)(lds + LR_PAR);
    LAS float* compA = (LAS float*)(lds + LR_COMP); LAS float* compH = compA + 1024;
    __syncthreads();
    {
        const bf16* waT = (const bf16*)(gws(p) + WS_WAT) + (size_t)n * 128 * 128; const bf16* wiT = (const bf16*)(gws(p) + WS_WIT) + (size_t)n * 128 * 128;
#pragma unroll
        for (int i = 0; i < 4; ++i) { const int ci = tid + 512 * i, r = ci >> 4, ch = ci & 15;
            *(LAS u32x4*)(lds + LR_WA + r * 272 + ch * 16) = *(const u32x4*)(waT + r * 128 + ch * 8);
            *(LAS u32x4*)(lds + LR_WI + r * 272 + ch * 16) = *(const u32x4*)(wiT + r * 128 + ch * 8); }
        if (tid < 128) { const int c = n * 128 + tid;
            par[tid] = -8.0f * LOG2E * log1pf(expf(-gin(p, I_LAM)[(size_t)l * 1024 + c]));
            par[128 + tid] = gin(p, I_BA)[(size_t)l * 1024 + c]; par[256 + tid] = gin(p, I_BI)[(size_t)l * 1024 + c]; par[384 + tid] = gin(p, I_CONVB)[(size_t)l * 1024 + c];
#pragma unroll
            for (int j = 0; j < 4; ++j) par[512 + 128 * j + tid] = gin(p, I_CONVW)[((size_t)l * 4 + j) * 1024 + c]; }
#define LRU_XLOAD(TT) do { const int t0_ = (tile0 + (TT)) * 128 - 3; _Pragma("unroll") for (int i = 0; i < 5; ++i) { const int q = tid + 512 * i, r = q >> 4, c = q & 15; xr[i] = (u32x4){0u, 0u, 0u, 0u}; \
            if (q < 131 * 16 && t0_ + r >= 0) xr[i] = *(const u32x4*)(P + ((size_t)b * SEQ + t0_ + r) * PLD + C_XL + n * 128 + 8 * c); } } while (0)
#define LRU_XSTORE(BUF) do { _Pragma("unroll") for (int i = 0; i < 5; ++i) { const int q = tid + 512 * i, r = q >> 4, c = q & 15; \
            if (q < 131 * 16) *(LAS u32x4*)(lds + LR_XT + (BUF) * LR_XTB + r * 256 + ((c ^ (r & 15)) << 4)) = xr[i]; } } while (0)
        { u32x4 xr[5]; LRU_XLOAD(0); LRU_XSTORE(0); }
        __syncthreads();
    }
#pragma unroll 1
    for (int tt = 0; tt < 4; ++tt) {
        u32x4 xr[5];
        if (tt < 3) LRU_XLOAD(tt + 1);
        const int tile = tile0 + tt, t = tile * 128 + wave * 16 + tok; const size_t row = (size_t)b * SEQ + t;
        const int hofs = launder_v(4 * h);
        float xc[4][2][4]; bf16x8 xb[4];
        const LAS unsigned char* xtb = lds + LR_XT + (tt & 1) * LR_XTB;
#pragma unroll
        for (int ks = 0; ks < 4; ++ks) {
#pragma unroll
            for (int hf = 0; hf < 2; ++hf) {
                const int cl = 32 * ks + 16 * hf + hofs;
                f32x4 a = *(const LAS f32x4*)(par + 384 + cl);
#pragma unroll
                for (int j = 0; j < 4; ++j) {
                    const int rj = tok + j;
                    const u32x2 xv = *(const LAS u32x2*)(xtb + (wave * 16 + rj) * 256 + (((4 * ks + 2 * hf + (h >> 1)) ^ (rj & 15)) << 4) + 8 * (h & 1));
                    const f32x4 cw = *(const LAS f32x4*)(par + 512 + 128 * j + cl);
                    a.x += cw.x * bflo(xv.x); a.y += cw.y * bfhi(xv.x); a.z += cw.z * bflo(xv.y); a.w += cw.w * bfhi(xv.y);
                }
                xc[ks][hf][0] = a.x; xc[ks][hf][1] = a.y; xc[ks][hf][2] = a.z; xc[ks][hf][3] = a.w;
            }
            u32x4 w; w.x = pkbf(xc[ks][0][0], xc[ks][0][1]); w.y = pkbf(xc[ks][0][2], xc[ks][0][3]); w.z = pkbf(xc[ks][1][0], xc[ks][1][1]); w.w = pkbf(xc[ks][1][2], xc[ks][1][3]);
            xb[ks] = __builtin_bit_cast(bf16x8, w);
        }
        float acum[8][4], hloc[8][4];
#pragma unroll
        for (int dt = 0; dt < 8; ++dt) {
            f32x4 acca = {0.f, 0.f, 0.f, 0.f}, acci = {0.f, 0.f, 0.f, 0.f};
            const LAS unsigned char* wa = lds + LR_WA + (16 * dt + tok) * 272 + 2 * hofs; const LAS unsigned char* wi = lds + LR_WI + (16 * dt + tok) * 272 + 2 * hofs;
#pragma unroll
            for (int ks = 0; ks < 4; ++ks) {
                const u32x2 a0 = *(const LAS u32x2*)(wa + 64 * ks), a1 = *(const LAS u32x2*)(wa + 64 * ks + 32);
                const u32x2 i0 = *(const LAS u32x2*)(wi + 64 * ks), i1 = *(const LAS u32x2*)(wi + 64 * ks + 32);
                const u32x4 fa = {a0.x, a0.y, a1.x, a1.y}, fi = {i0.x, i0.y, i1.x, i1.y};
                acca = mfma16(__builtin_bit_cast(bf16x8, fa), xb[ks], acca);
                acci = mfma16(__builtin_bit_cast(bf16x8, fi), xb[ks], acci);
            }
            const int cl0 = 16 * dt + hofs;
            const f32x4 vsp = *(const LAS f32x4*)(par + cl0), vba = *(const LAS f32x4*)(par + 128 + cl0), vbi = *(const LAS f32x4*)(par + 256 + cl0);
            float av[4], uv[4];
#pragma unroll
            for (int r = 0; r < 4; ++r) {
                const float rg = fsig(acca[r] + vba[r]), ig = fsig(acci[r] + vbi[r]);
                const float l2a = rg * vsp[r];
                const float a = __builtin_amdgcn_exp2f(l2a);
                const float x2 = 2.0f * 0.6931471805599453f * l2a;
                float om_s = -x2 * (1.0f + x2 * (0.5f + x2 * (0.16666667f + x2 * 0.041666668f))), om_l = 1.0f - a * a;
                asm volatile("" : "+v"(om_s), "+v"(om_l));
                const float om = (x2 > -0.06f) ? om_s : om_l;
                av[r] = a; uv[r] = __builtin_amdgcn_sqrtf(fmaxf(om, 0.f)) * (ig * xc[dt >> 1][dt & 1][r]);
            }
            scan16x4(av[0], av[1], av[2], av[3], uv[0], uv[1], uv[2], uv[3]);
#pragma unroll
            for (int r = 0; r < 4; ++r) { acum[dt][r] = av[r]; hloc[dt][r] = uv[r]; }
            if (tok == 15) { *(LAS f32x4*)(compA + wave * 128 + cl0) = (f32x4){av[0], av[1], av[2], av[3]}; *(LAS f32x4*)(compH + wave * 128 + cl0) = (f32x4){uv[0], uv[1], uv[2], uv[3]}; }
        }
        __syncthreads();
#pragma unroll
        for (int dt = 0; dt < 8; ++dt) {
            const int cl0 = 16 * dt + hofs;
            f32x4 cin = {0.f, 0.f, 0.f, 0.f}, pa = {1.f, 1.f, 1.f, 1.f};
            for (int w2 = 0; w2 < wave; ++w2) { const f32x4 ca = *(const LAS f32x4*)(compA + w2 * 128 + cl0), chh = *(const LAS f32x4*)(compH + w2 * 128 + cl0); cin = ca * cin + chh; pa = pa * ca; }
            f32x4 A, H;
#pragma unroll
            for (int r = 0; r < 4; ++r) { A[r] = acum[dt][r] * pa[r]; H[r] = acum[dt][r] * cin[r] + hloc[dt][r]; }
            *(u32x4*)(LRS + row * 1024 + n * 128 + cl0) = (u32x4){pkbf(A[0], H[0]), pkbf(A[1], H[1]), pkbf(A[2], H[2]), pkbf(A[3], H[3])};
            if (wave == 7 && tok == 15) { const size_t o = ((size_t)b * 64 + tile) * 1024 + n * 128 + cl0; *(f32x4*)(aggA + o) = A; *(f32x4*)(aggH + o) = H; }
        }
        if (tt < 3) LRU_XSTORE((tt + 1) & 1);
        __syncthreads();
    }
}
#undef LRU_XLOAD
#undef LRU_XSTORE
__device__ __forceinline__ void lru_apply_job(KP p, int jb, LAS unsigned char* lds, int tid, int lane_, int wave, bf16* OB, int old) {
    const int lane = launder_v(lane_);
    const int half = jb & 1, tile = (jb >> 1) & 63, b = jb >> 7;
    const float* aggA = (const float*)(gws(p) + WS_AGG); const float* aggH = aggA + (size_t)BATCH * 64 * 1024;
    const unsigned* LRS = (const unsigned*)(gws(p) + WS_LRS);
    const bf16* P = (const bf16*)(gws(p) + WS_R1);
    LAS float* carry = (LAS float*)lds;
    __syncthreads();
    {
        const float* pa = aggA + (size_t)b * 64 * 1024 + half * 512 + tid; const float* ph = aggH + (size_t)b * 64 * 1024 + half * 512 + tid;
        float a[64], hh[64];
#pragma unroll
        for (int j = 0; j < 64; ++j) { const bool ok = j < tile; const int ic = ok ? j : 0; a[j] = pa[(size_t)ic * 1024]; hh[j] = ph[(size_t)ic * 1024]; if (!ok) { a[j] = 1.f; hh[j] = 0.f; } }
        float C = 0.f;
#pragma unroll
        for (int j = 0; j < 64; ++j) C = a[j] * C + hh[j];
        carry[tid] = C;
    }
    __syncthreads();
    const f32x4 c0 = *(const LAS f32x4*)(carry + 8 * lane), c1 = *(const LAS f32x4*)(carry + 8 * lane + 4);
    const size_t row0 = (size_t)b * SEQ + tile * 128 + wave * 16; const int c = half * 512 + 8 * lane;
#pragma unroll 1
    for (int r0 = 0; r0 < 16; r0 += 8) {
        u32x4 s0[8], s1[8], gv[8];
#pragma unroll
        for (int i = 0; i < 8; ++i) { const size_t row = row0 + r0 + i; const u32x4* sp = (const u32x4*)(LRS + row * 1024 + c); s0[i] = sp[0]; s1[i] = sp[1]; gv[i] = *(const u32x4*)(P + row * PLD + C_GL + c); }
#pragma unroll
        for (int i = 0; i < 8; ++i) { const size_t row = row0 + r0 + i;
            float y[8];
#pragma unroll
            for (int k = 0; k < 4; ++k) { y[k] = bflo(s0[i][k]) * c0[k] + bfhi(s0[i][k]); y[4 + k] = bflo(s1[i][k]) * c1[k] + bfhi(s1[i][k]); }
            u32x4 w;
#pragma unroll
            for (int k = 0; k < 4; ++k) w[k] = pkbf(y[2 * k] * gelu_tanh(bflo(gv[i][k])), y[2 * k + 1] * gelu_tanh(bfhi(gv[i][k])));
            *(u32x4*)(OB + row * old + c) = w; }
    }
}

__device__ __forceinline__ void memattn_job(KP p, int pp, LAS unsigned char* lds, int tid, int lane_, int wave, bf16* OB, int old) {
    const int lane = launder_v(lane_);
    const int hd = pp & 3, b = (pp >> 2) & 1, j0 = pp >> 3, tok = lane & 15, h = lane >> 4;
    const bf16* P = (const bf16*)(gws(p) + WS_R1);
    const bf16* MK = (const bf16*)(gws(p) + WS_MK); const bf16* VTM = (const bf16*)(gws(p) + WS_VTM);
    __syncthreads();
#pragma unroll
    for (int i = 0; i < 16; ++i) { const int ci = tid + 512 * i, m = ci >> 5, c = ci & 31;
        *(LAS u32x4*)(lds + m * 512 + ((c ^ (m & 15)) << 4)) = *(const u32x4*)(MK + (size_t)(b * 256 + m) * 1024 + hd * 256 + c * 8); }
    const size_t rowA = (size_t)b * SEQ + j0 * 128 + wave * 16 + tok, rowB = rowA + 32 * 128;
    bf16x8 qfA[8], qfB[8];
#pragma unroll
    for (int ks = 0; ks < 8; ++ks) qfA[ks] = *(const bf16x8*)(P + rowA * PLD + C_QM + hd * 256 + 32 * ks + 8 * h);
    unsigned ka[8];
#pragma unroll
    for (int ks = 0; ks < 8; ++ks) ka[ks] = (unsigned)launder_v(tok * 512 + (((4 * ks + h) ^ tok) << 4));
    __syncthreads();
    bf16x8 pfA[8], pfB[8]; float invA, invB;
#define MA_QK(QF, PF, INV) do { f32x4 S[16]; \
        _Pragma("unroll") for (int mt = 0; mt < 16; ++mt) { f32x4 acc = {0.f, 0.f, 0.f, 0.f}; \
            _Pragma("unroll") for (int ks = 0; ks < 8; ++ks) acc = mfma16(*(const LAS bf16x8*)(lds + ka[ks] + mt * 8192), QF[ks], acc); \
            S[mt] = acc; } \
        float mx = -3.0e38f; \
        _Pragma("unroll") for (int mt = 0; mt < 16; ++mt) _Pragma("unroll") for (int r = 0; r < 4; ++r) mx = fmaxf(mx, S[mt][r]); \
        mx = fmaxf(mx, __shfl_xor(mx, 16)); mx = fmaxf(mx, __shfl_xor(mx, 32)); \
        const float sc = 0.0625f * LOG2E; float sum = 0.f; \
        _Pragma("unroll") for (int mt = 0; mt < 16; ++mt) _Pragma("unroll") for (int r = 0; r < 4; ++r) { const float e = __builtin_amdgcn_exp2f((S[mt][r] - mx) * sc); S[mt][r] = e; sum += e; } \
        sum += __shfl_xor(sum, 16); sum += __shfl_xor(sum, 32); INV = 1.0f / sum; \
        _Pragma("unroll") for (int T = 0; T < 8; ++T) { u32x4 w; w.x = pkbf(S[2 * T][0], S[2 * T][1]); w.y = pkbf(S[2 * T][2], S[2 * T][3]); w.z = pkbf(S[2 * T + 1][0], S[2 * T + 1][1]); w.w = pkbf(S[2 * T + 1][2], S[2 * T + 1][3]); \
            PF[T] = __builtin_bit_cast(bf16x8, w); } } while (0)
    MA_QK(qfA, pfA, invA);
    asm volatile("" ::: "memory");
#pragma unroll
    for (int ks = 0; ks < 8; ++ks) qfB[ks] = *(const bf16x8*)(P + rowB * PLD + C_QM + hd * 256 + 32 * ks + 8 * h);
    MA_QK(qfB, pfB, invB);
#undef MA_QK
    __syncthreads();
#pragma unroll
    for (int i = 0; i < 16; ++i) { const int ci = tid + 512 * i, d = ci >> 5, c = ci & 31;
        *(LAS u32x4*)(lds + d * 512 + ((c ^ (d & 15)) << 4)) = *(const u32x4*)(VTM + (size_t)(hd * 256 + d) * 512 + b * 256 + c * 8); }
    unsigned va[8][2];
#pragma unroll
    for (int T = 0; T < 8; ++T) { va[T][0] = (unsigned)launder_v(tok * 512 + 8 * (h & 1) + (((4 * T + (h >> 1)) ^ tok) << 4)); va[T][1] = (unsigned)launder_v(tok * 512 + 8 * (h & 1) + (((4 * T + 2 + (h >> 1)) ^ tok) << 4)); }
    __syncthreads();
#pragma unroll 2
    for (int dt = 0; dt < 16; ++dt) {
        f32x4 accA = {0.f, 0.f, 0.f, 0.f}, accB = {0.f, 0.f, 0.f, 0.f};
#pragma unroll
        for (int T = 0; T < 8; ++T) { const u32x2 v0 = *(const LAS u32x2*)(lds + va[T][0] + dt * 8192), v1 = *(const LAS u32x2*)(lds + va[T][1] + dt * 8192); const u32x4 f = {v0.x, v0.y, v1.x, v1.y};
            accA = mfma16(__builtin_bit_cast(bf16x8, f), pfA[T], accA); accB = mfma16(__builtin_bit_cast(bf16x8, f), pfB[T], accB); }
        u32x2 w; w.x = pkbf(accA[0] * invA, accA[1] * invA); w.y = pkbf(accA[2] * invA, accA[3] * invA);
        *(u32x2*)(OB + rowA * old + hd * 256 + 16 * dt + 4 * h) = w;
        w.x = pkbf(accB[0] * invB, accB[1] * invB); w.y = pkbf(accB[2] * invB, accB[3] * invB);
        *(u32x2*)(OB + rowB * old + hd * 256 + 16 * dt + 4 * h) = w;
    }
}

struct KFr { bf16x8 a0, a1, b0, b1; };
__device__ __forceinline__ KFr idx_load(const bf16* kidx, size_t krow, int lane) {
    const bf16* kp = kidx + (krow >> 4) * 1024 + lane * 8;
    KFr f; f.a0 = *(const bf16x8*)kp; f.a1 = *(const bf16x8*)(kp + 512); f.b0 = *(const bf16x8*)(kp + 1024); f.b1 = *(const bf16x8*)(kp + 1536); return f;
}
__device__ __forceinline__ f32x4 idx_score4(const bf16x8 k0, const bf16x8 k1, const bf16x8 (&qf)[4][2], const f32x4 w) {
    f32x4 s = {0.f, 0.f, 0.f, 0.f};
#pragma unroll
    for (int hd = 0; hd < 4; ++hd) {
        f32x4 d = {0.f, 0.f, 0.f, 0.f};
        d = mfma16(k0, qf[hd][0], d); d = mfma16(k1, qf[hd][1], d);
#pragma unroll
        for (int r = 0; r < 4; ++r) { const int di = __float_as_int(d[r]); s[r] = __builtin_fmaf(w[hd], __int_as_float(di > 0 ? di : 0), s[r]); }
    }
    return s;
}
__device__ __forceinline__ unsigned orderable(float s) { const unsigned u = __float_as_uint(s); return u ^ ((u >> 31) ? 0xFFFFFFFFu : 0x80000000u); }

template <int NE> __device__ __forceinline__ unsigned long long rank_select(const unsigned long long (&v)[NE], unsigned long long top12, int need) {
    unsigned long long prefix = top12 << 33;
    for (int bit = 32; bit >= 0; --bit) {
        const unsigned long long cand = prefix | (1ull << bit);
        int cnt = 0;
#pragma unroll
        for (int e = 0; e < NE; ++e) cnt += __popcll(__ballot(v[e] >= cand));
        if (cnt >= need) prefix = cand;
    }
    return prefix;
}

template <int sprobe> __device__ __forceinline__ void select_item(KP p, int b, int u, LAS unsigned char* lds, int tid, int lane, int wave) {
    LAS unsigned* hist = (LAS unsigned*)lds;
    LAS unsigned long long* lists = (LAS unsigned long long*)lds;
    LAS unsigned* mstage = (LAS unsigned*)(lds + 131072);
    LAS int* qinfo = (LAS int*)(lds + 147456);
    const bf16* P = (const bf16*)(gws(p) + WS_R1); const bf16* kidx = (const bf16*)(gws(p) + WS_KIDX);
    const int q0 = u * 16, nkeys = q0 + 16, ngrp = (nkeys + 31) >> 5, nw2 = (nkeys + 63) >> 6;
#pragma unroll
    for (int i = 0; i < 16; ++i) ((LAS u32x4*)hist)[tid + 512 * i] = (u32x4){0u, 0u, 0u, 0u};
#pragma unroll
    for (int i = 0; i < 2; ++i) ((LAS u32x4*)mstage)[tid + 512 * i] = (u32x4){0u, 0u, 0u, 0u};
    if (tid < 48) qinfo[tid] = 0;
    const int ql = lane & 15, h4 = lane >> 4, tq = q0 + ql;
    const size_t qrow = (size_t)b * SEQ + tq;
    bf16x8 qf[4][2];
#pragma unroll
    for (int hd = 0; hd < 4; ++hd)
#pragma unroll
        for (int ks = 0; ks < 2; ++ks) qf[hd][ks] = *(const bf16x8*)(P + qrow * PLD + C_QI + hd * 64 + ks * 32 + h4 * 8);
    const f32x4 w = *(const f32x4*)((const float*)(gws(p) + WS_WIDX) + qrow * 4);
    __syncthreads();
    {
        const size_t kr0 = (size_t)b * SEQ;
#define SEL_HADD(x) do { const unsigned u_ = __float_as_uint(x);   \
            (void)__hip_atomic_fetch_add((LAS unsigned*)((LAS unsigned char*)hist + hqb + (((u_ >> 19) + hrot) & 0x1FFCu)), 1u + ((u_ >> 20) & 1u) * 0xFFFFu, __ATOMIC_RELAXED, __HIP_MEMORY_SCOPE_WORKGROUP); } while (0)
#define SEL_BODY1(KF, gg) do { if ((gg) < ngrp) { if ((gg) * 32 + 31 <= q0) { \
            { const f32x4 sc = idx_score4(KF.a0, KF.a1, qf, w); _Pragma("unroll") for (int r = 0; r < 4; ++r) SEL_HADD(sc[r]); } \
            { const f32x4 sc = idx_score4(KF.b0, KF.b1, qf, w); _Pragma("unroll") for (int r = 0; r < 4; ++r) SEL_HADD(sc[r]); } } \
          else { _Pragma("unroll") for (int hf = 0; hf < 2; ++hf) { const int kb = (gg) * 32 + hf * 16; \
            if (kb < nkeys) { const f32x4 sc = hf ? idx_score4(KF.b0, KF.b1, qf, w) : idx_score4(KF.a0, KF.a1, qf, w); \
                _Pragma("unroll") for (int r = 0; r < 4; ++r) { const int key = kb + 4 * h4 + r; if (key <= tq) SEL_HADD(sc[r]); } } } } } } while (0)
#define SEL_LOAD(gg) idx_load(kidx, kr0 + 32 * ((gg) < ngrp ? (gg) : wave), lane)
        const unsigned hqb = (unsigned)ql * 8192u;
        const unsigned hrot = (unsigned)ql * 16u;
        KFr kA = SEL_LOAD(wave), kB = SEL_LOAD(wave + 8), kC;
        for (int g = wave; g < ngrp; g += 24) {
            kC = SEL_LOAD(g + 16); SEL_BODY1(kA, g);
            kA = SEL_LOAD(g + 24); SEL_BODY1(kB, g + 8);
            kB = SEL_LOAD(g + 32); SEL_BODY1(kC, g + 16);
        }
#undef SEL_BODY1
#undef SEL_HADD
    }
    __syncthreads();
    for (int qq = 0; qq < 2; ++qq) {
        const int q = 2 * wave + qq, total = q0 + q + 1;
        if (total <= 256) { if (lane == 0) { qinfo[q] = -1; qinfo[16 + q] = 0; } continue; }
        LAS unsigned* hq = hist + q * 2048;
        const int wb = lane < 32 ? 992 - 32 * lane : 32 * lane;
        int s = 0;
#pragma unroll 8
        for (int i = 0; i < 32; ++i) { const unsigned wv = hq[(wb + ((i + lane) & 31) + 4 * q) & 2047]; s += (int)(wv & 0xffffu) + (int)(wv >> 16); }
        int pre = s;
#pragma unroll
        for (int off = 1; off < 64; off <<= 1) { const int t = __shfl_up(pre, off); if (lane >= off) pre += t; }
        const unsigned long long ball = __ballot(pre >= 256);
        const int L = __ffsll((long long)ball) - 1;
        const int above = (L > 0) ? __shfl(pre, L - 1) : 0;
        const int wbL = L < 32 ? 992 - 32 * L : 32 * L;
        const int wj = L < 32 ? wbL + 31 - (lane >> 1) : wbL + (lane >> 1), hj = L < 32 ? 1 - (lane & 1) : (lane & 1);
        const unsigned wv = hq[(wj + 4 * q) & 2047];
        const int c = hj ? (int)(wv >> 16) : (int)(wv & 0xffffu);
        int pre2 = c;
#pragma unroll
        for (int off = 1; off < 64; off <<= 1) { const int t = __shfl_up(pre2, off); if (lane >= off) pre2 += t; }
        pre2 += above;
        const unsigned long long ball2 = __ballot(pre2 >= 256);
        const int is = __ffsll((long long)ball2) - 1;
        const int nab = __shfl(pre2, is) - __shfl(c, is);
        const int b1raw = __shfl(2 * wj + hj, is);
        if (lane == 0) { qinfo[q] = b1raw; qinfo[16 + q] = nab; }
    }
    __syncthreads();
    const int b1q = qinfo[ql];
    {
        const size_t kr0 = (size_t)b * SEQ;
        struct Pend { int pos; unsigned flags; int gg; unsigned ub[8]; };
#define SEL_FLUSH(PD) do { if ((PD).flags) { _Pragma("unroll") for (int k = 0; k < 8; ++k) if (((PD).flags >> k) & 1u) { \
            const int idx = (PD).pos + __popc((PD).flags & ((1u << k) - 1u)), key = (PD).gg * 32 + (k >> 2) * 16 + 4 * h4 + (k & 3); \
            if (idx < 1024) lists[ql * 1024 + idx] = ((unsigned long long)orderable(__uint_as_float((PD).ub[k])) << 13) | (unsigned long long)(8191 - key); } } } while (0)
#define SEL_EL2(x, K, OK) do { const float x_ = (x); (PN_).ub[K] = __float_as_uint(x_); const bool gt = x_ > hiF, ge = x_ >= loF; \
            bits |= ((OK) && gt) ? (1u << (((K) >> 2) * 16 + 4 * h4 + ((K) & 3))) : 0u; (PN_).flags |= ((OK) && ge && !gt) ? (1u << (K)) : 0u; } while (0)
#define SEL_BODY2(KF, gg_, PN, PO) do { (PN).flags = 0u; (PN).gg = (gg_); (PN).pos = 0; if ((gg_) < ngrp) { unsigned bits = 0u; auto& PN_ = (PN); \
            if ((gg_) * 32 + 31 <= q0) { \
                { const f32x4 sc = idx_score4(KF.a0, KF.a1, qf, w); _Pragma("unroll") for (int r = 0; r < 4; ++r) SEL_EL2(sc[r], r, true); } \
                { const f32x4 sc = idx_score4(KF.b0, KF.b1, qf, w); _Pragma("unroll") for (int r = 0; r < 4; ++r) SEL_EL2(sc[r], 4 + r, true); } } \
            else { _Pragma("unroll") for (int hf = 0; hf < 2; ++hf) { const int kb = (gg_) * 32 + hf * 16; \
                if (kb < nkeys) { const f32x4 sc = hf ? idx_score4(KF.b0, KF.b1, qf, w) : idx_score4(KF.a0, KF.a1, qf, w); \
                    _Pragma("unroll") for (int r = 0; r < 4; ++r) { const int key = kb + 4 * h4 + r; SEL_EL2(sc[r], hf * 4 + r, key <= tq); } } } } \
            if ((PN).flags) (PN).pos = __hip_atomic_fetch_add(&qinfo[32 + ql], __popc((PN).flags), __ATOMIC_RELAXED, __HIP_MEMORY_SCOPE_WORKGROUP); \
            bits = xor16_or(bits); bits = xor32_or(bits); if (h4 == 0) mstage[(gg_) * 16 + ql] = bits; } \
            SEL_FLUSH(PO); } while (0)
        const unsigned e0 = (unsigned)b1q << 20, e1 = e0 | 0xFFFFFu;
        const float hiF = b1q < 0 ? -__builtin_inff() : (b1q < 2048 ? __uint_as_float(e1) : __uint_as_float(e0 | (b1q == 2048 ? 1u : 0u)));
        const float loF = b1q < 0 ? -__builtin_inff() : (b1q < 2048 ? __uint_as_float(e0) : __uint_as_float(e1));
        Pend pA, pB, pC; pC.flags = 0u; pC.pos = 0; pC.gg = 0;
#pragma unroll
        for (int k = 0; k < 8; ++k) pC.ub[k] = 0u;
        KFr kA = SEL_LOAD(wave), kB = SEL_LOAD(wave + 8), kC;
        for (int g = wave; g < ngrp; g += 24) {
            kC = SEL_LOAD(g + 16); SEL_BODY2(kA, g, pA, pC);
            kA = SEL_LOAD(g + 24); SEL_BODY2(kB, g + 8, pB, pA);
            kB = SEL_LOAD(g + 32); SEL_BODY2(kC, g + 16, pC, pB);
        }
        SEL_FLUSH(pC);
#undef SEL_FLUSH
#undef SEL_BODY2
#undef SEL_EL2
#undef SEL_LOAD
    }
    __syncthreads();
    for (int qq = 0; qq < 2; ++qq) {
        const int q = 2 * wave + qq, b1 = qinfo[q];
        if (b1 < 0) continue;
        int n = qinfo[32 + q]; n = n > 1024 ? 1024 : n;
        const int need = 256 - qinfo[16 + q];
        const unsigned long long top12 = (unsigned long long)(b1 < 2048 ? (b1 | 2048) : (b1 ^ 4095));
        const LAS unsigned long long* Lq = lists + q * 1024;
        unsigned long long thr;
        if (n <= 64) { unsigned long long v[1]; v[0] = lane < n ? Lq[lane] : 0ull; thr = rank_select<1>(v, top12, need); }
        else if (n <= 256) { unsigned long long v[4];
#pragma unroll
            for (int e = 0; e < 4; ++e) v[e] = (lane + 64 * e) < n ? Lq[lane + 64 * e] : 0ull;
            thr = rank_select<4>(v, top12, need); }
        else if (n <= 512) { unsigned long long v[8];
#pragma unroll
            for (int e = 0; e < 8; ++e) v[e] = (lane + 64 * e) < n ? Lq[lane + 64 * e] : 0ull;
            thr = rank_select<8>(v, top12, need); }
        else { unsigned long long v[16];
#pragma unroll
            for (int e = 0; e < 16; ++e) v[e] = (lane + 64 * e) < n ? Lq[lane + 64 * e] : 0ull;
            thr = rank_select<16>(v, top12, need); }
        for (int e = lane; e < n; e += 64) { const unsigned long long v = Lq[e]; if (v >= thr) { const int key = 8191 - (int)(v & 8191ull); (void)__hip_atomic_fetch_or(&mstage[(key >> 5) * 16 + q], 1u << (key & 31), __ATOMIC_RELAXED, __HIP_MEMORY_SCOPE_WORKGROUP); } }
    }
    __syncthreads();
    unsigned* mask = (unsigned*)(gws(p) + WS_MASK);
    for (int i = tid; i < 16 * nw2; i += 512) { const int wp = i >> 4, q = i & 15; u32x2 mv; mv.x = mstage[(2 * wp) * 16 + q]; mv.y = mstage[(2 * wp + 1) * 16 + q]; *(u32x2*)(mask + (((size_t)(b * 128 + wp)) * SEQ + q0 + q) * 2) = mv; }
    __syncthreads();
}

__device__ __forceinline__ float bfi_sel(int sel, float x) { float r; asm("v_bfi_b32 %0, %1, %2, %3" : "=v"(r) : "v"(sel), "v"(x), "v"(0xff800000u)); return r; }
constexpr int AT_K = 0, AT_VT = 16384, AT_BUF = 32768, AT_BIAS = 3 * AT_BUF;
__device__ __forceinline__ void attn_bias_table(KP p, LAS unsigned char* lds, int tid) {
    LAS float* bt = (LAS float*)(lds + AT_BIAS);
    for (int i = tid; i < 1024; i += 512) {
        const int hd = i >> 7, dd = i & 127;
        int bk = dd;
        if (dd >= 16) { bk = 16 + (dd >= 19) + (dd >= 21) + (dd >= 24) + (dd >= 27) + (dd >= 31) + (dd >= 35) + (dd >= 40) + (dd >= 46) + (dd >= 52) + (dd >= 59) + (dd >= 67) + (dd >= 77) + (dd >= 87) + (dd >= 99) + (dd >= 113); }
        bt[i] = gin(p, I_RELB)[bk * 8 + hd] * LOG2E;
    }
}
template <int probe> __device__ __forceinline__ void attn_item(KP p, int b, int kvh, int qt, LAS unsigned char* lds, int lane_, int wave, bf16* OB, int old) {
    const int lane = launder_v(lane_);
    const bf16* P = (const bf16*)(gws(p) + WS_R1); const bf16* VT = (const bf16*)(gws(p) + WS_VT); const unsigned* mask = (const unsigned*)(gws(p) + WS_MASK);
    const int head = kvh * 4 + (wave & 3), q0 = qt * 64 + 32 * (wave >> 2), nkt = qt + 1, ql = lane & 31, hi = lane >> 5, tq = q0 + ql;
    const size_t row = (size_t)b * SEQ + tq;
    bf16x8 qf[8];
#pragma unroll
    for (int ks = 0; ks < 8; ++ks) qf[ks] = *(const bf16x8*)(P + row * PLD + C_QA + head * 128 + 16 * ks + 8 * hi);
    f32x16 O[4];
#pragma unroll
    for (int dt = 0; dt < 4; ++dt)
#pragma unroll
        for (int r = 0; r < 16; ++r) O[dt][r] = 0.f;
    float mrun = -1.0e4f, lrun = 0.f;
    const float c1 = 0.08838834764831845f * LOG2E;
    const LAS float* btab = (const LAS float*)(lds + AT_BIAS) + head * 128;
    const bf16* kbase = P + (size_t)b * SEQ * PLD + C_KA + kvh * 128; const bf16* vbase = VT + (size_t)(b * 2 + kvh) * 128 * SEQ; (void)0;
#define AT_MW(KT) (*(const u32x2*)(mask + (((size_t)(b * 128 + (KT))) * SEQ + (q0 + (launder_v(lane) & 31))) * 2))
#define AT_DMA(kt, st) do { const int l_ = launder_v(lane); _Pragma("unroll") for (int i = 0; i < 2; ++i) { \
        const int pos = 1024 * (wave + 8 * i) + 16 * l_;             \
        const int key = pos >> 8, kc = ((pos >> 4) & 15) ^ (key & 15); const unsigned koff_ = (unsigned)(key * PLD + kc * 8); \
        const int d = pos >> 7, vc = ((pos >> 4) & 7) ^ ((d >> 1) & 7); const unsigned voff_ = (unsigned)(d * 64 + vc * 8); \
        __builtin_amdgcn_global_load_lds((const unsigned*)(kbase + (size_t)(kt) * 64 * PLD + koff_), (LAS unsigned*)(lds + (st) * AT_BUF + AT_K + 1024 * (wave + 8 * i)), 16, 0, 0); \
        __builtin_amdgcn_global_load_lds((const unsigned*)(vbase + (size_t)(kt) * 8192 + voff_), (LAS unsigned*)(lds + (st) * AT_BUF + AT_VT + 1024 * (wave + 8 * i)), 16, 0, 0); } } while (0)
    const int piq = (ql & 16) | ((ql & 4) << 1) | ((ql & 8) >> 1) | (ql & 3);
    const unsigned ksw0 = (unsigned)launder_v(piq * 256 + ((hi ^ (piq & 15)) << 4)), vsw0 = (unsigned)launder_v(ql * 128 + ((hi ^ ((ql >> 1) & 7)) << 4));
    bf16x8 X[8], Y[8];
#define AT_LDK(dst, stg, hh) do { const LAS unsigned char* kb_ = lds + (stg) * AT_BUF + AT_K + (hh) * 8192; _Pragma("unroll") for (int ks = 0; ks < 8; ++ks) dst[ks] = *(const LAS bf16x8*)(kb_ + (ksw0 ^ (unsigned)(ks << 5))); } while (0)
#define AT_LDV(dst, stg, sh) do { const LAS unsigned char* vb_ = lds + (stg) * AT_BUF + AT_VT; _Pragma("unroll") for (int dt = 0; dt < 4; ++dt) _Pragma("unroll") for (int s = 0; s < 2; ++s) dst[dt * 2 + s] = *(const LAS bf16x8*)(vb_ + (vsw0 ^ (unsigned)((2 * (sh) + s) << 5)) + dt * 4096); } while (0)
    AT_DMA(0, 0);
    u32x2 mwA = AT_MW(0);
    if (nkt > 1) AT_DMA(1, 1);
    asm volatile("s_waitcnt vmcnt(0)" ::: "memory");
    __builtin_amdgcn_s_barrier();
    asm volatile("" ::: "memory");
    bf16x8 pf[4];
    f32x16 Sa[2], Sb[2];
#pragma unroll
    for (int r = 0; r < 16; ++r) { Sa[0][r] = 0.f; Sa[1][r] = 0.f; }
    AT_LDK(X, 0, 0); AT_LDK(Y, 0, 1);
#pragma unroll
    for (int ks = 0; ks < 8; ++ks) Sa[0] = mfma32(X[ks], qf[ks], Sa[0]);
#pragma unroll
    for (int ks = 0; ks < 8; ++ks) Sa[1] = mfma32(Y[ks], qf[ks], Sa[1]);
    int st = 0;
#define AT_STEP(SC, SN, KT) do { const int kt_ = (KT); const int stn = st == 2 ? 0 : st + 1, stnn = stn == 2 ? 0 : stn + 1; \
        asm volatile("s_waitcnt vmcnt(0)" ::: "memory"); __builtin_amdgcn_s_barrier(); asm volatile("" ::: "memory");        \
        const u32x2 mcur = mwA; \
        if (kt_ + 1 < nkt) mwA = AT_MW(kt_ + 1); \
        if (kt_ + 2 < nkt) AT_DMA(kt_ + 2, stnn); \
          \
        AT_LDK(X, stn, 0); \
        _Pragma("unroll") for (int r = 0; r < 16; ++r) { SN[0][r] = 0.f; SN[1][r] = 0.f; } \
        const bool farr = (q0 - (64 * kt_ + 63)) >= 113; \
        float mt = -INFINITY; \
          \
        if (farr) { const float boff = btab[127] - mrun; \
            _Pragma("unroll") for (int ks = 0; ks < 8; ++ks) SN[0] = mfma32(X[ks], qf[ks], SN[0]); \
            _Pragma("unroll") for (int hh = 0; hh < 2; ++hh) { const unsigned wbits = (hh ? mcur.y : mcur.x) >> (8 * hi); \
                _Pragma("unroll") for (int r = 0; r < 16; ++r) { const int kk = 16 * (r >> 3) + 4 * ((r >> 2) & 1) + (r & 3); \
                    const float x = __builtin_fmaf(SC[hh][r], c1, boff); const int sel = __builtin_amdgcn_sbfe((int)wbits, kk, 1); const float xm = bfi_sel(sel, x); SC[hh][r] = xm; mt = fmaxf(mt, xm); } } \
            _Pragma("unroll") for (int i = 0; i < 8; ++i) { __builtin_amdgcn_sched_group_barrier(0x008, 1, 0); __builtin_amdgcn_sched_group_barrier(0x002, 14, 0); } \
        } else { \
            _Pragma("unroll") for (int ks = 0; ks < 8; ++ks) SN[0] = mfma32(X[ks], qf[ks], SN[0]); \
            _Pragma("unroll") for (int hh = 0; hh < 2; ++hh) { const unsigned wbits = (hh ? mcur.y : mcur.x) >> (8 * hi); const int dbase = tq - (64 * kt_ + 32 * hh + 8 * hi); \
                _Pragma("unroll") for (int r = 0; r < 16; ++r) { const int kk = 16 * (r >> 3) + 4 * ((r >> 2) & 1) + (r & 3); int dist = dbase - kk; dist = dist < 0 ? 0 : (dist > 127 ? 127 : dist); \
                    const float x = __builtin_fmaf(SC[hh][r], c1, btab[dist] - mrun); const int sel = __builtin_amdgcn_sbfe((int)wbits, kk, 1); const float xm = bfi_sel(sel, x); SC[hh][r] = xm; mt = fmaxf(mt, xm); } } \
        } \
        mt = xmax32(mt); \
        float alpha = 1.0f; \
        if (!__all(mt <= 8.0f)) { const float dm = fmaxf(mt, 0.f); alpha = __builtin_amdgcn_exp2f(-dm); mrun += dm; \
            _Pragma("unroll") for (int dt = 0; dt < 4; ++dt) _Pragma("unroll") for (int r = 0; r < 16; ++r) O[dt][r] *= alpha; \
            _Pragma("unroll") for (int hh = 0; hh < 2; ++hh) _Pragma("unroll") for (int r = 0; r < 16; ++r) SC[hh][r] -= dm; } \
          \
        AT_LDK(X, stn, 1); \
        _Pragma("unroll") for (int ks = 0; ks < 8; ++ks) SN[1] = mfma32(X[ks], qf[ks], SN[1]); \
        float ps = 0.f; \
        _Pragma("unroll") for (int hh = 0; hh < 2; ++hh) _Pragma("unroll") for (int r = 0; r < 16; ++r) { const float e = __builtin_amdgcn_exp2f(SC[hh][r]); SC[hh][r] = e; ps += e; } \
        lrun = lrun * alpha + ps; \
        _Pragma("unroll") for (int s4 = 0; s4 < 4; ++s4) { const int hh = s4 >> 1, r0 = 8 * (s4 & 1); \
            u32x4 wv; wv.x = pkbf(SC[hh][r0 + 0], SC[hh][r0 + 1]); wv.y = pkbf(SC[hh][r0 + 2], SC[hh][r0 + 3]); wv.z = pkbf(SC[hh][r0 + 4], SC[hh][r0 + 5]); wv.w = pkbf(SC[hh][r0 + 6], SC[hh][r0 + 7]); \
            pf[s4] = __builtin_bit_cast(bf16x8, wv); } \
        __builtin_amdgcn_sched_barrier(0); \
          \
        AT_LDV(X, st, 0); AT_LDV(Y, st, 1); \
        _Pragma("unroll") for (int i = 0; i < 8; ++i) { const int dt = i >> 1, sx = i & 1; O[dt] = mfma32(X[dt * 2 + sx], pf[sx], O[dt]); } \
        _Pragma("unroll") for (int i = 0; i < 8; ++i) { const int dt = i >> 1, sx = i & 1; O[dt] = mfma32(Y[dt * 2 + sx], pf[2 + sx], O[dt]); } \
        __builtin_amdgcn_sched_barrier(0); \
        st = stn; } while (0)
    for (int kt = 0; kt < nkt; kt += 2) {
        AT_STEP(Sa, Sb, kt);
        if (kt + 1 < nkt) AT_STEP(Sb, Sa, kt + 1);
    }
#undef AT_STEP
#undef AT_MW
#undef AT_LDK
#undef AT_LDV
#undef AT_DMA
    const float ltot = xadd32(lrun);
    const float inv = 1.0f / ltot;
#pragma unroll
    for (int dt = 0; dt < 4; ++dt)
#pragma unroll
        for (int g = 0; g < 4; ++g) {
            u32x2 wv; wv.x = pkbf(O[dt][4 * g + 0] * inv, O[dt][4 * g + 1] * inv); wv.y = pkbf(O[dt][4 * g + 2] * inv, O[dt][4 * g + 3] * inv);
            *(u32x2*)(OB + row * old + head * 128 + 32 * dt + 8 * g + 4 * hi) = wv;
        }
    asm volatile("s_waitcnt vmcnt(0)" ::: "memory");
    __builtin_amdgcn_s_barrier();
    asm volatile("" ::: "memory");
}

#ifndef SKIP_MIXER
#define SKIP_MIXER 0
#endif
#ifndef PROBE_MIX
#define PROBE_MIX 0
#endif
#ifndef PROBE_CVT
#define PROBE_CVT 0
#endif
#ifndef ZERO_BRANCH
#define ZERO_BRANCH 0
#endif
__device__ __forceinline__ void zero_cols(bf16* P, int col0, int gw, int NGW, int lane) {
    for (int m = gw; m < M; m += NGW) { u32x4* o = (u32x4*)(P + (size_t)m * PLD + col0) + lane; o[0] = (u32x4){0u, 0u, 0u, 0u}; o[64] = (u32x4){0u, 0u, 0u, 0u}; }
}
__global__ void __launch_bounds__(512, 2) fwd(Params pdummy) {
    extern __shared__ __attribute__((aligned(16))) unsigned char lds_raw[];
    LAS unsigned char* lds = (LAS unsigned char*)lds_raw;
    const int wave0 = __builtin_amdgcn_readfirstlane(threadIdx.x >> 6);
    const int G = gridDim.x, bx = blockIdx.x;
    const int vcu = (G % 8 == 0) ? (bx % 8) * (G / 8) + bx / 8 : bx;
    const int NGW = G * 8;
    if (threadIdx.x < 64) ((LAS unsigned*)(lds + MISC_OFF))[threadIdx.x] = 0u;
    __syncthreads();
    XcdBarrier bar = xcd_barrier_post((unsigned*)(gws(kargs()) + WS_CTL) + CW_BAR, (volatile LAS unsigned*)(lds + MISC_OFF + 32));
#define GRID_BAR() xcd_barrier(bar)
#define PH_BEGIN const int lane = lane_id_asm(), wave = wave0, tid = wave * 64 + lane, gw = vcu * 8 + wave, bxl = launder_s(bx); KP p = kargs(); (void)bxl; unsigned char* ws = gws(p); (void)lane; (void)gw; (void)ws;

    for (int l = 0; l < DEPTH; ++l) {
        for (int rep = (PROBE_CVT & 1) ? 0 : 1; rep < 2; ++rep) { PH_BEGIN phase_cvt(p, l, lds, vcu, G, gw, NGW, wave, lane); }
        for (int f = 0; f < 2; ++f) {
            if (f == 1 && !SKIP_MIXER) {
                for (int rep = (PROBE_CVT & 1) ? 0 : 1; rep < 2; ++rep) { PH_BEGIN rstd_from_parts(p, gw * 64 + lane, NGW * 64); }
                GRID_BAR();
                for (int rep = (PROBE_CVT & 4) ? 0 : 1; rep < 2; ++rep)
                { PH_BEGIN
                    pg8::Gemm g{(const bf16*)(ws + WS_XB), (const bf16*)(ws + WS_WIN), M, DIN_PAD, DM, DM, DM}; pg8::StaticOrder S; S.init(M, DIN_PAD, G, bxl);
                    pg8::EpiProj E{(bf16*)(ws + WS_R1), PLD, (float*)(ws + WS_SIDE), (bf16*)(ws + WS_GFR), (long)WS_RSTD - (long)WS_R1};
                    pg8::gemm_phase<pg8::EpiProj, pg8::StaticOrder, true, true>(lds, g, S, E, tid);
                }
                GRID_BAR();
                for (int rep = (PROBE_MIX & 16) ? 0 : 1; rep < 2; ++rep) {
                { PH_BEGIN
                    for (int gt = vcu * 512 + tid; gt < 4 * M; gt += G * 512) kidx_ln_quarter(p, l, gt);
                    for (int it = gw; it < 1024; it += NGW) vt_item(p, it, lds + 8192 + wave * 16384, lane);
                } }
                for (int rep = (PROBE_MIX & 32) ? 0 : 1; rep < 2; ++rep)
                { PH_BEGIN for (int it = vcu; it < 256; it += G) lru_job(p, l, it, lds, tid, lane, wave); }
                for (int rep = (PROBE_MIX & 64) ? 0 : 1; rep < 2; ++rep)
                { PH_BEGIN bf16* OB = rep ? (bf16*)(ws + WS_R1) + C_QM : (bf16*)(ws + WS_SCR); const int old = rep ? PLD : 1024;
                    if (!(ZERO_BRANCH & 4)) { for (int it = vcu; it < 256; it += G) memattn_job(p, it, lds, tid, lane, wave, OB, old); __syncthreads(); } else zero_cols((bf16*)(ws + WS_R1), C_QM, gw, NGW, lane);
                }
                GRID_BAR();
                for (int rep = (PROBE_MIX & 6) ? 0 : 1; rep < 2; ++rep) {
                { PH_BEGIN
                    if (!(ZERO_BRANCH & 1) && (rep || (PROBE_MIX & 2))) for (int pi = vcu; pi < 512; pi += G) { const int b = pi >> 8, j = pi & 255;
#pragma unroll 1
                        for (int k = 0; k < 2; ++k) { if ((PROBE_MIX >> 12) && rep == 0) select_item<(PROBE_MIX >> 12)>(p, b, k ? 511 - j : j, lds, tid, lane, wave); else select_item<0>(p, b, k ? 511 - j : j, lds, tid, lane, wave); } }
                    __syncthreads();
                }
                { PH_BEGIN bf16* OB = rep ? (bf16*)(ws + WS_R1) + C_GL : (bf16*)(ws + WS_SCR); const int old = rep ? PLD : 1024;
                    if (!(ZERO_BRANCH & 2) && (rep || (PROBE_MIX & 4))) { for (int it = vcu; it < 256; it += G) lru_apply_job(p, it, lds, tid, lane, wave, OB, old); } else if (ZERO_BRANCH & 2) zero_cols((bf16*)(ws + WS_R1), C_GL, gw, NGW, lane);
                }
                }
                GRID_BAR();
                for (int rep = (PROBE_MIX & 8) ? 0 : 1; rep < 2; ++rep) {
                { PH_BEGIN bf16* OB = rep ? (bf16*)(ws + WS_R1) + C_XL : (bf16*)(ws + WS_SCR); const int old = rep ? PLD : 1024;
                    if (!(ZERO_BRANCH & 1)) {
                        attn_bias_table(p, lds, tid);
                        __syncthreads();
                        for (int pi = vcu; pi < 256; pi += G) { const int bk = pi >> 6, j = pi & 63;
#pragma unroll 1
                            for (int k = 0; k < 2; ++k) { if ((PROBE_MIX >> 8) && rep == 0) attn_item<(PROBE_MIX >> 8)>(p, bk >> 1, bk & 1, k ? 127 - j : j, lds, lane, wave, OB, old); else attn_item<0>(p, bk >> 1, bk & 1, k ? 127 - j : j, lds, lane, wave, OB, old); } }
                    } else zero_cols((bf16*)(ws + WS_R1), C_XL, gw, NGW, lane);
                }
                }
                GRID_BAR();
                for (int rep = (PROBE_CVT & 16) ? 0 : 1; rep < 2; ++rep) {
                { PH_BEGIN bf16* R1 = (bf16*)(ws + WS_R1); const bf16* WBR = (const bf16*)(ws + WS_WBR); pg8::StaticOrder S; S.init(M, DM, G, bxl);
                  pg8::Gemm g{R1 + C_XL, WBR, M, DM, 3072, PLD, 3072}; pg8::EpiGate E{(const bf16*)(ws + WS_GFR), 0, (bf16*)(ws + WS_XN), DM}; pg8::gemm_phase<pg8::EpiGate, pg8::StaticOrder, true, true>(lds, g, S, E, tid); }
                }
                GRID_BAR();
                { PH_BEGIN
                    pg8::Gemm g{(const bf16*)(ws + WS_XN), (const bf16*)(ws + WS_WOUT), M, DM, DM, DM, DM}; pg8::StaticOrder S; S.init(M, DM, G, bxl);
                    pg8::EpiResidB<false> E{nullptr, (const bf16*)(ws + WS_XB), (bf16*)(ws + WS_XB), DM, 1.0f, (long)WS_PART - (long)WS_XB};
                    pg8::gemm_phase<pg8::EpiResidB<false>, pg8::StaticOrder, true, true>(lds, g, S, E, tid);
                }
                GRID_BAR();
            }
            for (int rep = (PROBE_CVT & 1) ? 0 : 1; rep < 2; ++rep) { PH_BEGIN if (l == 0 && f == 0) rstd_first(p, gw, NGW, lane); else rstd_from_parts(p, gw * 64 + lane, NGW * 64); }
            GRID_BAR();
            if (f == 0) {
                { PH_BEGIN const bf16* WM = (const bf16*)(ws + WS_WMKV); const bf16* MN = (const bf16*)(ws + WS_MEMN);
                  pg8::Gemm g{MN, WM, BATCH * NMEM, 1024, DM, DM, DM}; pg8::SimpleOrder S; S.init(BATCH * NMEM, 1024, G, bxl - 192); pg8::EpiBf16 E{(bf16*)(ws + WS_MK), 1024}; pg8::gemm_phase<pg8::EpiBf16, pg8::SimpleOrder, true, true>(lds, g, S, E, tid); }
                { PH_BEGIN const bf16* WM = (const bf16*)(ws + WS_WMKV); const bf16* MN = (const bf16*)(ws + WS_MEMN);
                  pg8::Gemm g{WM + (size_t)1024 * DM, MN, 1024, BATCH * NMEM, DM, DM, DM}; pg8::SimpleOrder S; S.init(1024, BATCH * NMEM, G, bxl - 200); pg8::EpiBf16 E{(bf16*)(ws + WS_VTM), BATCH * NMEM}; pg8::gemm_phase<pg8::EpiBf16, pg8::SimpleOrder, true, true>(lds, g, S, E, tid); }
            }
            for (int rep = (PROBE_CVT & 2) ? 0 : 1; rep < 2; ++rep)
            { PH_BEGIN
                pg8::Gemm g{(const bf16*)(ws + WS_XB), (const bf16*)(ws + (f ? WS_WGU2 : WS_WGU)), M, 2 * DFF, DM, DM, DM}; pg8::StaticOrder S; S.init(M, 2 * DFF, G, bxl);
                pg8::EpiSwiglu E{(bf16*)(ws + WS_R1), DFF, (long)WS_RSTD - (long)WS_R1};
                pg8::gemm_phase<pg8::EpiSwiglu, pg8::StaticOrder, true, true>(lds, g, S, E, tid);
            }
            GRID_BAR();
            for (int rep = (PROBE_CVT & 8) ? 0 : 1; rep < 2; ++rep)
            { PH_BEGIN
                pg8::Gemm g{(const bf16*)(ws + WS_R1), (const bf16*)(ws + (f ? WS_WDN2 : WS_WDN)), M, DM, DFF, DFF, DFF}; pg8::StaticOrder S; S.init(M, DM, G, bxl);
                if (l == 0 && f == 0) { pg8::EpiResidB<true> E{gin(p, I_X), nullptr, (bf16*)(ws + WS_XB), DM, 0.5f, (long)WS_PART - (long)WS_XB}; pg8::gemm_phase<pg8::EpiResidB<true>, pg8::StaticOrder, true, true>(lds, g, S, E, tid); }
                else { pg8::EpiResidB<false> E{nullptr, (const bf16*)(ws + WS_XB), (bf16*)(ws + WS_XB), DM, 0.5f, (long)WS_PART - (long)WS_XB}; pg8::gemm_phase<pg8::EpiResidB<false>, pg8::StaticOrder, true, true>(lds, g, S, E, tid); }
            }
            GRID_BAR();
        }
    }
    { PH_BEGIN float* X = gout(p); const bf16* XB = (const bf16*)(ws + WS_XB); const float* g = gin(p, I_FNORM);
      f32x4 gg[4][2];
#pragma unroll
      for (int j = 0; j < 4; ++j) { gg[j][0] = *(const f32x4*)(g + 512 * j + 8 * lane); gg[j][1] = *(const f32x4*)(g + 512 * j + 8 * lane + 4); }
      for (int m = gw; m < M; m += 4 * NGW) {
          u32x4 v[4][4]; float ss[4];
#pragma unroll
          for (int r = 0; r < 4; ++r) { const int mr = (m + r * NGW < M) ? m + r * NGW : m; const u32x4* xr = (const u32x4*)(XB + (size_t)mr * DM) + lane;
#pragma unroll
              for (int j = 0; j < 4; ++j) v[r][j] = xr[64 * j]; }
#pragma unroll
          for (int r = 0; r < 4; ++r) { float sq = 0.f;
#pragma unroll
              for (int j = 0; j < 4; ++j)
#pragma unroll
                  for (int e = 0; e < 4; ++e) { const float a = bflo(v[r][j][e]), b2 = bfhi(v[r][j][e]); sq += a * a + b2 * b2; }
              ss[r] = 1.0f / sqrtf(wave_sum(sq) * (1.0f / DM) + EPS); }
#pragma unroll
          for (int r = 0; r < 4; ++r) if (m + r * NGW < M) { float* o = X + (size_t)(m + r * NGW) * DM + 8 * lane;
#pragma unroll
              for (int j = 0; j < 4; ++j) {
                  *(f32x4*)(o + 512 * j) = (f32x4){bflo(v[r][j].x), bfhi(v[r][j].x), bflo(v[r][j].y), bfhi(v[r][j].y)} * ss[r] * gg[j][0];
                  *(f32x4*)(o + 512 * j + 4) = (f32x4){bflo(v[r][j].z), bfhi(v[r][j].z), bflo(v[r][j].w), bfhi(v[r][j].w)} * ss[r] * gg[j][1]; } }
      } }
}

extern "C" void kernel_launch(void* const* d_in, const int* in_sizes, int n_in, void* d_out, int out_size, void* d_ws, size_t ws_size, hipStream_t stream) {
    static int grid = 0;
    if (grid == 0) {
        if (n_in != 25 || in_sizes[0] != M * DM || out_size != M * DM || ws_size < WS_END) { fprintf(stderr, "kernel_launch: unexpected shapes / workspace (n_in %d, ws %zu, need %zu); nothing launched\n", n_in, ws_size, (size_t)WS_END); grid = -1; return; }
        int dev = 0, cus = 0, per_cu = 0;
        if (hipGetDevice(&dev) != hipSuccess || hipDeviceGetAttribute(&cus, hipDeviceAttributeMultiprocessorCount, dev) != hipSuccess) { grid = -1; return; }
        if (hipFuncSetAttribute((const void*)fwd, hipFuncAttributeMaxDynamicSharedMemorySize, LDS_BYTES) != hipSuccess) { fprintf(stderr, "kernel_launch: hipFuncSetAttribute failed\n"); grid = -1; return; }
        if (hipOccupancyMaxActiveBlocksPerMultiprocessor(&per_cu, (const void*)fwd, 512, LDS_BYTES) != hipSuccess || per_cu < 1) { fprintf(stderr, "kernel_launch: occupancy query reports %d workgroups per CU; nothing launched\n", per_cu); (void)hipGetLastError(); grid = -1; return; }
        grid = cus;
    }
    if (grid < 0) return;
    if (hipMemsetAsync((char*)d_ws + WS_CTL, 0, CTL_ZERO_BYTES, stream) != hipSuccess) return;
    Params a{};
    for (int i = 0; i < 25; ++i) a.in[i] = (const GAS float*)d_in[i];
    a.out = (GAS float*)d_out; a.ws = (GAS unsigned char*)d_ws;
    hipLaunchKernelGGL(fwd, dim3(grid), dim3(512), LDS_BYTES, stream, a);
}
```
